# Optimizing an MI355X kernel written in HIP

```python
import jax, jax.numpy as jnp
from jax import lax
import numpy as np

D_MODEL = 2048
BATCH = 4
SEQ = 4096
DEPTH = 2

A_WIDTH = D_MODEL // 2
A_HEADS = 8
A_HEAD_DIM = A_WIDTH // A_HEADS
GMLP_CHUNK = 128
B_WIDTH = D_MODEL // 2
B_HEAD_DIM = 128
B_HEADS = B_WIDTH // B_HEAD_DIM
HGRN_CHUNK = 64
C_HEAD_DIM = 128
C_HEADS = D_MODEL // C_HEAD_DIM
ATTN_BLOCK = 128
FFN_HIDDEN = ((8 * D_MODEL // 3 + 255) // 256) * 256
CONV_WIDTH = 3
RMS_EPS = 1e-6
N_AB = (DEPTH + 1) // 2
N_C = DEPTH // 2
AB_IN = 2 * A_WIDTH + 4 * B_WIDTH
C_IN = 4 * D_MODEL + C_HEADS

kernel_name = "hybrid_gmlp_hgrn2_fox_convffn"


def rms_norm(x, gain):
    xf = x.astype(jnp.float32)
    y = xf * lax.rsqrt(jnp.mean(xf * xf, axis=-1, keepdims=True) + RMS_EPS)
    return (y * gain.astype(jnp.float32)).astype(x.dtype)


def hgrn2(q, f_logit, i, g, lower_bound, o_gain):
    bsz, seq, _ = q.shape
    dt = q.dtype
    f32 = jnp.float32
    shp = (bsz, seq, B_HEADS, B_HEAD_DIM)
    fl = f_logit.astype(f32).reshape(shp)
    lb = lower_bound.astype(f32).reshape(B_HEADS, B_HEAD_DIM)
    log_f = jnp.logaddexp(jnp.log(lb), jnp.log1p(-lb) + jax.nn.log_sigmoid(fl))
    k = (1.0 - lb) * jax.nn.sigmoid(-fl)
    nc = seq // HGRN_CHUNK

    def chunks(t):
        return t.reshape(bsz, nc, HGRN_CHUNK, B_HEADS, -1).transpose(1, 0, 3, 2, 4)

    qc = chunks(q.astype(f32).reshape(shp))
    kc = chunks(k)
    vc = chunks(i.astype(f32).reshape(shp))
    lfc = chunks(log_f)
    mask = jnp.tril(jnp.ones((HGRN_CHUNK, HGRN_CHUNK), dtype=bool))

    def step(state, xs):
        q_c, k_c, v_c, lf_c = xs
        G = jnp.cumsum(lf_c, axis=2)
        o_inter = jnp.einsum('bhtk,bhkv->bhtv', q_c * jnp.exp(G), state)
        diff = G[:, :, :, None, :] - G[:, :, None, :, :]
        decay = jnp.exp(jnp.where(mask[:, :, None], diff, -jnp.inf))
        scores = jnp.einsum('bhtk,bhtsk,bhsk->bhts', q_c, decay, k_c)
        o_intra = jnp.einsum('bhts,bhsv->bhtv', scores, v_c)
        G_end = G[:, :, -1:, :]
        new_state = (jnp.exp(G_end[:, :, 0, :])[..., None] * state
                     + jnp.einsum('bhsk,bhsv->bhkv', k_c * jnp.exp(G_end - G), v_c))
        return new_state, o_inter + o_intra

    s0 = jnp.zeros((bsz, B_HEADS, B_HEAD_DIM, B_HEAD_DIM), f32)
    _, o = lax.scan(step, s0, (qc, kc, vc, lfc))
    o = o.transpose(1, 0, 3, 2, 4).reshape(shp)
    o = rms_norm(o, o_gain) * jax.nn.silu(g.astype(f32).reshape(shp))
    return o.reshape(bsz, seq, B_WIDTH).astype(dt)


def mixer_ab(h, w_in, sp_w, sp_b, v_gain, lower_bound, o_gain, w_out):
    bsz, seq, _ = h.shape
    cuts = [A_WIDTH, 2 * A_WIDTH, 2 * A_WIDTH + B_WIDTH,
            2 * A_WIDTH + 2 * B_WIDTH, 2 * A_WIDTH + 3 * B_WIDTH]
    u, v, q, f, i, g = jnp.split(h @ w_in, cuts, axis=-1)
    u = jax.nn.gelu(u, approximate=False)
    v = jax.nn.gelu(v, approximate=False)
    v = rms_norm(v.reshape(bsz, seq, A_HEADS, A_HEAD_DIM), v_gain.reshape(A_HEADS, A_HEAD_DIM))
    v = v.reshape(bsz, seq // GMLP_CHUNK, GMLP_CHUNK, A_HEADS, A_HEAD_DIM)
    w_causal = sp_w * jnp.tril(jnp.ones((GMLP_CHUNK, GMLP_CHUNK), sp_w.dtype))
    mixed = jnp.einsum('hts,bcshd->bcthd', w_causal, v) + sp_b.T[:, :, None]
    y_a = u * mixed.reshape(bsz, seq, A_WIDTH)
    y_b = hgrn2(q, f, i, g, lower_bound, o_gain)
    return jnp.concatenate([y_a, y_b], axis=-1) @ w_out


def mixer_c(h, w_in, b_f, q_gain, k_gain, w_out):
    bsz, seq, _ = h.shape
    shp = (bsz, seq, C_HEADS, C_HEAD_DIM)
    q, k, v, g, f = jnp.split(h @ w_in, [D_MODEL, 2 * D_MODEL, 3 * D_MODEL, 4 * D_MODEL], axis=-1)
    q = rms_norm(q.reshape(shp), q_gain)
    k = rms_norm(k.reshape(shp), k_gain)
    v = v.reshape(shp)
    log_f = jax.nn.log_sigmoid(f.astype(jnp.float32) + b_f.astype(jnp.float32))
    c = jnp.cumsum(log_f, axis=1).transpose(0, 2, 1)
    scale = C_HEAD_DIM ** -0.5
    outs = []
    for blk in range(seq // ATTN_BLOCK):
        lo, hi = blk * ATTN_BLOCK, (blk + 1) * ATTN_BLOCK
        s = jnp.einsum('bthd,bshd->bhts', q[:, lo:hi], k[:, :hi]).astype(jnp.float32) * scale
        s = s + c[:, :, lo:hi, None] - c[:, :, None, :hi]
        causal = (lo + jnp.arange(ATTN_BLOCK))[:, None] >= jnp.arange(hi)[None, :]
        p = jax.nn.softmax(jnp.where(causal, s, -jnp.inf), axis=-1).astype(v.dtype)
        outs.append(jnp.einsum('bhts,bshd->bthd', p, v[:, :hi]))
    o = jnp.concatenate(outs, axis=1).reshape(bsz, seq, D_MODEL) * jax.nn.sigmoid(g)
    return o @ w_out


def conv_ffn(h, w_up, conv_w, conv_b, w_down):
    seq = h.shape[1]
    z = h @ w_up
    zp = jnp.pad(z, ((0, 0), (CONV_WIDTH - 1, 0), (0, 0)))
    z = sum(conv_w[j] * zp[:, j:j + seq] for j in range(CONV_WIDTH)) + conv_b
    a, b = jnp.split(z, 2, axis=-1)
    return (jax.nn.silu(a) * b) @ w_down


def setup_inputs(seed: int = 0) -> dict:
    key = jax.random.key(seed)
    ks = jax.random.split(key, 20)
    f32 = jnp.float32

    def dense(k, shape, fan_in):
        return jax.random.normal(k, shape, f32) * (fan_in ** -0.5)

    def gain(k, shape):
        return 1.0 + 0.02 * jax.random.normal(k, shape, f32)

    def small(k, shape, s=0.02):
        return s * jax.random.normal(k, shape, f32)

    return {
        "x": jax.random.normal(ks[0], (BATCH, SEQ, D_MODEL), f32),
        "mix_norm": gain(ks[1], (DEPTH, D_MODEL)),
        "ab_w_in": dense(ks[2], (N_AB, D_MODEL, AB_IN), D_MODEL),
        "ab_sp_w": dense(ks[3], (N_AB, A_HEADS, GMLP_CHUNK, GMLP_CHUNK), GMLP_CHUNK),
        "ab_sp_b": small(ks[4], (N_AB, A_HEADS, GMLP_CHUNK)),
        "ab_v_norm": gain(ks[5], (N_AB, A_WIDTH)),
        "hgrn_gamma": small(ks[6], (DEPTH + 1, B_WIDTH)),
        "hgrn_o_norm": gain(ks[7], (N_AB, B_HEAD_DIM)),
        "ab_w_out": dense(ks[8], (N_AB, A_WIDTH + B_WIDTH, D_MODEL), A_WIDTH + B_WIDTH),
        "c_w_in": dense(ks[9], (N_C, D_MODEL, C_IN), D_MODEL),
        "c_b_f": small(ks[10], (N_C, C_HEADS), 0.1),
        "c_q_norm": gain(ks[11], (N_C, C_HEAD_DIM)),
        "c_k_norm": gain(ks[12], (N_C, C_HEAD_DIM)),
        "c_w_out": dense(ks[13], (N_C, D_MODEL, D_MODEL), D_MODEL),
        "ffn_norm": gain(ks[14], (DEPTH, D_MODEL)),
        "ffn_w_up": dense(ks[15], (DEPTH, D_MODEL, 2 * FFN_HIDDEN), D_MODEL),
        "ffn_conv_w": dense(ks[16], (DEPTH, CONV_WIDTH, 2 * FFN_HIDDEN), CONV_WIDTH),
        "ffn_conv_b": small(ks[17], (DEPTH, 2 * FFN_HIDDEN)),
        "ffn_w_down": dense(ks[18], (DEPTH, FFN_HIDDEN, D_MODEL), FFN_HIDDEN),
    }


def reference(x, mix_norm, ab_w_in, ab_sp_w, ab_sp_b, ab_v_norm, hgrn_gamma, hgrn_o_norm,
              ab_w_out, c_w_in, c_b_f, c_q_norm, c_k_norm, c_w_out, ffn_norm, ffn_w_up,
              ffn_conv_w, ffn_conv_b, ffn_w_down):
    lb_table = jnp.cumsum(jax.nn.softmax(hgrn_gamma.astype(jnp.float32), axis=0), axis=0)
    for l in range(DEPTH):
        j = l // 2
        h = rms_norm(x, mix_norm[l])
        if l % 2 == 0:
            h = mixer_ab(h, ab_w_in[j], ab_sp_w[j], ab_sp_b[j], ab_v_norm[j],
                         lb_table[l], hgrn_o_norm[j], ab_w_out[j])
        else:
            h = mixer_c(h, c_w_in[j], c_b_f[j], c_q_norm[j], c_k_norm[j], c_w_out[j])
        x = x + h
        h = rms_norm(x, ffn_norm[l])
        x = x + conv_ffn(h, ffn_w_up[l], ffn_conv_w[l], ffn_conv_b[l], ffn_w_down[l])
    return x
```

```cpp
#include <hip/hip_runtime.h>
#include <hip/hip_bf16.h>
#include <hip/hip_cooperative_groups.h>
#include <cstdio>
#include <cstdint>
#include <cmath>
namespace cg = cooperative_groups;
namespace pg8 {
#define PG8_LAS __attribute__((address_space(3)))
typedef unsigned short bf16_t;
typedef short bf16x8 __attribute__((ext_vector_type(8)));
typedef float f32x4 __attribute__((ext_vector_type(4)));
typedef unsigned u32x4 __attribute__((ext_vector_type(4)));
constexpr int BM = 256, BK = 64, HALF = 128, HTB = HALF * BK * 2  , STAGE_BYTES = 8 * HTB, NXCD = 8, WGM = 8;

__host__ __device__ __forceinline__ int lds_byte(int r, int c) { const int st = (r >> 4) * 2 + (c >> 5), rr = r & 15, cc = c & 31, ob = rr * 64 + cc * 2; return st * 1024 + (ob ^ (((ob >> 9) & 1) << 5)); }
__host__ __device__ __forceinline__ void stage_rc(int b, int& R, int& C) { const int st = b / 1024, sb = b % 1024, swz = sb ^ (((sb >> 9) & 1) << 5); R = (st >> 1) * 16 + swz / 64; C = (st & 1) * 32 + (swz % 64) / 2; }
__host__ __device__ __forceinline__ int perm32(int rho) { const int n = rho >> 4, i = rho & 15; return 8 * (i >> 2) + 4 * n + (i & 3); }

struct Unit { int pm, pn; };
struct Gemm { const bf16_t* A; const bf16_t* Bt; int M, N, K; };

struct StaticOrder {
    int nM, nN, nwg, G, c;
    __host__ __device__ void init(int M, int N, int G_, int c_) { nM = M / BM; nN = N / BM; nwg = nM * nN; G = G_; c = c_; }
    __host__ __device__ bool next(int i, Unit& u) const {
        const long L = (long)i * G + c; if (L >= nwg) return false;
        int wgid = (int)L; { const int q = nwg / NXCD, r = nwg % NXCD, xcd = wgid % NXCD, off = wgid / NXCD; wgid = (xcd < r ? xcd * (q + 1) : r * (q + 1) + (xcd - r) * q) + off; }
        const int nig = WGM * nN, gid = wgid / nig, fm = gid * WGM, gsz = (nM - fm) < WGM ? (nM - fm) : WGM;
        u.pm = fm + ((wgid % nig) % gsz); u.pn = (wgid % nig) / gsz; return true;
    }
    __device__ __forceinline__ void a_ready(const Unit&) const {}
    __device__ __forceinline__ void done(const Unit&) const {}
};

__device__ __forceinline__ unsigned cvt_pk_bf16(float lo, float hi) { unsigned r; asm volatile("v_cvt_pk_bf16_f32 %0, %1, %2" : "=v"(r) : "v"(lo), "v"(hi)); return r; }
typedef float f32x2 __attribute__((ext_vector_type(2)));
__device__ __forceinline__ f32x2 gelu_pk(f32x2 v) {
    const f32x2 av = __builtin_elementwise_abs(v), d = av * 0.2316418882f + 1.0f;
    f32x2 t; t.x = __builtin_amdgcn_rcpf(d.x); t.y = __builtin_amdgcn_rcpf(d.y);
    f32x2 q = t * 0.5307027145f + (-0.7265760135f); q = q * t + 0.7107068705f; q = q * t + (-0.142248368f); q = q * t + 0.127414796f; q = q * t;
    const f32x2 s = (v * v) * (-0.72134752044f);
    f32x2 e; e.x = __builtin_amdgcn_exp2f(s.x); e.y = __builtin_amdgcn_exp2f(s.y);
    const f32x2 m = v * (q * e), r = v - m;
    f32x2 o; o.x = v.x < 0.f ? m.x : r.x; o.y = v.y < 0.f ? m.y : r.y; return o;
}

template <int ACT  > struct EpiBf16 {
    static constexpr bool PERM = true, AFTER_DRAIN = false; static_assert(ACT == 0 || ACT == 1, "EpiBf16: ACT is 0 (none) or 1 (gelu_pk)");
    bf16_t* O; int ldc; const float* bias; int split_cols; size_t split_stride; float scale0;
    __device__ __forceinline__ void operator()(const f32x4 (&acc)[2][2][4][2], const Unit& u, int wr, int wc, int fr, int fq) const {
        const int row0 = u.pm * BM + wr * 64 + fr; int colt = u.pn * BM; bf16_t* base = O;
        float sc = 1.f; if (split_cols) { const int t = colt / split_cols; base += (size_t)t * split_stride; colt -= t * split_cols; if (t == 0) sc = scale0; }
        const int col0 = colt + wc * 32 + 8 * fq, bcol0 = u.pn * BM + wc * 32 + 8 * fq;
        f32x4 bv[2][2];
#pragma unroll
        for (int bj = 0; bj < 2; ++bj)
#pragma unroll
            for (int n = 0; n < 2; ++n) bv[bj][n] = bias ? *(const f32x4*)(bias + bcol0 + bj * HALF + 4 * n) : (f32x4){0.f, 0.f, 0.f, 0.f};
#pragma unroll
        for (int ai = 0; ai < 2; ++ai)
#pragma unroll
            for (int m = 0; m < 4; ++m) { bf16_t* rowp = base + (size_t)(row0 + ai * HALF + m * 16) * ldc + col0;
#pragma unroll
                for (int bj = 0; bj < 2; ++bj) { f32x4 v0 = acc[ai][bj][m][0] + bv[bj][0], v1 = acc[ai][bj][m][1] + bv[bj][1];
                    if (ACT == 1) { f32x2 a = gelu_pk((f32x2){v0[0], v0[1]}), b = gelu_pk((f32x2){v0[2], v0[3]}), c = gelu_pk((f32x2){v1[0], v1[1]}), d = gelu_pk((f32x2){v1[2], v1[3]});
                        v0 = (f32x4){a.x, a.y, b.x, b.y}; v1 = (f32x4){c.x, c.y, d.x, d.y}; }
                    v0 = v0 * sc; v1 = v1 * sc; u32x4 w; w.x = cvt_pk_bf16(v0[0], v0[1]); w.y = cvt_pk_bf16(v0[2], v0[3]); w.z = cvt_pk_bf16(v1[0], v1[1]); w.w = cvt_pk_bf16(v1[2], v1[3]);
                    *(u32x4*)(rowp + bj * HALF) = w; } }
    }
};
struct EpiResF32 {
    static constexpr bool PERM = false, AFTER_DRAIN = false;
    const float* res; float* out; int ldc;
    __device__ __forceinline__ void operator()(const f32x4 (&acc)[2][2][4][2], const Unit& u, int wr, int wc, int fr, int fq) const {
        const int col0 = u.pn * BM + wc * 32 + 4 * fq;
#pragma unroll
        for (int ai = 0; ai < 2; ++ai)
#pragma unroll
            for (int m = 0; m < 4; ++m) { const size_t off = (size_t)(u.pm * BM + ai * HALF + wr * 64 + m * 16 + fr) * ldc + col0;
#pragma unroll
                for (int bj = 0; bj < 2; ++bj)
#pragma unroll
                    for (int n = 0; n < 2; ++n) { const f32x4 bs = *(const f32x4*)(res + off + bj * HALF + n * 16); *(f32x4*)(out + off + bj * HALF + n * 16) = bs + acc[ai][bj][m][n]; } }
    }
};
struct EpiCin {
    static constexpr bool PERM = true, AFTER_DRAIN = false;
    bf16_t* O; const float* qg; const float* kg; PG8_LAS float* X;
    __device__ __forceinline__ void operator()(const f32x4 (&acc)[2][2][4][2], const Unit& u, int wr, int wc, int fr, int fq) const {
        const int sec = u.pn >> 3, h0 = (u.pn & 7) * 2, b = u.pm >> 4, s0 = (u.pm & 15) * BM + wr * 64 + fr;
        bf16_t* base = O + (size_t)sec * ((size_t)16384 * 2048) + ((size_t)(b * 16 + h0) * 4096) * 128 + wc * 32 + 8 * fq;
        const bool nrm = sec < 2;
        f32x4 g0 = (f32x4){1.f, 1.f, 1.f, 1.f}, g1 = g0;
        if (nrm) {
            const float* gp = (sec ? kg : qg) + wc * 32 + 8 * fq; g0 = *(const f32x4*)gp; g1 = *(const f32x4*)(gp + 4);
#pragma unroll
            for (int ai = 0; ai < 2; ++ai)
#pragma unroll
                for (int m = 0; m < 4; ++m)
#pragma unroll
                    for (int bj = 0; bj < 2; ++bj) { const f32x4 v0 = acc[ai][bj][m][0], v1 = acc[ai][bj][m][1];
                        float ss = ((v0[0] * v0[0] + v0[1] * v0[1]) + (v0[2] * v0[2] + v0[3] * v0[3])) + ((v1[0] * v1[0] + v1[1] * v1[1]) + (v1[2] * v1[2] + v1[3] * v1[3]));
                        ss += __shfl_xor(ss, 16); ss += __shfl_xor(ss, 32);
                        if (fq == 0) X[((ai * HALF + wr * 64 + m * 16 + fr) * 2 + bj) * 4 + wc] = ss; }
            asm volatile("s_waitcnt lgkmcnt(0)" ::: "memory"); __builtin_amdgcn_s_barrier(); asm volatile("" ::: "memory");
        }
#pragma unroll
        for (int ai = 0; ai < 2; ++ai)
#pragma unroll
            for (int m = 0; m < 4; ++m) { bf16_t* rowp = base + (size_t)(s0 + ai * HALF + m * 16) * 128;
#pragma unroll
                for (int bj = 0; bj < 2; ++bj) { f32x4 v0 = acc[ai][bj][m][0], v1 = acc[ai][bj][m][1];
                    if (nrm) { const f32x4 pp = *(const PG8_LAS f32x4*)(X + ((ai * HALF + wr * 64 + m * 16 + fr) * 2 + bj) * 4);
                        const float r = __builtin_amdgcn_rsqf(((pp[0] + pp[1]) + (pp[2] + pp[3])) * (1.0f / 128.0f) + 1e-6f); v0 = v0 * r * g0; v1 = v1 * r * g1; }
                    u32x4 w; w.x = cvt_pk_bf16(v0[0], v0[1]); w.y = cvt_pk_bf16(v0[2], v0[3]); w.z = cvt_pk_bf16(v1[0], v1[1]); w.w = cvt_pk_bf16(v1[2], v1[3]);
                    *(u32x4*)(rowp + (size_t)bj * 4096 * 128) = w; } }
    }
};
__device__ __forceinline__ float dpp_ror1(float v) { return __builtin_bit_cast(float, __builtin_amdgcn_update_dpp(0, __builtin_bit_cast(int, v), 0x121, 0xF, 0xF, false)); }
__device__ __forceinline__ float dpp_ror2(float v) { return __builtin_bit_cast(float, __builtin_amdgcn_update_dpp(0, __builtin_bit_cast(int, v), 0x122, 0xF, 0xF, false)); }
struct EpiConvGate {
    static constexpr bool PERM = true, AFTER_DRAIN = false;
    bf16_t* GA; float* HALO; const float* cw; const float* cb;
    __device__ __forceinline__ void operator()(const f32x4 (&acc)[2][2][4][2], const Unit& u, int wr, int wc, int fr, int fq) const {
        constexpr int F2 = 11264, FH = 5632;
        const int cl = wc * 32 + 8 * fq, ca = u.pn * 128 + cl, ct = u.pn * 256 + cl;
        const bool f1 = fr >= 1, f2 = fr >= 2;
#pragma unroll
        for (int n = 0; n < 2; ++n) {
            const f32x4 wa0 = *(const f32x4*)(cw + ca + 4 * n), wa1 = *(const f32x4*)(cw + F2 + ca + 4 * n), wa2 = *(const f32x4*)(cw + 2 * F2 + ca + 4 * n), ba = *(const f32x4*)(cb + ca + 4 * n);
            const f32x4 wb0 = *(const f32x4*)(cw + FH + ca + 4 * n), wb1 = *(const f32x4*)(cw + F2 + FH + ca + 4 * n), wb2 = *(const f32x4*)(cw + 2 * F2 + FH + ca + 4 * n), bb = *(const f32x4*)(cb + FH + ca + 4 * n);
#pragma unroll
            for (int ai = 0; ai < 2; ++ai) {
                const int grp = u.pm * 4 + ai * 2 + wr;
                f32x4 pa1 = (f32x4){0.f, 0.f, 0.f, 0.f}, pa2 = pa1, pb1 = pa1, pb2 = pa1;
#pragma unroll
                for (int m = 0; m < 4; ++m) {
                    const f32x4 za = acc[ai][0][m][n], zb = acc[ai][1][m][n];
                    f32x4 ra1, ra2, rb1, rb2;
#pragma unroll
                    for (int i = 0; i < 4; ++i) { ra1[i] = dpp_ror1(za[i]); ra2[i] = dpp_ror2(za[i]); rb1[i] = dpp_ror1(zb[i]); rb2[i] = dpp_ror2(zb[i]); }
                    f32x4 a, b;
#pragma unroll
                    for (int i = 0; i < 4; ++i) { const float a1 = f1 ? ra1[i] : pa1[i], a2 = f2 ? ra2[i] : pa2[i], b1 = f1 ? rb1[i] : pb1[i], b2 = f2 ? rb2[i] : pb2[i];
                        a[i] = ba[i] + wa0[i] * a2 + wa1[i] * a1 + wa2[i] * za[i]; b[i] = bb[i] + wb0[i] * b2 + wb1[i] * b1 + wb2[i] * zb[i]; }
                    pa1 = ra1; pa2 = ra2; pb1 = rb1; pb2 = rb2;
                    float g[4];
#pragma unroll
                    for (int i = 0; i < 4; ++i) g[i] = a[i] * __builtin_amdgcn_rcpf(1.0f + __expf(-a[i])) * b[i];
                    const size_t row = (size_t)grp * 64 + m * 16 + fr;
                    unsigned long long w = (unsigned long long)cvt_pk_bf16(g[0], g[1]) | ((unsigned long long)cvt_pk_bf16(g[2], g[3]) << 32);
                    *(unsigned long long*)(GA + row * FH + ca + 4 * n) = w;
                    if (m == 0 && fr < 2) { float* hp = HALO + ((size_t)grp * 4 + fr) * F2 + ct + 4 * n; *(f32x4*)hp = za; *(f32x4*)(hp + 128) = zb; }
                    if (m == 3 && fr >= 14) { float* hp = HALO + ((size_t)grp * 4 + (fr - 12)) * F2 + ct + 4 * n; *(f32x4*)hp = za; *(f32x4*)(hp + 128) = zb; }
                }
            }
        }
    }
};
template <class Epi, class Sched, bool ALIGN_EPI = false, bool SP2 = false>
__device__ __forceinline__ void gemm_phase(PG8_LAS unsigned char* lds, const Gemm g, const Sched& S, const Epi& E) {
    int tid_l = threadIdx.x; asm volatile("" : "+v"(tid_l)); const int tid = tid_l, wid = __builtin_amdgcn_readfirstlane(tid >> 6), lane = tid & 63, wr = wid >> 2, wc = wid & 3, fr = lane & 15, fq = lane >> 4;
    const int K = g.K, nt = K / BK;
    unsigned voffA[2], voffB[2];
#pragma unroll
    for (int i = 0; i < 2; ++i) { int R, C; stage_rc(tid * 16 + i * 8192, R, C); const int Rb = Epi::PERM ? ((R & ~31) + perm32(R & 31)) : R;
        voffA[i] = (unsigned)(R * K + C) * 2u; voffB[i] = (unsigned)(Rb * K + C) * 2u; }
    const size_t kstep = (size_t)(BK * 2);
    const size_t hstep = (size_t)HALF * K * 2;
    const size_t tstep = 2 * hstep;
    const unsigned ldsw = (unsigned)wid * 1024u;
    const int aoff = lds_byte(wr * 64 + fr, fq * 8), boff = lds_byte(wc * 32 + fr, fq * 8);
#define PG8_SA(b, h) (((b) * 2 + (h)) * HTB)
#define PG8_SB(b, h) ((4 + (b) * 2 + (h)) * HTB)
#define PG8_STAGE(bufoff, gbase, voff) do { _Pragma("unroll") for (int _i = 0; _i < 2; ++_i) \
        __builtin_amdgcn_global_load_lds((const unsigned*)((const char*)(gbase) + (voff)[_i]), (PG8_LAS unsigned*)(lds + (bufoff) + ldsw + _i * 8192), 16, 0, 0); } while (0)
#define PG8_LDA(dst, b, h) do { _Pragma("unroll") for (int m = 0; m < 4; ++m) _Pragma("unroll") for (int k = 0; k < 2; ++k) dst[m][k] = *(const PG8_LAS bf16x8*)(lds + PG8_SA(b, h) + aoff + m * 2048 + k * 1024); } while (0)
#define PG8_LDB(dst, b, h) do { _Pragma("unroll") for (int n = 0; n < 2; ++n) _Pragma("unroll") for (int k = 0; k < 2; ++k) dst[n][k] = *(const PG8_LAS bf16x8*)(lds + PG8_SB(b, h) + boff + n * 2048 + k * 1024); } while (0)
#define PG8_MMA(ai, bj, At, Bt) do { __builtin_amdgcn_s_setprio(1); _Pragma("unroll") for (int m = 0; m < 4; ++m) _Pragma("unroll") for (int n = 0; n < 2; ++n) _Pragma("unroll") for (int k = 0; k < 2; ++k) \
        acc[ai][bj][m][n] = __builtin_amdgcn_mfma_f32_16x16x32_bf16(Bt[n][k], At[m][k], acc[ai][bj][m][n], 0, 0, 0); __builtin_amdgcn_s_setprio(0); } while (0)
#define PG8_WAIT_V(n) asm volatile("s_waitcnt vmcnt(" #n ")" ::: "memory")
#define PG8_WAIT_L(n) asm volatile("s_waitcnt lgkmcnt(" #n ")" ::: "memory")
#define PG8_BAR __builtin_amdgcn_s_barrier()
#define PG8_SCHED __builtin_amdgcn_sched_barrier(0)
    Unit cur, nxt; int ui = 0;
    if (!S.next(0, cur)) return;
    f32x4 acc[2][2][4][2];
#pragma unroll
    for (int a = 0; a < 2; ++a)
#pragma unroll
        for (int b = 0; b < 2; ++b)
#pragma unroll
            for (int m = 0; m < 4; ++m)
#pragma unroll
                for (int n = 0; n < 2; ++n) acc[a][b][m][n] = (f32x4){0.f, 0.f, 0.f, 0.f};
    bf16x8 At[4][2], B0[2][2], B1[2][2];
    const char* cA = (const char*)g.A + (size_t)cur.pm * tstep; const char* cB = (const char*)g.Bt + (size_t)cur.pn * tstep;
    S.a_ready(cur);
    if constexpr (SP2) {
        PG8_STAGE(PG8_SB(0, 0), cB, voffB); PG8_STAGE(PG8_SB(0, 1), cB + hstep, voffB); PG8_STAGE(PG8_SA(0, 0), cA, voffA); PG8_STAGE(PG8_SA(0, 1), cA + hstep, voffA);
        if (wr == 1) PG8_BAR;
        PG8_WAIT_V(2); PG8_BAR;
        PG8_STAGE(PG8_SB(1, 0), cB + kstep, voffB); PG8_STAGE(PG8_SA(1, 0), cA + kstep, voffA); PG8_STAGE(PG8_SB(1, 1), cB + hstep + kstep, voffB);
        PG8_WAIT_V(6); PG8_BAR;
    } else {
        PG8_STAGE(PG8_SB(0, 0), cB, voffB); PG8_STAGE(PG8_SA(0, 0), cA, voffA); PG8_STAGE(PG8_SB(0, 1), cB + hstep, voffB); PG8_STAGE(PG8_SA(0, 1), cA + hstep, voffA);
        if (wr == 1) PG8_BAR;
        PG8_WAIT_V(4); PG8_BAR;
        PG8_STAGE(PG8_SB(1, 0), cB + kstep, voffB); PG8_STAGE(PG8_SA(1, 0), cA + kstep, voffA); PG8_STAGE(PG8_SB(1, 1), cB + hstep + kstep, voffB);
        PG8_WAIT_V(6); PG8_BAR;
    }
    for (;;) {
        const bool has_next = S.next(ui + 1, nxt);
        const char* nA = has_next ? (const char*)g.A + (size_t)nxt.pm * tstep : cA; const char* nB = has_next ? (const char*)g.Bt + (size_t)nxt.pn * tstep : cB;
        for (int t = 0; t < nt; t += 2) {
            const bool last = (t == nt - 2);
            const char* a1 = cA + (size_t)(t + 1) * kstep;
            const char* a2 = last ? nA : cA + (size_t)(t + 2) * kstep; const char* b2 = last ? nB : cB + (size_t)(t + 2) * kstep;
            const char* a3 = a2 + kstep; const char* b3 = b2 + kstep;
            if (last && has_next) S.a_ready(nxt);
            if constexpr (SP2) {
            PG8_LDB(B0, 0, 0); PG8_LDB(B1, 0, 1); PG8_SCHED; PG8_LDA(At, 0, 0); PG8_STAGE(PG8_SA(1, 1), a1 + hstep, voffA);
            PG8_WAIT_V(8); PG8_WAIT_L(0); PG8_BAR; PG8_MMA(0, 0, At, B0); PG8_MMA(0, 1, At, B1); PG8_BAR; PG8_SCHED;
            PG8_LDA(At, 0, 1); PG8_STAGE(PG8_SB(0, 0), b2, voffB); PG8_STAGE(PG8_SB(0, 1), b2 + hstep, voffB); PG8_STAGE(PG8_SA(0, 0), a2, voffA);
            PG8_WAIT_V(8); PG8_WAIT_L(0); PG8_BAR; PG8_MMA(1, 0, At, B0); PG8_MMA(1, 1, At, B1); PG8_BAR; PG8_SCHED;
            PG8_LDB(B0, 1, 0); PG8_LDB(B1, 1, 1); PG8_SCHED; PG8_LDA(At, 1, 0); PG8_STAGE(PG8_SA(0, 1), a2 + hstep, voffA);
            PG8_WAIT_V(8); PG8_WAIT_L(0); PG8_BAR; PG8_MMA(0, 0, At, B0); PG8_MMA(0, 1, At, B1); PG8_BAR; PG8_SCHED;
            PG8_LDA(At, 1, 1); PG8_STAGE(PG8_SB(1, 0), b3, voffB); PG8_STAGE(PG8_SB(1, 1), b3 + hstep, voffB); PG8_STAGE(PG8_SA(1, 0), a3, voffA);
            PG8_WAIT_V(8); PG8_WAIT_L(0); PG8_BAR; PG8_MMA(1, 0, At, B0); PG8_MMA(1, 1, At, B1); PG8_BAR; PG8_SCHED;
            } else {
            PG8_LDB(B0, 0, 0); PG8_SCHED; PG8_LDA(At, 0, 0); PG8_STAGE(PG8_SA(1, 1), a1 + hstep, voffA);
            PG8_WAIT_L(8); PG8_BAR; PG8_WAIT_L(0); PG8_MMA(0, 0, At, B0); PG8_BAR; PG8_SCHED;
            PG8_LDB(B1, 0, 1); PG8_STAGE(PG8_SB(0, 0), b2, voffB);
            PG8_BAR; PG8_WAIT_L(0); PG8_MMA(0, 1, At, B1); PG8_BAR;
            PG8_LDA(At, 0, 1); PG8_STAGE(PG8_SA(0, 0), a2, voffA);
            PG8_BAR; PG8_WAIT_L(0); PG8_MMA(1, 0, At, B0); PG8_BAR; PG8_SCHED;
            PG8_STAGE(PG8_SB(0, 1), b2 + hstep, voffB);
            PG8_WAIT_V(6); PG8_BAR; PG8_MMA(1, 1, At, B1); PG8_BAR;
            PG8_LDB(B0, 1, 0); PG8_SCHED; PG8_LDA(At, 1, 0); PG8_STAGE(PG8_SA(0, 1), a2 + hstep, voffA);
            PG8_WAIT_L(8); PG8_BAR; PG8_WAIT_L(0); PG8_MMA(0, 0, At, B0); PG8_BAR; PG8_SCHED;
            PG8_LDB(B1, 1, 1); PG8_STAGE(PG8_SB(1, 0), b3, voffB);
            PG8_BAR; PG8_WAIT_L(0); PG8_MMA(0, 1, At, B1); PG8_BAR;
            PG8_LDA(At, 1, 1); PG8_STAGE(PG8_SA(1, 0), a3, voffA);
            PG8_BAR; PG8_WAIT_L(0); PG8_MMA(1, 0, At, B0); PG8_BAR; PG8_SCHED;
            PG8_STAGE(PG8_SB(1, 1), b3 + hstep, voffB);
            PG8_WAIT_V(6); PG8_BAR; PG8_MMA(1, 1, At, B1); PG8_BAR;
            }
        }
        if constexpr (ALIGN_EPI) { if (wr == 0) PG8_BAR; }
        if constexpr (!Epi::AFTER_DRAIN) { E(acc, cur, wr, wc, fr, fq); S.done(cur); }
        if (!has_next) break;
#pragma unroll
        for (int a = 0; a < 2; ++a)
#pragma unroll
            for (int b = 0; b < 2; ++b)
#pragma unroll
                for (int m = 0; m < 4; ++m)
#pragma unroll
                    for (int n = 0; n < 2; ++n) acc[a][b][m][n] = (f32x4){0.f, 0.f, 0.f, 0.f};
        cur = nxt; cA = nA; cB = nB; ++ui;
        if constexpr (ALIGN_EPI) { if (wr == 1) PG8_BAR; }
    }
    PG8_WAIT_V(0);
    if constexpr (!ALIGN_EPI) { if (wr == 0) PG8_BAR; }
    PG8_BAR;
    if constexpr (Epi::AFTER_DRAIN) { E.fused(acc, cur, wr, wc, fr, fq, lds, wid, lane); S.done(cur); }
#undef PG8_SA
#undef PG8_SB
#undef PG8_STAGE
#undef PG8_LDA
#undef PG8_LDB
#undef PG8_MMA
#undef PG8_WAIT_V
#undef PG8_WAIT_L
#undef PG8_BAR
#undef PG8_SCHED
}
}
namespace fox {
constexpr int D = 128, PQ = 128, PO = 2048;
constexpr float THR = 8.f; constexpr bool WSKIP = false;
constexpr float SCALE = 0.08838834764831845f;
constexpr int NW = 8, QBLK = 32, KVBLK = 64, QB = NW * QBLK;
constexpr int SHM_V = KVBLK * D * 2, SHM_K = KVBLK * D * 2;
constexpr int LDS_CB = 2 * SHM_V + 2 * SHM_K + NW * 64 * 4;
constexpr int LDS_BYTES = LDS_CB + 4096 * 4;

using bf16 = __hip_bfloat16;
typedef short bf16x8 __attribute__((ext_vector_type(8)));
typedef short s16x4 __attribute__((ext_vector_type(4)));
typedef float f32x16 __attribute__((ext_vector_type(16)));
typedef float f32x4 __attribute__((ext_vector_type(4)));
typedef unsigned u32x4 __attribute__((ext_vector_type(4)));
template <class A, class Bt> struct same_t { static constexpr bool v = false; };
template <class A> struct same_t<A, A> { static constexpr bool v = true; };

#define KSWZ(row, colB) ((row) * 256 + ((colB) ^ (((row) & 7) << 4)))
#define SBAR() __builtin_amdgcn_sched_barrier(0)
__device__ __forceinline__ int v_st(int k, int c) { const int kk = (k & ~0xC) | ((k & 4) << 1) | ((k & 8) >> 1); return ((kk >> 3) * 4 + (c >> 5)) * 512 + ((kk & 7) * 32 + (c & 31)) * 2; }
__device__ __forceinline__ int v_rd_base(int lane) { return ((lane & 3) << 3) | (((lane >> 2) & 3) << 6) | (((lane >> 4) & 1) << 5) | (((lane >> 5) & 1) << 8); }
constexpr int v_rd_off(int d0, int ks, int half) { return d0 * 512 + ks * 4096 + half * 2048; }
__device__ __forceinline__ int crow(int r, int hi) { return (r & 3) + 8 * (r >> 2) + 4 * hi; }
__device__ __forceinline__ unsigned cvtpk(float lo, float hi) {
    unsigned r; asm volatile("v_cvt_pk_bf16_f32 %0, %1, %2" : "=v"(r) : "v"(lo), "v"(hi)); return r;
}
__device__ __forceinline__ bf16x8 pack8(f32x4 a, f32x4 b) {
    u32x4 w = {cvtpk(a[0], a[1]), cvtpk(a[2], a[3]), cvtpk(b[0], b[1]), cvtpk(b[2], b[3])};
    return *reinterpret_cast<bf16x8*>(&w);
}
template <class T> __device__ __forceinline__ bf16x8 load8(const T* p) {
    if constexpr (same_t<T, float>::v) { return pack8(*(const f32x4*)p, *(const f32x4*)(p + 4)); }
    else { return *reinterpret_cast<const bf16x8*>(p); }
}
__device__ __forceinline__ void mask_tile(f32x16& p0, f32x16& p1, int dq, unsigned W) {
    const float NEG = -__builtin_inff();
#pragma unroll
    for (int r = 0; r < 16; ++r) {
        const int c = (r & 3) + 8 * (r >> 2);
        if ((unsigned)(dq - c) >= W) p0[r] = NEG;
        if ((unsigned)(dq - c - 32) >= W) p1[r] = NEG;
    }
}
__device__ __forceinline__ void partialSM(f32x16& p0, f32x16& p1, float& m_reg, float& mn, float& alpha) {
    float pmax = p0[0]; for (int r = 1; r < 16; ++r) pmax = fmaxf(pmax, p0[r]); for (int r = 0; r < 16; ++r) pmax = fmaxf(pmax, p1[r]);
    { auto rr = __builtin_amdgcn_permlane32_swap(__float_as_uint(pmax), __float_as_uint(pmax), false, false);
      pmax = fmaxf(__uint_as_float(rr[0]), __uint_as_float(rr[1])); }
    constexpr float C2 = 1.4426950408889634f * SCALE;
    if (__builtin_expect(__all((pmax - m_reg) * SCALE <= THR), 1)) { mn = m_reg; alpha = 1.f; }
    else { mn = fmaxf(m_reg, pmax); alpha = __builtin_amdgcn_exp2f((m_reg - mn) * C2); m_reg = mn; }
    const float mnL = -mn * C2;
    for (int r = 0; r < 16; ++r) p0[r] = fmaf(p0[r], C2, mnL); for (int r = 0; r < 16; ++r) p1[r] = fmaf(p1[r], C2, mnL);
    for (int r = 0; r < 16; ++r) p0[r] = __builtin_amdgcn_exp2f(p0[r]);
}
__device__ __forceinline__ void finishSM(f32x16& p0, f32x16& p1, float alpha, float& l_reg, bf16x8& pa0, bf16x8& pa1, bf16x8& pa2, bf16x8& pa3) {
    for (int r = 0; r < 16; ++r) p1[r] = __builtin_amdgcn_exp2f(p1[r]);
    float ps = 0; for (int r = 0; r < 16; ++r) ps += p0[r]; for (int r = 0; r < 16; ++r) ps += p1[r];
    { auto rr = __builtin_amdgcn_permlane32_swap(__float_as_uint(ps), __float_as_uint(ps), false, false);
      ps = __uint_as_float(rr[0]) + __uint_as_float(rr[1]); }
    l_reg = l_reg * alpha + ps;
#define PK4(P, B_, OUT) do { unsigned a0 = cvtpk(P[B_+0], P[B_+1]), a1 = cvtpk(P[B_+2], P[B_+3]);                          \
        unsigned b0 = cvtpk(P[B_+4], P[B_+5]), b1 = cvtpk(P[B_+6], P[B_+7]);                                             \
        auto r0 = __builtin_amdgcn_permlane32_swap(a0, b0, false, false); auto r1 = __builtin_amdgcn_permlane32_swap(a1, b1, false, false); \
        u32x4 w = {r0[0], r1[0], r0[1], r1[1]}; OUT = *reinterpret_cast<bf16x8*>(&w); } while (0)
    PK4(p0, 0, pa0); PK4(p0, 8, pa1); PK4(p1, 0, pa2); PK4(p1, 8, pa3);
#undef PK4
}
__device__ __forceinline__ void bias_init(f32x16& p0, f32x16& p1, const float* cbt) {
#pragma unroll
    for (int g = 0; g < 4; ++g) { const f32x4 b0v = *(const f32x4*)(cbt + 8 * g), b1v = *(const f32x4*)(cbt + 32 + 8 * g);
        p0[4 * g] = b0v[0]; p0[4 * g + 1] = b0v[1]; p0[4 * g + 2] = b0v[2]; p0[4 * g + 3] = b0v[3];
        p1[4 * g] = b1v[0]; p1[4 * g + 1] = b1v[1]; p1[4 * g + 2] = b1v[2]; p1[4 * g + 3] = b1v[3]; }
}
template <int KB, bool SK>
__device__ __forceinline__ void qkt(f32x16& p0, f32x16& p1, const char* K_lds, int r32, int hi, const bf16x8* qr, bool act, const float* cbt) {
    if (SK && !act) { const float NEG = -__builtin_inff();
#pragma unroll
        for (int r = 0; r < 16; ++r) { p0[r] = NEG; p1[r] = NEG; } return; }
    (void)cbt;
    const char* kb[4];
#pragma unroll
    for (int dd = 0; dd < 4; ++dd) kb[dd] = K_lds + KB * SHM_K + KSWZ(r32, (dd * 16 + hi * 8) * 2);
#pragma unroll
    for (int d0 = 0; d0 < 8; ++d0) { const char* a = kb[d0 & 3] + (d0 >> 2) * 128;
        bf16x8 b0 = *reinterpret_cast<const bf16x8*>(a);
        bf16x8 b1 = *reinterpret_cast<const bf16x8*>(a + 32 * 256);
        p0 = __builtin_amdgcn_mfma_f32_32x32x16_bf16(b0, qr[d0], p0, 0, 0, 0);
        p1 = __builtin_amdgcn_mfma_f32_32x32x16_bf16(b1, qr[d0], p1, 0, 0, 0); }
}
template <int VB, bool SK>
__device__ __forceinline__ void pv_tile(f32x16* o, int vb0, bf16x8 pa0, bf16x8 pa1, bf16x8 pa2, bf16x8 pa3, bool act) {
    if (SK && !act) return;
#define TRRD(dst, off) asm volatile("ds_read_b64_tr_b16 %0, %1 offset:%2" : "=&v"(dst) : "v"(vb0), "i"(off) : "memory")
#define PV_D0(d0) do { s16x4 l0, l1, l2, l3, h0, h1, h2, h3; constexpr int b_ = VB * SHM_V + v_rd_off(d0, 0, 0);     \
        TRRD(l0, b_); TRRD(h0, b_ + 2048); TRRD(l1, b_ + 4096); TRRD(h1, b_ + 6144); TRRD(l2, b_ + 8192); TRRD(h2, b_ + 10240); TRRD(l3, b_ + 12288); TRRD(h3, b_ + 14336); \
        asm volatile("s_waitcnt lgkmcnt(0)" ::: "memory"); SBAR();                 \
        o[d0] = __builtin_amdgcn_mfma_f32_32x32x16_bf16(pa0, (bf16x8){l0[0], l0[1], l0[2], l0[3], h0[0], h0[1], h0[2], h0[3]}, o[d0], 0, 0, 0);   \
        o[d0] = __builtin_amdgcn_mfma_f32_32x32x16_bf16(pa1, (bf16x8){l1[0], l1[1], l1[2], l1[3], h1[0], h1[1], h1[2], h1[3]}, o[d0], 0, 0, 0);   \
        o[d0] = __builtin_amdgcn_mfma_f32_32x32x16_bf16(pa2, (bf16x8){l2[0], l2[1], l2[2], l2[3], h2[0], h2[1], h2[2], h2[3]}, o[d0], 0, 0, 0);   \
        o[d0] = __builtin_amdgcn_mfma_f32_32x32x16_bf16(pa3, (bf16x8){l3[0], l3[1], l3[2], l3[3], h3[0], h3[1], h3[2], h3[3]}, o[d0], 0, 0, 0); } while (0)
    PV_D0(0); PV_D0(1); PV_D0(2); PV_D0(3);
#undef PV_D0
#undef TRRD
}

__device__ __forceinline__ int fox_jlo(const float* cb, int P0, float margin) {
    const int lane = threadIdx.x & 63, nt0 = P0 / KVBLK;
    const float thr = cb[P0] + margin;
    bool dead = false; if (lane < nt0) dead = cb[KVBLK * lane + KVBLK - 1] > thr;
    const unsigned long long m = __ballot(dead);
    return __builtin_amdgcn_readfirstlane((int)__builtin_ctzll(~m));
}
template <class TIn, class TOut> struct BlockRef { const TIn* Q; const TIn* K; const TIn* V; TOut* O; int P0; const float* cb; const TIn* Gt; };
template <class TIn> struct Seam {
    bf16x8 qr[8];
    bf16x8 st_v0, st_v1, st_k0, st_k1; f32x4 sf0, sf1, sf2, sf3;
    f32x4 tq[16];
};
__device__ __forceinline__ int swa_jlo(int P0, int W) { const int lowk = P0 - W + 1; return lowk > 0 ? lowk / KVBLK : 0; }
#define ROW(p, k0, rr) ((p) + (size_t)((k0) + (rr)) * PQ + sc)
#define VMW() asm volatile("s_waitcnt vmcnt(0)" ::: "memory")
#define VMWN(n) asm volatile("s_waitcnt vmcnt(%0)" :: "i"(n) : "memory")
#define SLOAD_H(Kp, Vp, k0) do { S.st_v0 = load8<TIn>(ROW(Vp, k0, sr)); S.st_v1 = load8<TIn>(ROW(Vp, k0, 32 + sr));              \
                         S.st_k0 = load8<TIn>(ROW(Kp, k0, sr)); S.st_k1 = load8<TIn>(ROW(Kp, k0, 32 + sr)); } while (0)
#define SWRITE_HK(bf) do { *(bf16x8*)(K_lds + (bf) * SHM_K + kws) = S.st_k0; *(bf16x8*)(K_lds + (bf) * SHM_K + kws + 32 * 256) = S.st_k1; } while (0)
#define SWRITE_HV(bf) do { *(bf16x8*)(V_lds + (bf) * SHM_V + vst0) = S.st_v0; *(bf16x8*)(V_lds + (bf) * SHM_V + vst1) = S.st_v1; } while (0)
#define SWRITE_H(bf) do { SWRITE_HV(bf); SWRITE_HK(bf); } while (0)
#define SLOAD_F(p, k0) do { S.sf0 = *(const f32x4*)ROW(p, k0, sr); S.sf1 = *(const f32x4*)(ROW(p, k0, sr) + 4);                \
                            S.sf2 = *(const f32x4*)ROW(p, k0, 32 + sr); S.sf3 = *(const f32x4*)(ROW(p, k0, 32 + sr) + 4); } while (0)
#define SWRITE_KF(bf) do { *(bf16x8*)(K_lds + (bf) * SHM_K + kws) = pack8(S.sf0, S.sf1); *(bf16x8*)(K_lds + (bf) * SHM_K + kws + 32 * 256) = pack8(S.sf2, S.sf3); } while (0)
#define SWRITE_VF(bf) do { *(bf16x8*)(V_lds + (bf) * SHM_V + vst0) = pack8(S.sf0, S.sf1); *(bf16x8*)(V_lds + (bf) * SHM_V + vst1) = pack8(S.sf2, S.sf3); } while (0)
template <class TIn, class TOut>
__device__ __forceinline__ void causal_swa_prime(const BlockRef<TIn, TOut>& cur, int W, char* lds, Seam<TIn>& S) {
    constexpr bool F32 = same_t<TIn, float>::v;
    int tid_l = threadIdx.x; asm volatile("" : "+v"(tid_l)); const int tid = tid_l, wid = __builtin_amdgcn_readfirstlane(tid >> 6), lane = tid & 63, r32 = lane & 31, hi = lane >> 5;
    const int sr = tid >> 4, sc = (tid & 15) * 8, kws = KSWZ(sr, sc * 2); char* K_lds = lds + 2 * SHM_V;
    const int kb0 = swa_jlo(cur.P0, W) * KVBLK;
    for (int d0 = 0; d0 < 8; ++d0) S.qr[d0] = load8<TIn>(cur.Q + (size_t)(wid * QBLK + r32) * PQ + d0 * 16 + hi * 8);
    if constexpr (F32) { SLOAD_F((const float*)cur.K, kb0); VMW(); SWRITE_KF(0); SBAR(); SLOAD_F((const float*)cur.V, kb0); }
    else { SLOAD_H(cur.K, cur.V, kb0); VMW(); SWRITE_HK(0); }
    __syncthreads();
}
template <class TIn, class TOut>
__device__ __forceinline__ void causal_swa_block(const BlockRef<TIn, TOut>& cur, const BlockRef<TIn, TOut>& nxt, int skv, int W, char* lds, Seam<TIn>& S) {
    constexpr bool F32 = same_t<TIn, float>::v;
    int tid_l = threadIdx.x; asm volatile("" : "+v"(tid_l)); const int tid = tid_l, wid = __builtin_amdgcn_readfirstlane(tid >> 6), lane = tid & 63, r32 = lane & 31, hi = lane >> 5;
    const int j_lo = swa_jlo(cur.P0, W);
    int j_hi = (cur.P0 + QB - 1) / KVBLK + 1; if (j_hi > skv / KVBLK) j_hi = skv / KVBLK;
    const int NT = j_hi - j_lo;
    const int kbn = swa_jlo(nxt.P0, W) * KVBLK;
    const int qlo = cur.P0 + wid * QBLK, qm = qlo + r32 - 4 * hi;
    char* V_lds = lds; char* K_lds = lds + 2 * SHM_V;
    float* ws = (float*)(lds + 2 * SHM_V + 2 * SHM_K) + wid * 64; float* li_l = ws, * al_l = ws + 32;
    float m_reg = -1e30f, l_reg = 0; f32x16 o[4] = {};
    float* cbl = (float*)(lds + LDS_CB);
    { const float cref = cur.cb[cur.P0]; const float rs = 1.0f / SCALE;
      for (int i = tid; i < cur.P0 + QB; i += 64 * NW) cbl[i] = (cref - cur.cb[i]) * rs;
      __syncthreads(); }
    const float* cbh = cbl + 4 * hi;
    const int sr = tid >> 4, sc = (tid & 15) * 8, vst0 = v_st(sr, sc), vst1 = v_st(32 + sr, sc), kws = KSWZ(sr, sc * 2);
    const int vb0 = (int)(uintptr_t)V_lds + v_rd_base(lane);
    const TIn* Kh = cur.K; const TIn* Vh = cur.V;
#define RESC(a) do { if (__any((a) < 1.f)) { if (hi == 0) al_l[r32] = (a); asm volatile("s_waitcnt lgkmcnt(0)" ::: "memory");              \
                     for (int d_ = 0; d_ < 4; ++d_) for (int r = 0; r < 16; ++r) o[d_][r] *= al_l[crow(r, hi)]; } } while (0)
#define KBASE(t) ((j_lo + (t)) * KVBLK)
#define ACT(t) (KBASE(t) <= qlo + QBLK - 1 && KBASE(t) + KVBLK - 1 >= qlo - W + 1)
#define MASKT(P0_, P1_, t) do { const int kb_ = KBASE(t); if ((!SK || ACT(t)) && (kb_ + KVBLK - 1 > qlo || kb_ <= qlo + QBLK - 1 - W)) mask_tile(P0_, P1_, qm - kb_, (unsigned)W); } while (0)
    constexpr int NQL = F32 ? 16 : 8;
    constexpr bool SK = WSKIP && !F32;
#define SEAM_K0() do { VMWN(NQL); if constexpr (F32) { SWRITE_KF(0); SBAR(); SLOAD_F((const float*)nxt.V, kbn); } else { SWRITE_HK(0); } SBAR(); } while (0)
    f32x16 pA0, pA1, pB0, pB1; float mnA, mnB, alA, alB; bf16x8 pa0, pa1, pa2, pa3;
    if constexpr (F32) { VMW(); SWRITE_VF(0); SBAR(); } else { SWRITE_HV(0); SBAR(); }
    if (NT > 1) { if constexpr (F32) SLOAD_F((const float*)Kh, KBASE(1)); else SLOAD_H(Kh, Vh, KBASE(1)); }
    bias_init(pA0, pA1, cbh + KBASE(0)); if (NT > 1) bias_init(pB0, pB1, cbh + KBASE(1));
    SBAR(); qkt<0, SK>(pA0, pA1, K_lds, r32, hi, S.qr, ACT(0), cbh + KBASE(0));
    if constexpr (F32) { if (NT > 1) { VMW(); SWRITE_KF(1); SBAR(); SLOAD_F((const float*)Vh, KBASE(1)); } }
    MASKT(pA0, pA1, 0); partialSM(pA0, pA1, m_reg, mnA, alA);
    if (NT > 1) { VMW(); if constexpr (F32) { SWRITE_VF(1); SBAR(); if (NT > 2) SLOAD_F((const float*)Kh, KBASE(2)); } else SWRITE_H(1); }
    __syncthreads();
#define HALF_STEP(PX0, PX1, mnX, alX, PY0, PY1, alY, t, KB, VB, SB) do {                                                      \
        SBAR(); qkt<KB, SK>(PX0, PX1, K_lds, r32, hi, S.qr, ACT(t), cbh + KBASE(t));                             \
        finishSM(PY0, PY1, alY, l_reg, pa0, pa1, pa2, pa3); SBAR();                                                           \
        if ((t) + 1 < NT) bias_init(PY0, PY1, cbh + KBASE((t) + 1));                                                          \
        if ((t) + 1 < NT) { if constexpr (F32) { VMW(); SWRITE_KF(SB); SBAR(); SLOAD_F((const float*)Vh, KBASE((t) + 1)); }  \
                            else { SLOAD_H(Kh, Vh, KBASE((t) + 1)); } SBAR(); }                                               \
        pv_tile<VB, SK>(o, vb0, pa0, pa1, pa2, pa3, ACT((t) - 1)); MASKT(PX0, PX1, (t)); partialSM(PX0, PX1, m_reg, mnX, alX);                                        \
        __syncthreads();                                                                                                      \
        if ((t) + 1 < NT) { VMW(); if constexpr (F32) { SWRITE_VF(SB); SBAR(); if ((t) + 2 < NT) SLOAD_F((const float*)Kh, KBASE((t) + 2)); } \
                            else { SWRITE_H(SB); } }                                                                          \
        RESC(alX); __syncthreads(); } while (0)
    for (int t = 1; t + 1 < NT; t += 2) {
        HALF_STEP(pB0, pB1, mnB, alB, pA0, pA1, alA, t, 1, 0, 0);
        HALF_STEP(pA0, pA1, mnA, alA, pB0, pB1, alB, t + 1, 0, 1, 1);
    }
    const bool even = (NT & 1) == 0;
    if (even) { SBAR(); qkt<1, SK>(pB0, pB1, K_lds, r32, hi, S.qr, ACT(NT - 1), cbh + KBASE(NT - 1)); SBAR(); }
#define QROW(e) (nxt.Q + (size_t)(wid * QBLK + r32) * PQ + ((e) >> 1) * 16 + hi * 8 + ((e) & 1) * 4)
    if constexpr (F32) { SLOAD_F((const float*)nxt.K, kbn); SBAR();
#pragma unroll
        for (int e = 0; e < 8; ++e) S.tq[e] = *(const f32x4*)QROW(e); }
    else { SLOAD_H(nxt.K, nxt.V, kbn); SBAR();
#pragma unroll
        for (int d0 = 0; d0 < 8; ++d0) S.qr[d0] = load8<TIn>(nxt.Q + (size_t)(wid * QBLK + r32) * PQ + d0 * 16 + hi * 8); }
    SBAR();
    finishSM(pA0, pA1, alA, l_reg, pa0, pa1, pa2, pa3); SBAR();
    if constexpr (F32) {
#pragma unroll
        for (int e = 8; e < 16; ++e) S.tq[e] = *(const f32x4*)QROW(e); SBAR(); }
#undef QROW
    pv_tile<0, SK>(o, vb0, pa0, pa1, pa2, pa3, ACT(even ? NT - 2 : NT - 1));
    if (even) { MASKT(pB0, pB1, NT - 1); partialSM(pB0, pB1, m_reg, mnB, alB); __syncthreads(); RESC(alB);
        finishSM(pB0, pB1, alB, l_reg, pa0, pa1, pa2, pa3); SBAR(); pv_tile<1, SK>(o, vb0, pa0, pa1, pa2, pa3, ACT(NT - 1)); }
    SBAR(); SEAM_K0();
    if (hi == 0) li_l[r32] = l_reg; asm volatile("s_waitcnt lgkmcnt(0)" ::: "memory");
    float rli[16];
#pragma unroll
    for (int r = 0; r < 16; ++r) rli[r] = __builtin_amdgcn_rcpf(li_l[crow(r, hi)]);
    TOut* Ow = cur.O + (size_t)(wid * QBLK) * PO; const TIn* Gw = cur.Gt + (size_t)(wid * QBLK) * PQ;
#pragma unroll
    for (int r = 0; r < 16; ++r) { const int orow = crow(r, hi);
#pragma unroll
        for (int d0 = 0; d0 < 4; ++d0) { const float gv = (float)Gw[(size_t)orow * PQ + d0 * 32 + r32]; const float v = o[d0][r] * rli[r] * __builtin_amdgcn_rcpf(1.0f + __expf(-gv));
            if constexpr (same_t<TOut, float>::v) { Ow[(size_t)orow * PO + d0 * 32 + r32] = v; }
            else { const float vn = __shfl_xor(v, 1);
                   if ((r32 & 1) == 0) *(unsigned*)(Ow + (size_t)orow * PO + d0 * 32 + r32) = cvtpk(v, vn); } } }
    if constexpr (F32) {
#pragma unroll
        for (int d0 = 0; d0 < 8; ++d0) S.qr[d0] = pack8(S.tq[2 * d0], S.tq[2 * d0 + 1]); }
    __syncthreads();
#undef RESC
#undef KBASE
#undef ACT
#undef MASKT
#undef SEAM_K0
#undef HALF_STEP
}
#undef ROW
#undef VMW
#undef VMWN
#undef SLOAD_H
#undef SWRITE_HK
#undef SWRITE_HV
#undef SWRITE_H
#undef SLOAD_F
#undef SWRITE_KF
#undef SWRITE_VF

}
constexpr int NTOK = 16384, DMOD = 2048, SEQL = 4096, NBAT = 4;
constexpr int ABIN = 6144, FFH = 5632, FF2 = 11264, CINW = 8208, CINP = 8448;
constexpr float RMS_EPS = 1e-6f;
constexpr size_t WS_WABIN = 0;
constexpr size_t WS_WABOUT = WS_WABIN + (size_t)ABIN * DMOD * 2;
constexpr size_t WS_WCIN = WS_WABOUT + (size_t)DMOD * DMOD * 2;
constexpr size_t WS_WCOUT = WS_WCIN + (size_t)CINP * DMOD * 2;
constexpr size_t WS_WUP0 = WS_WCOUT + (size_t)DMOD * DMOD * 2;
constexpr size_t WS_WUP1 = WS_WUP0 + (size_t)FF2 * DMOD * 2;
constexpr size_t WS_WDN0 = WS_WUP1 + (size_t)FF2 * DMOD * 2;
constexpr size_t WS_WDN1 = WS_WDN0 + (size_t)DMOD * FFH * 2;
constexpr size_t WS_ACT = WS_WDN1 + (size_t)DMOD * FFH * 2;
constexpr size_t WS_BIG = WS_ACT + (size_t)NTOK * DMOD * 2;
constexpr size_t WS_Z1 = WS_BIG;
constexpr size_t WS_HL = WS_Z1 + (size_t)NTOK * ABIN * 2;
constexpr size_t WS_DEC = WS_HL + (size_t)32 * 64 * 128 * 128 * 2;
constexpr size_t WS_END_AB = WS_DEC + (size_t)32 * 64 * 128 * 4;
constexpr size_t WS_GA = WS_BIG;
constexpr size_t WS_HALO = WS_GA + (size_t)NTOK * FFH * 2;
constexpr size_t WS_END_FFN = WS_HALO + (size_t)256 * 4 * FF2 * 4;
constexpr size_t WS_QKVG = WS_BIG;
constexpr size_t WS_F = WS_QKVG + (size_t)NTOK * 8192 * 2;
constexpr size_t WS_C = WS_F + (size_t)2 * NTOK * 16 * 4;
constexpr size_t WS_END_C = WS_C + (size_t)64 * 4096 * 4;
constexpr size_t WS_NEED = WS_END_FFN > WS_END_AB ? (WS_END_FFN > WS_END_C ? WS_END_FFN : WS_END_C) : (WS_END_AB > WS_END_C ? WS_END_AB : WS_END_C);
constexpr size_t WS_BAR = (WS_NEED + 255) / 256 * 256;
constexpr size_t WS_TOTAL = WS_BAR + 16384;
constexpr int LDS_BYTES = 147456, LDS_MISC = LDS_BYTES - 128;
constexpr int LDS_BYTES_UNUSED = 0;

#define LAS __attribute__((address_space(3)))
typedef unsigned short bfu;
typedef unsigned v4u __attribute__((ext_vector_type(4)));
typedef float f32x4 __attribute__((ext_vector_type(4)));
typedef short bf16x8 __attribute__((ext_vector_type(8)));
#define LDS_WAIT() asm volatile("s_waitcnt lgkmcnt(0)" ::: "memory")
typedef float f32x2_t __attribute__((ext_vector_type(2))); typedef __bf16 bf16x2_t __attribute__((ext_vector_type(2)));
__device__ __forceinline__ unsigned pk2(float lo, float hi) { f32x2_t v = {lo, hi}; bf16x2_t b = __builtin_convertvector(v, bf16x2_t); return __builtin_bit_cast(unsigned, b); }
__device__ __forceinline__ unsigned f2bf(float f) { return pk2(f, 0.f) & 0xffffu; }
__device__ __forceinline__ float bf2f(unsigned h) { return __builtin_bit_cast(float, h << 16); }
__device__ __forceinline__ float bflo(unsigned w) { return __builtin_bit_cast(float, w << 16); }
__device__ __forceinline__ float bfhi(unsigned w) { return __builtin_bit_cast(float, w & 0xffff0000u); }
__device__ __forceinline__ float sigmoidf_(float x) { return __builtin_amdgcn_rcpf(1.0f + __expf(-x)); }
__device__ __forceinline__ float gelu_erf(float x) { return 0.5f * x * (1.0f + erff(x * 0.70710678118654752f)); }
__device__ __forceinline__ void gelu2(float& a, float& b) { const pg8::f32x2 r = pg8::gelu_pk((pg8::f32x2){a, b}); a = r.x; b = r.y; }
__device__ __forceinline__ float wave_sum(float v) {
#pragma unroll
    for (int o = 1; o < 64; o <<= 1) v += __shfl_xor(v, o);
    return v;
}
__device__ __forceinline__ bf16x8 pack8f(f32x4 a, f32x4 b) { v4u w = {pk2(a[0], a[1]), pk2(a[2], a[3]), pk2(b[0], b[1]), pk2(b[2], b[3])}; return __builtin_bit_cast(bf16x8, w); }
#define MFMA16(a, b, c) __builtin_amdgcn_mfma_f32_16x16x32_bf16((a), (b), (c), 0, 0, 0)

__device__ __forceinline__ void tr_item64(const float* W, int ldw, int K, bfu* WT, int nblk, int item, LAS float* scr, int lane, bool ab_remap = false) {
    const int kb = item / nblk, nb = item - kb * nblk, k0 = 64 * kb, n0 = 64 * nb;
    int d0 = n0; if (ab_remap) { const int bj = n0 >= FFH ? 1 : 0, rem = n0 - bj * FFH; d0 = (rem >> 7) * 256 + bj * 128 + (rem & 127); }
    const int q = lane & 15, kr = lane >> 4;
    f32x4 v[16];
#pragma unroll
    for (int i = 0; i < 16; ++i) v[i] = *(const f32x4*)(W + (size_t)(k0 + 4 * i + kr) * ldw + n0 + 4 * q);
#pragma unroll
    for (int i = 0; i < 16; ++i) { LAS float* s = scr + (4 * i + kr) * 65 + 4 * q; s[0] = v[i][0]; s[1] = v[i][1]; s[2] = v[i][2]; s[3] = v[i][3]; }
    LDS_WAIT(); asm volatile("" ::: "memory");
    const int c = lane & 7;
#pragma unroll
    for (int j = 0; j < 8; ++j) { const int n = (lane >> 3) + 8 * j; const LAS float* s = scr + (8 * c) * 65 + n;
        v4u o; o.x = pk2(s[0], s[65]); o.y = pk2(s[130], s[195]); o.z = pk2(s[260], s[325]); o.w = pk2(s[390], s[455]);
        *(v4u*)(WT + (size_t)(d0 + n) * K + k0 + 8 * c) = o; }
    LDS_WAIT(); asm volatile("" ::: "memory");
}
template <bool NT = false> __device__ __forceinline__ void rms_rows(const float* X, const float* gain, bfu* O, int gw, int NGW, int lane) {
    f32x4 gv[8];
#pragma unroll
    for (int j = 0; j < 8; ++j) gv[j] = ((const f32x4*)gain)[64 * j + lane];
    for (int m = gw; m < NTOK; m += NGW) {
        const f32x4* xr = (const f32x4*)(X + (size_t)m * DMOD) + lane;
        f32x4 v[8]; float s = 0.f;
#pragma unroll
        for (int j = 0; j < 8; ++j) { v[j] = NT ? __builtin_nontemporal_load(xr + 64 * j) : xr[64 * j]; s += (v[j][0] * v[j][0] + v[j][1] * v[j][1]) + (v[j][2] * v[j][2] + v[j][3] * v[j][3]); }
        const float r = rsqrtf(wave_sum(s) * (1.0f / DMOD) + RMS_EPS);
        unsigned long long* o8 = (unsigned long long*)(O + (size_t)m * DMOD) + lane;
#pragma unroll
        for (int j = 0; j < 8; ++j) { const f32x4 y = v[j] * r * gv[j]; o8[64 * j] = (unsigned long long)pk2(y[0], y[1]) | ((unsigned long long)pk2(y[2], y[3]) << 32); }
    }
}

__device__ __forceinline__ void gmlp_tile(int tile, const bfu* Z1, const float* spw, const float* spb, const float* vgain, bfu* Y, LAS unsigned char* lds, int tid, int wave, int lane) {
    const int h = tile & 7, bc = tile >> 3; const size_t tok0 = (size_t)bc * 128;
    LAS bfu* vnT = (LAS bfu*)lds;
    { const int s = tid >> 2, part = tid & 3;
      const bfu* src = Z1 + (tok0 + s) * ABIN + 1024 + h * 128 + 32 * part;
      v4u raw[4];
#pragma unroll
      for (int i = 0; i < 4; ++i) raw[i] = __builtin_nontemporal_load((const v4u*)src + i);
      float g[32]; float ss = 0.f;
#pragma unroll
      for (int i = 0; i < 4; ++i)
#pragma unroll
          for (int j = 0; j < 4; ++j) { float a = bflo(raw[i][j]), b = bfhi(raw[i][j]); gelu2(a, b); g[8 * i + 2 * j] = a; g[8 * i + 2 * j + 1] = b; ss += a * a + b * b; }
      ss += __shfl_xor(ss, 1); ss += __shfl_xor(ss, 2);
      const float r = rsqrtf(ss * (1.0f / 128.0f) + RMS_EPS);
      const float* gp = vgain + h * 128 + 32 * part;
#pragma unroll
      for (int e = 0; e < 32; ++e) vnT[(32 * part + e) * 136 + s] = (bfu)f2bf(g[e] * r * gp[e]);
    }
    __syncthreads();
    const int fr = lane & 15, fq = lane >> 4, t0 = 16 * wave, trow = t0 + fr;
    f32x4 acc[8];
#pragma unroll
    for (int nb = 0; nb < 8; ++nb) acc[nb] = (f32x4){0.f, 0.f, 0.f, 0.f};
    const float* wrow = spw + (size_t)(h * 128 + trow) * 128;
    const int nks = (t0 + 15) / 32 + 1;
    for (int ks = 0; ks < nks; ++ks) {
        const int s0 = 32 * ks + 8 * fq;
        f32x4 w0 = *(const f32x4*)(wrow + s0), w1 = *(const f32x4*)(wrow + s0 + 4);
#pragma unroll
        for (int j = 0; j < 4; ++j) { if (s0 + j > trow) w0[j] = 0.f; if (s0 + 4 + j > trow) w1[j] = 0.f; }
        const bf16x8 a = pack8f(w0, w1);
#pragma unroll
        for (int nb = 0; nb < 8; ++nb) { const bf16x8 b = *(const LAS bf16x8*)(vnT + (16 * nb + fr) * 136 + 32 * ks + 8 * fq); acc[nb] = MFMA16(a, b, acc[nb]); }
    }
#pragma unroll
    for (int i = 0; i < 4; ++i) { const int t = t0 + 4 * fq + i; const float bias = spb[h * 128 + t];
        const bfu* up = Z1 + (tok0 + t) * ABIN + h * 128 + fr; bfu* yp = Y + (tok0 + t) * DMOD + h * 128 + fr;
#pragma unroll
        for (int nb = 0; nb < 8; nb += 2) { float u0 = bf2f(__builtin_nontemporal_load(up + 16 * nb)), u1 = bf2f(__builtin_nontemporal_load(up + 16 * nb + 16)); gelu2(u0, u1);
            yp[16 * nb] = (bfu)f2bf(u0 * (acc[nb][i] + bias)); yp[16 * nb + 16] = (bfu)f2bf(u1 * (acc[nb + 1][i] + bias)); } }
    __syncthreads();
}

__device__ __forceinline__ float hgrn_lb(const float* gamma, int col) {
    const float g0 = gamma[col], g1 = gamma[1024 + col], g2 = gamma[2048 + col]; const float mx = fmaxf(g0, fmaxf(g1, g2));
    const float e0 = __expf(g0 - mx), e1 = __expf(g1 - mx), e2 = __expf(g2 - mx); return e0 / (e0 + e1 + e2);
}
__device__ __forceinline__ void hgrn_local_tile(int tile, const bfu* Z1, const float* gamma, bfu* HL, float* DEC, LAS unsigned char* lds, int tid, int wave, int lane) {
    const int bh = tile >> 6, c = tile & 63, b = bh >> 3, h = bh & 7; const size_t tok0 = (size_t)b * SEQL + c * 64;
    LAS float* segsum = (LAS float*)lds; LAS bfu* keT = (LAS bfu*)(lds + 2048); LAS bfu* vT = (LAS bfu*)(lds + 2048 + 18432);
    const int seg = tid >> 7, k = tid & 127;
    const float lb = hgrn_lb(gamma, h * 128 + k);
    float fl[16], G[16]; float run = 0.f;
#pragma unroll
    for (int i = 0; i < 16; ++i) { fl[i] = bf2f(Z1[(tok0 + 16 * seg + i) * ABIN + 3072 + h * 128 + k]); run += __logf(lb + (1.0f - lb) * sigmoidf_(fl[i])); G[i] = run; }
    segsum[seg * 128 + k] = run;
    unsigned vw[8];
#pragma unroll
    for (int i = 0; i < 8; ++i) vw[i] = (unsigned)Z1[(tok0 + 16 * seg + 2 * i) * ABIN + 4096 + h * 128 + k] | ((unsigned)Z1[(tok0 + 16 * seg + 2 * i + 1) * ABIN + 4096 + h * 128 + k] << 16);
    *(LAS v4u*)(vT + k * 72 + 16 * seg) = (v4u){vw[0], vw[1], vw[2], vw[3]}; *(LAS v4u*)(vT + k * 72 + 16 * seg + 8) = (v4u){vw[4], vw[5], vw[6], vw[7]};
    __syncthreads();
    float pre = 0.f, tot = 0.f;
#pragma unroll
    for (int s = 0; s < 4; ++s) { const float v = segsum[s * 128 + k]; if (s < seg) pre += v; tot += v; }
    unsigned kw[8];
#pragma unroll
    for (int i = 0; i < 8; ++i) { const float k0 = (1.0f - lb) * sigmoidf_(-fl[2 * i]) * __expf(tot - (pre + G[2 * i])), k1 = (1.0f - lb) * sigmoidf_(-fl[2 * i + 1]) * __expf(tot - (pre + G[2 * i + 1])); kw[i] = pk2(k0, k1); }
    *(LAS v4u*)(keT + k * 72 + 16 * seg) = (v4u){kw[0], kw[1], kw[2], kw[3]}; *(LAS v4u*)(keT + k * 72 + 16 * seg + 8) = (v4u){kw[4], kw[5], kw[6], kw[7]};
    if (seg == 3) DEC[(size_t)(bh * 64 + c) * 128 + k] = __expf(tot);
    __syncthreads();
    const int fr = lane & 15, fq = lane >> 4;
    f32x4 acc[8];
#pragma unroll
    for (int nb = 0; nb < 8; ++nb) acc[nb] = (f32x4){0.f, 0.f, 0.f, 0.f};
#pragma unroll
    for (int ks = 0; ks < 2; ++ks) { const bf16x8 a = *(const LAS bf16x8*)(vT + (16 * wave + fr) * 72 + 32 * ks + 8 * fq);
#pragma unroll
        for (int nb = 0; nb < 8; ++nb) { const bf16x8 bb = *(const LAS bf16x8*)(keT + (16 * nb + fr) * 72 + 32 * ks + 8 * fq); acc[nb] = MFMA16(a, bb, acc[nb]); } }
    LAS bfu* Lt = (LAS bfu*)(lds + 40960);
#pragma unroll
    for (int i = 0; i < 4; ++i)
#pragma unroll
        for (int nb = 0; nb < 8; ++nb) Lt[(16 * wave + 4 * fq + i) * 136 + 16 * nb + fr] = (bfu)f2bf(acc[nb][i]);
    __syncthreads();
    bfu* Lp = HL + (size_t)(bh * 64 + c) * 16384;
#pragma unroll
    for (int j = 0; j < 4; ++j) { const int idx = tid + 512 * j, row = idx >> 4, ch = idx & 15; *(v4u*)(Lp + row * 128 + ch * 8) = *(const LAS v4u*)(Lt + row * 136 + ch * 8); }
    __syncthreads();
}
__device__ __forceinline__ void hgrn_out_tile(int tile, const bfu* Z1, const float* gamma, const float* ogain, const bfu* HL, bfu* Y, LAS unsigned char* lds, int tid, int wave, int lane) {
    const int bh = tile >> 6, c = tile & 63, b = bh >> 3, h = bh & 7; const size_t tok0 = (size_t)b * SEQL + c * 64;
    LAS float* segsum = (LAS float*)lds; LAS float* ssq = (LAS float*)(lds + 2048);
    LAS bfu* qd = (LAS bfu*)(lds + 4096); LAS bfu* kd = qd + 64 * 136; LAS bfu* vT = kd + 64 * 136; LAS bfu* Pm = vT + 128 * 72;
    const int seg = tid >> 7, k = tid & 127;
    const int fr = lane & 15, fq = lane >> 4, tb = wave >> 1, wh = wave & 1;
    const float lb = hgrn_lb(gamma, h * 128 + k);
    unsigned flraw[16], qraw[16], vraw[16], graw[4][4];
#pragma unroll
    for (int i = 0; i < 16; ++i) { const bfu* rp = Z1 + (tok0 + 16 * seg + i) * ABIN + h * 128 + k; flraw[i] = __builtin_nontemporal_load(rp + 3072); vraw[i] = __builtin_nontemporal_load(rp + 4096); qraw[i] = __builtin_nontemporal_load(rp + 2048); }
#pragma unroll
    for (int i = 0; i < 4; ++i)
#pragma unroll
        for (int j = 0; j < 4; ++j) graw[i][j] = __builtin_nontemporal_load(Z1 + (tok0 + 16 * tb + 4 * fq + i) * ABIN + 5120 + h * 128 + 16 * (4 * wh + j) + fr);
    float fl[16], G[16]; float run = 0.f;
#pragma unroll
    for (int i = 0; i < 16; ++i) { fl[i] = bf2f(flraw[i]); run += __logf(lb + (1.0f - lb) * sigmoidf_(fl[i])); G[i] = run; }
    segsum[seg * 128 + k] = run;
    unsigned vw[8];
#pragma unroll
    for (int i = 0; i < 8; ++i) vw[i] = vraw[2 * i] | (vraw[2 * i + 1] << 16);
    *(LAS v4u*)(vT + k * 72 + 16 * seg) = (v4u){vw[0], vw[1], vw[2], vw[3]}; *(LAS v4u*)(vT + k * 72 + 16 * seg + 8) = (v4u){vw[4], vw[5], vw[6], vw[7]};
    __syncthreads();
    float pre = 0.f;
#pragma unroll
    for (int s = 0; s < 3; ++s) { const float v = segsum[s * 128 + k]; if (s < seg) pre += v; }
#pragma unroll
    for (int i = 0; i < 16; ++i) { const int t = 16 * seg + i; const float Gt = pre + G[i]; const float qv = bf2f(qraw[i]);
        qd[t * 136 + k] = (bfu)f2bf(qv * __expf(Gt)); kd[t * 136 + k] = (bfu)f2bf((1.0f - lb) * sigmoidf_(-fl[i]) * __expf(-Gt)); }
    const bfu* Sg = HL + (size_t)(bh * 64 + c) * 16384;
    bf16x8 sfr[4][4];
#pragma unroll
    for (int ks = 0; ks < 4; ++ks)
#pragma unroll
        for (int j = 0; j < 4; ++j) sfr[ks][j] = *(const bf16x8*)(Sg + (16 * (4 * wh + j) + fr) * 128 + 32 * ks + 8 * fq);
    __syncthreads();
#pragma unroll
    for (int jj = 0; jj < 2; ++jj) { const int sb = 2 * wh + jj; f32x4 sc = (f32x4){0.f, 0.f, 0.f, 0.f};
        if (sb <= tb) {
#pragma unroll
            for (int ks = 0; ks < 4; ++ks) { const bf16x8 a = *(const LAS bf16x8*)(qd + (16 * tb + fr) * 136 + 32 * ks + 8 * fq), bb = *(const LAS bf16x8*)(kd + (16 * sb + fr) * 136 + 32 * ks + 8 * fq); sc = MFMA16(a, bb, sc); } }
#pragma unroll
        for (int i = 0; i < 4; ++i) { const int t = 16 * tb + 4 * fq + i, s = 16 * sb + fr; Pm[t * 72 + s] = (bfu)f2bf(s <= t ? sc[i] : 0.f); } }
    __syncthreads();
    f32x4 acc[4];
#pragma unroll
    for (int j = 0; j < 4; ++j) acc[j] = (f32x4){0.f, 0.f, 0.f, 0.f};
#pragma unroll
    for (int ks = 0; ks < 2; ++ks) { const bf16x8 a = *(const LAS bf16x8*)(Pm + (16 * tb + fr) * 72 + 32 * ks + 8 * fq);
#pragma unroll
        for (int j = 0; j < 4; ++j) { const bf16x8 bb = *(const LAS bf16x8*)(vT + (16 * (4 * wh + j) + fr) * 72 + 32 * ks + 8 * fq); acc[j] = MFMA16(a, bb, acc[j]); } }
#pragma unroll
    for (int ks = 0; ks < 4; ++ks) { const bf16x8 a = *(const LAS bf16x8*)(qd + (16 * tb + fr) * 136 + 32 * ks + 8 * fq);
#pragma unroll
        for (int j = 0; j < 4; ++j) acc[j] = MFMA16(a, sfr[ks][j], acc[j]); }
#pragma unroll
    for (int i = 0; i < 4; ++i) { float pp = (acc[0][i] * acc[0][i] + acc[1][i] * acc[1][i]) + (acc[2][i] * acc[2][i] + acc[3][i] * acc[3][i]);
        pp += __shfl_xor(pp, 1); pp += __shfl_xor(pp, 2); pp += __shfl_xor(pp, 4); pp += __shfl_xor(pp, 8);
        if (fr == 0) ssq[wave * 16 + 4 * fq + i] = pp; }
    __syncthreads();
#pragma unroll
    for (int i = 0; i < 4; ++i) { const int t = 16 * tb + 4 * fq + i; const float r = rsqrtf((ssq[wave * 16 + 4 * fq + i] + ssq[(wave ^ 1) * 16 + 4 * fq + i]) * (1.0f / 128.0f) + RMS_EPS);
#pragma unroll
        for (int j = 0; j < 4; ++j) { const int v = 16 * (4 * wh + j) + fr; const float gt = bf2f(graw[i][j]);
            Y[(tok0 + t) * DMOD + 1024 + h * 128 + v] = (bfu)f2bf(acc[j][i] * r * ogain[v] * gt * sigmoidf_(gt)); } }
    __syncthreads();
}


#ifndef EN_ATTN
#define EN_ATTN 1
#endif
#ifndef EN_MIXAB
#define EN_MIXAB 1
#endif
#ifndef EN_GEMM
#define EN_GEMM 1
#endif
#define XB_TMO      128
#define XB_XCNT(j)  (256  + 64 * (j))
#define XB_XSUB(j)  (1280 + 64 * (j))
#define XB_XGEN(j)  (2304 + 64 * (j))
#define XB_TOP      3328
#define XB_TOPGEN   3392
#define XCD_BAR_WORDS 3456
#define XB_SPIN_CAP (1u << 18)

__device__ __forceinline__ unsigned xb_ld(unsigned* p)              { return __hip_atomic_load(p, __ATOMIC_RELAXED, __HIP_MEMORY_SCOPE_AGENT); }
__device__ __forceinline__ unsigned xb_add(unsigned* p, unsigned v) { return __hip_atomic_fetch_add(p, v, __ATOMIC_RELAXED, __HIP_MEMORY_SCOPE_AGENT); }
__device__ __forceinline__ unsigned xb_xcc_id() { return (unsigned)__builtin_amdgcn_s_getreg((3 << 11) | 20) & 0xFu; }
#define XB_SPIN(cond, bar) do { unsigned _sp = 0; while (cond) { __builtin_amdgcn_s_sleep(1); \
    if ((++_sp & 255u) == 0u) { if (xb_ld(&(bar)[XB_TMO])) break; if (_sp > XB_SPIN_CAP) { atomicAdd(&(bar)[XB_TMO], 1u); break; } } } } while (0)

struct XcdBarrier {
    unsigned* bar; unsigned x;
    volatile LAS unsigned* st;
};

__device__ __forceinline__ XcdBarrier xcd_barrier_post(unsigned* bar, volatile LAS unsigned* st) {
    XcdBarrier b; b.bar = bar; b.x = xb_xcc_id(); b.st = st;
    if (threadIdx.x == 0) (void)xb_add(&bar[XB_XCNT(b.x)], 1u);
    return b;
}
__device__ __forceinline__ void xcd_barrier_complete(unsigned* bar, unsigned x, unsigned& nloc, unsigned& nx) {
    const unsigned G = gridDim.x * gridDim.y * gridDim.z;
    unsigned sum, cnt, mine, sp = 0u;
    for (;;) {
        sum = 0u; cnt = 0u; mine = 0u;
#pragma unroll
        for (unsigned j = 0; j < 16; ++j) { const unsigned c = xb_ld(&bar[XB_XCNT(j)]); sum += c; cnt += (c > 0u) ? 1u : 0u; mine = (j == x) ? c : mine; }
        if (sum == G) break;
        __builtin_amdgcn_s_sleep(1);
        if ((++sp & 255u) == 0u) { if (xb_ld(&bar[XB_TMO])) break; if (sp > XB_SPIN_CAP) { atomicAdd(&bar[XB_TMO], 1u); break; } }
    }
    nloc = mine > 0u ? mine : 1u; nx = cnt > 0u ? cnt : 1u;
}

__device__ __forceinline__ void xcd_barrier(const XcdBarrier& b) {
    asm volatile("s_waitcnt vmcnt(0)" ::: "memory");
    __syncthreads();
    if (threadIdx.x == 0) {
        unsigned* bar = b.bar;
        __builtin_amdgcn_s_waitcnt(0);
        unsigned nloc = b.st[0], nx = b.st[1];
        if (nloc == 0u) { xcd_barrier_complete(bar, b.x, nloc, nx); b.st[0] = nloc; b.st[1] = nx; }
        const unsigned old = xb_add(&bar[XB_XSUB(b.x)], 1u);
        const unsigned gen = old / nloc;
        if (old + 1u == (gen + 1u) * nloc) {
            __builtin_amdgcn_fence(__ATOMIC_RELEASE, "agent");
            asm volatile("s_waitcnt vmcnt(0)" ::: "memory");
            const unsigned og = xb_add(&bar[XB_TOP], 1u);
            const unsigned tg = og / nx;
            if (og + 1u == (tg + 1u) * nx) xb_add(&bar[XB_TOPGEN], 1u);
            else XB_SPIN(xb_ld(&bar[XB_TOPGEN]) == tg, bar);
            __builtin_amdgcn_fence(__ATOMIC_ACQUIRE, "agent");
            xb_add(&bar[XB_XGEN(b.x)], 1u);
            asm volatile("s_waitcnt vmcnt(0)" ::: "memory");
        } else {
            XB_SPIN(xb_ld(&bar[XB_XGEN(b.x)]) == gen, bar);
            __builtin_amdgcn_fence(__ATOMIC_ACQUIRE, "agent");
            asm volatile("s_waitcnt vmcnt(0)" ::: "memory");
        }
    }
    __syncthreads();
}

struct Params { const float* in[19]; float* out; unsigned char* ws; };
#define ARG(p_, i_) ([&]() -> const float* { int k_ = (i_); asm volatile("" : "+s"(k_)); return (p_).in[k_]; }())
#define PHASE_IDS() int tid = threadIdx.x; asm volatile("" : "+v"(tid)); const int lane = tid & 63, wave = __builtin_amdgcn_readfirstlane(tid >> 6); \
    const int G = gridDim.x, gw = blockIdx.x * 8 + wave, NGW = G * 8; const long gtid = (long)blockIdx.x * 512 + tid, NGT = (long)G * 512; (void)lane; (void)gw; (void)NGW; (void)gtid; (void)NGT

template <class Epi> __device__ __forceinline__ void run_gemm(LAS unsigned char* lds, const bfu* A, const bfu* Bt, int M, int N, int K, const Epi& E) {
#if EN_GEMM
    pg8::Gemm g{A, Bt, M, N, K}; pg8::StaticOrder S; S.init(M, N, (int)gridDim.x, (int)blockIdx.x);
    pg8::gemm_phase<Epi, pg8::StaticOrder, true, true>(lds, g, S, E);
#endif
}

struct TrDesc { const float* src; bfu* dst; int ldw, K; };
__device__ __forceinline__ TrDesc tr_decode(const Params& p, int item) {
    constexpr int I0 = 96 * 32, I1 = 32 * 32, I2 = 128 * 32, I3 = 32 * 32, I4 = 176 * 32, I5 = 32 * 88;
    unsigned char* ws = p.ws; const float* W; bfu* WT; int ldw, K, nblk; bool remap = false; int r = item;
    if (r < I0) { W = ARG(p, 2); WT = (bfu*)(ws + WS_WABIN); ldw = ABIN; K = DMOD; nblk = 96; }
    else if ((r -= I0) < I1) { W = ARG(p, 8); WT = (bfu*)(ws + WS_WABOUT); ldw = DMOD; K = DMOD; nblk = 32; }
    else if ((r -= I1) < I2) { W = ARG(p, 9); WT = (bfu*)(ws + WS_WCIN); ldw = CINW; K = DMOD; nblk = 128; }
    else if ((r -= I2) < I3) { W = ARG(p, 13); WT = (bfu*)(ws + WS_WCOUT); ldw = DMOD; K = DMOD; nblk = 32; }
    else if ((r -= I3) < I4) { W = ARG(p, 15); WT = (bfu*)(ws + WS_WUP0); ldw = FF2; K = DMOD; nblk = 176; remap = true; }
    else if ((r -= I4) < I4) { W = ARG(p, 15) + (size_t)DMOD * FF2; WT = (bfu*)(ws + WS_WUP1); ldw = FF2; K = DMOD; nblk = 176; remap = true; }
    else if ((r -= I4) < I5) { W = ARG(p, 18); WT = (bfu*)(ws + WS_WDN0); ldw = DMOD; K = FFH; nblk = 32; }
    else { r -= I5; W = ARG(p, 18) + (size_t)FFH * DMOD; WT = (bfu*)(ws + WS_WDN1); ldw = DMOD; K = FFH; nblk = 32; }
    const int kb = r / nblk, nb = r - kb * nblk, k0 = 64 * kb, n0 = 64 * nb;
    int d0 = n0; if (remap) { const int bj = n0 >= FFH ? 1 : 0, rem = n0 - bj * FFH; d0 = (rem >> 7) * 256 + bj * 128 + (rem & 127); }
    TrDesc d; d.src = W + (size_t)k0 * ldw + n0; d.dst = WT + (size_t)d0 * K + k0; d.ldw = ldw; d.K = K; return d;
}
__device__ __forceinline__ void tr_load(const TrDesc& d, f32x4 (&v)[16], int lane) {
    const float* s = d.src + (size_t)(lane >> 4) * d.ldw + 4 * (lane & 15);
#pragma unroll
    for (int i = 0; i < 16; ++i) v[i] = __builtin_nontemporal_load((const f32x4*)(s + (size_t)(4 * i) * d.ldw));
}
__device__ __forceinline__ void tr_finish(const TrDesc& d, const f32x4 (&v)[16], LAS float* scr, int lane) {
    const int q = lane & 15, kr = lane >> 4;
#pragma unroll
    for (int i = 0; i < 16; ++i) { LAS float* s = scr + (4 * i + kr) * 65 + 4 * q; s[0] = v[i][0]; s[1] = v[i][1]; s[2] = v[i][2]; s[3] = v[i][3]; }
    LDS_WAIT(); asm volatile("" ::: "memory");
    const int c = lane & 7;
#pragma unroll
    for (int j = 0; j < 8; ++j) { const int n = (lane >> 3) + 8 * j; const LAS float* s = scr + (8 * c) * 65 + n;
        v4u o; o.x = pk2(s[0], s[65]); o.y = pk2(s[130], s[195]); o.z = pk2(s[260], s[325]); o.w = pk2(s[390], s[455]);
        *(v4u*)(d.dst + (size_t)n * d.K + 8 * c) = o; }
    LDS_WAIT(); asm volatile("" ::: "memory");
}
__device__ __forceinline__ void p0_phase(const Params& p, LAS unsigned char* lds) {
    PHASE_IDS(); unsigned char* ws = p.ws;
    bfu* Wcin = (bfu*)(ws + WS_WCIN);
    LAS float* scr = (LAS float*)(lds + wave * 16640);
    constexpr int NIT = 96 * 32 + 32 * 32 + 128 * 32 + 32 * 32 + 2 * 176 * 32 + 2 * 32 * 88;
    f32x4 va[16], vb[16]; TrDesc da, db; int it = gw;
    if (it < NIT) { da = tr_decode(p, it); tr_load(da, va, lane); }
    for (; it < NIT; it += 2 * NGW) {
        const int it1 = it + NGW, it2 = it + 2 * NGW;
        if (it1 < NIT) { db = tr_decode(p, it1); tr_load(db, vb, lane); }
        tr_finish(da, va, scr, lane);
        if (it2 < NIT) { da = tr_decode(p, it2); tr_load(da, va, lane); }
        if (it1 < NIT) tr_finish(db, vb, scr, lane);
    }
    for (long i = gtid; i < 16 * DMOD; i += NGT) { const int j = (int)(i / DMOD), kk = (int)(i % DMOD); Wcin[(size_t)(8192 + j) * DMOD + kk] = (bfu)f2bf(ARG(p, 9)[(size_t)kk * CINW + 8192 + j]); }
    rms_rows<true>(ARG(p, 0), ARG(p, 1), (bfu*)(ws + WS_ACT), gw, NGW, lane);
}
__device__ __forceinline__ void norm_phase(const float* X, const float* gain, bfu* O) { PHASE_IDS(); rms_rows<true>(X, gain, O, gw, NGW, lane); }

__device__ __forceinline__ void mixab_phase1(const Params& p, LAS unsigned char* lds) {
#if EN_MIXAB
    PHASE_IDS(); unsigned char* ws = p.ws; const bfu* Z1 = (const bfu*)(ws + WS_Z1);
    for (int t = blockIdx.x; t < 1024 + 2048; t += G) {
        if (t < 1024) gmlp_tile(t, Z1, ARG(p, 3), ARG(p, 4), ARG(p, 5), (bfu*)(ws + WS_ACT), lds, tid, wave, lane);
        else hgrn_local_tile(t - 1024, Z1, ARG(p, 6), (bfu*)(ws + WS_HL), (float*)(ws + WS_DEC), lds, tid, wave, lane);
    }
#endif
}
__device__ __forceinline__ void hgrn_scan_phase(const Params& p) {
    PHASE_IDS(); bfu* HL = (bfu*)(p.ws + WS_HL); const float* DEC = (const float*)(p.ws + WS_DEC);
    typedef unsigned u32x2 __attribute__((ext_vector_type(2)));
    for (long e = gtid; e < 32L * 128 * 32; e += NGT) {
        const int bh = (int)(e >> 12), vq = (int)(e & 4095);
        bfu* base = HL + (size_t)bh * 64 * 16384 + (size_t)vq * 4; const float* db = DEC + (size_t)bh * 64 * 128 + (vq & 31) * 4;
        f32x4 s = (f32x4){0.f, 0.f, 0.f, 0.f};
        for (int c0 = 0; c0 < 64; c0 += 16) {
            u32x2 Lc[16]; f32x4 dc[16];
#pragma unroll
            for (int u = 0; u < 16; ++u) { Lc[u] = *(const u32x2*)(base + (size_t)(c0 + u) * 16384); dc[u] = *(const f32x4*)(db + (c0 + u) * 128); }
#pragma unroll
            for (int u = 0; u < 16; ++u) { *(u32x2*)(base + (size_t)(c0 + u) * 16384) = (u32x2){pk2(s[0], s[1]), pk2(s[2], s[3])};
                s = dc[u] * s + (f32x4){bflo(Lc[u][0]), bfhi(Lc[u][0]), bflo(Lc[u][1]), bfhi(Lc[u][1])}; }
        }
    }
}
__device__ __forceinline__ void mixab_phase3(const Params& p, LAS unsigned char* lds) {
#if EN_MIXAB
    PHASE_IDS(); unsigned char* ws = p.ws;
    for (int t = blockIdx.x; t < 2048; t += G) hgrn_out_tile(t, (const bfu*)(ws + WS_Z1), ARG(p, 6), ARG(p, 7), (const bfu*)(ws + WS_HL), (bfu*)(ws + WS_ACT), lds, tid, wave, lane);
#endif
}
__device__ __forceinline__ void fgate_phase(const Params& p) {
    PHASE_IDS(); const bfu* A = (const bfu*)(p.ws + WS_ACT); const bfu* Bw = (const bfu*)(p.ws + WS_WCIN) + (size_t)8192 * DMOD; float* Fb = (float*)(p.ws + WS_F);
    const int fr = lane & 15, fq = lane >> 4;
    for (int it = gw; it < 2 * (NTOK / 16); it += NGW) {
        const int rb = it >> 1, kh = it & 1;
        const bfu* ap = A + (size_t)(16 * rb + fr) * DMOD + 8 * fq + 1024 * kh; const bfu* bp = Bw + (size_t)fr * DMOD + 8 * fq + 1024 * kh;
        f32x4 acc0 = (f32x4){0.f, 0.f, 0.f, 0.f}, acc1 = acc0;
#pragma unroll 8
        for (int ks = 0; ks < 32; ks += 2) {
            const bf16x8 a0 = *(const bf16x8*)(ap + 32 * ks), b0 = *(const bf16x8*)(bp + 32 * ks), a1 = *(const bf16x8*)(ap + 32 * ks + 32), b1 = *(const bf16x8*)(bp + 32 * ks + 32);
            acc0 = MFMA16(a0, b0, acc0); acc1 = MFMA16(a1, b1, acc1); }
#pragma unroll
        for (int i = 0; i < 4; ++i) Fb[(size_t)kh * NTOK * 16 + (size_t)(16 * rb + 4 * fq + i) * 16 + fr] = acc0[i] + acc1[i];
    }
}
__device__ __forceinline__ void qknorm_phase(const Params& p) {
    PHASE_IDS(); const float* Fb = (const float*)(p.ws + WS_F); float* Cb = (float*)(p.ws + WS_C);
    if (gw < 64) {
        const int bh = gw, b = bh >> 4, h = bh & 15; const float bf_ = ARG(p, 10)[h];
        const float* fp = Fb + ((size_t)b * SEQL + 64 * lane) * 16 + h;
        float tot = 0.f;
        for (int i = 0; i < 64; ++i) { const float z = fp[i * 16] + fp[(size_t)NTOK * 16 + i * 16] + bf_; tot += fminf(z, 0.f) - log1pf(__expf(-fabsf(z))); }
        float inc = tot;
#pragma unroll
        for (int o = 1; o < 64; o <<= 1) { const float u = __shfl_up(inc, o); if (lane >= o) inc += u; }
        float run = inc - tot;
        float* cp = Cb + (size_t)bh * SEQL + 64 * lane;
        for (int i = 0; i < 64; ++i) { const float z = fp[i * 16] + fp[(size_t)NTOK * 16 + i * 16] + bf_; run += fminf(z, 0.f) - log1pf(__expf(-fabsf(z))); cp[i] = run; }
    }
}
__device__ __forceinline__ void attn_phase(const Params& p, char* ldsg) {
#if EN_ATTN
    using bfh = __hip_bfloat16; typedef fox::BlockRef<bfh, bfh> BR;
    const bfh* Qb = (const bfh*)(p.ws + WS_QKVG); bfh* Yb = (bfh*)(p.ws + WS_ACT); const float* Cb = (const float*)(p.ws + WS_C);
    const int total = 512, stride = gridDim.x;
    float margin;
    { const float* qg = ARG(p, 11); const float* kg = ARG(p, 12); float a = 0.f, b = 0.f;
#pragma unroll 8
      for (int i = 0; i < 128; ++i) { a = fmaxf(a, fabsf(qg[i])); b = fmaxf(b, fabsf(kg[i])); }
      margin = 110.0f + 2.0f * 1.01f * 128.0f * a * b * fox::SCALE;
      margin = __builtin_bit_cast(float, __builtin_amdgcn_readfirstlane(__builtin_bit_cast(int, margin))); }
#define FOX_ID(L_, pass_) const int bh_ = ((L_) & 7) + 8 * ((L_) >> 6), x_ = ((L_) >> 3) & 7, qb_ = (pass_) ? 15 - x_ : x_, b_ = bh_ >> 4, h_ = bh_ & 15
#define FOX_REF(r, L_, pass_, sk_) do { FOX_ID(L_, pass_); \
        const size_t SEC_ = (size_t)NTOK * 2048, hb_ = (size_t)bh_ * SEQL * 128, rq_ = hb_ + (size_t)qb_ * 256 * 128; \
        (r).Q = Qb + rq_; (r).K = Qb + SEC_ + hb_ + (size_t)(sk_) * 128; (r).V = Qb + 2 * SEC_ + hb_ + (size_t)(sk_) * 128; (r).Gt = Qb + 3 * SEC_ + rq_; \
        (r).O = Yb + ((size_t)b_ * SEQL + (size_t)qb_ * 256) * 2048 + h_ * 128; (r).P0 = qb_ * 256 - (sk_); (r).cb = Cb + (size_t)bh_ * SEQL + (sk_); } while (0)
    int sk00 = 0, sk01 = 0, sk10 = 0, sk11 = 0;
#define FOX_SKIP(dst, L_, pass_) do { FOX_ID(L_, pass_); (void)b_; (void)h_; dst = fox::fox_jlo(Cb + (size_t)bh_ * SEQL, qb_ * 256, margin) * 64; } while (0)
    { const int L0 = blockIdx.x, L1 = blockIdx.x + stride;
      if (L0 < total) { FOX_SKIP(sk00, L0, 0); FOX_SKIP(sk01, L0, 1); }
      if (L1 < total) { FOX_SKIP(sk10, L1, 0); FOX_SKIP(sk11, L1, 1); } }
#define FOX_SK(L_, pass_) ((L_) == (int)blockIdx.x ? ((pass_) ? sk01 : sk00) : (L_) == (int)blockIdx.x + stride ? ((pass_) ? sk11 : sk10) : 0)
    int L = blockIdx.x;
    if (L < total) {
        int pass = 0; BR cur; FOX_REF(cur, L, 0, FOX_SK(L, 0));
        fox::Seam<bfh> S;
        fox::causal_swa_prime<bfh, bfh>(cur, SEQL, ldsg, S);
        for (;;) {
            const bool more_pass = pass == 0, more_item = L + stride < total, last = !more_pass && !more_item;
            int passn = pass + 1, Ln = L;
            if (!more_pass) { passn = 0; Ln = more_item ? L + stride : L; }
            BR nxt = cur; if (!last) FOX_REF(nxt, Ln, passn, FOX_SK(Ln, passn));
            fox::causal_swa_block<bfh, bfh>(cur, nxt, SEQL, SEQL, ldsg, S);
            if (last) break;
            cur = nxt; pass = passn; L = Ln;
        }
#undef FOX_SK
#undef FOX_SKIP
#undef FOX_ID
#undef FOX_REF
    }
#endif
}
__device__ __forceinline__ void conv_fix_phase(const float* HALO, const float* cw, const float* cbv, bfu* GA) {
    PHASE_IDS();
    for (long e = gtid; e < 256L * 2 * 1408; e += NGT) {
        const int cq = (int)(e % 1408), gr = (int)(e / 1408), r = gr & 1, g = gr >> 1;
        const int c = cq * 4, cp = (c >> 7) * 256 + (c & 127);
        const bool first = (g & 63) == 0;
        const float* H = HALO + (size_t)g * 4 * FF2 + cp; const float* Hp = first ? H : H - 4 * FF2;
        const f32x4 zero = (f32x4){0.f, 0.f, 0.f, 0.f};
        const f32x4 za = *(const f32x4*)(H + r * FF2), zb = *(const f32x4*)(H + r * FF2 + 128);
        f32x4 za1, zb1, za2, zb2;
        if (r == 0) { za1 = *(const f32x4*)(Hp + 3 * FF2); zb1 = *(const f32x4*)(Hp + 3 * FF2 + 128); za2 = *(const f32x4*)(Hp + 2 * FF2); zb2 = *(const f32x4*)(Hp + 2 * FF2 + 128); if (first) { za1 = zero; zb1 = zero; za2 = zero; zb2 = zero; } }
        else { za1 = *(const f32x4*)(H); zb1 = *(const f32x4*)(H + 128); za2 = *(const f32x4*)(Hp + 3 * FF2); zb2 = *(const f32x4*)(Hp + 3 * FF2 + 128); if (first) { za2 = zero; zb2 = zero; } }
        const f32x4 a = *(const f32x4*)(cbv + c) + *(const f32x4*)(cw + c) * za2 + *(const f32x4*)(cw + FF2 + c) * za1 + *(const f32x4*)(cw + 2 * FF2 + c) * za;
        const f32x4 b = *(const f32x4*)(cbv + FFH + c) + *(const f32x4*)(cw + FFH + c) * zb2 + *(const f32x4*)(cw + FF2 + FFH + c) * zb1 + *(const f32x4*)(cw + 2 * FF2 + FFH + c) * zb;
        float gv[4];
#pragma unroll
        for (int i = 0; i < 4; ++i) gv[i] = a[i] * sigmoidf_(a[i]) * b[i];
        *(unsigned long long*)(GA + ((size_t)g * 64 + r) * FFH + c) = (unsigned long long)pk2(gv[0], gv[1]) | ((unsigned long long)pk2(gv[2], gv[3]) << 32);
    }
}
#define GSYNC() xcd_barrier(xbar)
template <int LAYER> __device__ __forceinline__ void ffn_block(const Params& p, LAS unsigned char* lds, const XcdBarrier& xbar) {
    unsigned char* ws = p.ws; bfu* ACT = (bfu*)(ws + WS_ACT); bfu* GA = (bfu*)(ws + WS_GA); float* HALO = (float*)(ws + WS_HALO);
    const bfu* Wup = (const bfu*)(ws + (LAYER ? WS_WUP1 : WS_WUP0)); const bfu* Wdn = (const bfu*)(ws + (LAYER ? WS_WDN1 : WS_WDN0));
    const float* cw = ARG(p, 16) + (size_t)LAYER * 3 * FF2; const float* cbv = ARG(p, 17) + (size_t)LAYER * FF2;
    norm_phase(p.out, ARG(p, 14) + (size_t)LAYER * DMOD, ACT);
    GSYNC();
    { pg8::EpiConvGate E{GA, HALO, cw, cbv}; run_gemm(lds, ACT, Wup, NTOK, FF2, DMOD, E); }
    GSYNC();
    conv_fix_phase(HALO, cw, cbv, GA);
    GSYNC();
    { pg8::EpiResF32 E{p.out, p.out, DMOD}; run_gemm(lds, GA, Wdn, NTOK, DMOD, FFH, E); }
}

__global__ void __launch_bounds__(512, 2) fwd_mega(Params p) {
    extern __shared__ __attribute__((aligned(16))) unsigned char lds_raw[];
    LAS unsigned char* lds = (LAS unsigned char*)lds_raw;
    unsigned char* ws = p.ws; bfu* ACT = (bfu*)(ws + WS_ACT);
    unsigned* barw = (unsigned*)(ws + WS_BAR);
    if (blockIdx.x == 0) for (int i = threadIdx.x; i < 4096; i += 512) barw[i] = 0u;
    if (threadIdx.x < 32) ((LAS unsigned*)(lds + LDS_MISC))[threadIdx.x] = 0u;
    cg::this_grid().sync();
    const XcdBarrier xbar = xcd_barrier_post(barw, (volatile LAS unsigned*)(lds + LDS_MISC));
    p0_phase(p, lds);
    GSYNC();
    { pg8::EpiBf16<0> E{(bfu*)(ws + WS_Z1), ABIN, nullptr, 0, 0, 1.f}; run_gemm(lds, ACT, (const bfu*)(ws + WS_WABIN), NTOK, ABIN, DMOD, E); }
    GSYNC();
    mixab_phase1(p, lds);
    GSYNC();
    hgrn_scan_phase(p);
    GSYNC();
    mixab_phase3(p, lds);
    GSYNC();
    { pg8::EpiResF32 E{ARG(p, 0), p.out, DMOD}; run_gemm(lds, ACT, (const bfu*)(ws + WS_WABOUT), NTOK, DMOD, DMOD, E); }
    GSYNC();
    ffn_block<0>(p, lds, xbar);
    GSYNC();
    norm_phase(p.out, ARG(p, 1) + DMOD, ACT);
    GSYNC();
    { pg8::EpiCin E{(bfu*)(ws + WS_QKVG), ARG(p, 11), ARG(p, 12), (LAS float*)(lds + 131072)}; run_gemm(lds, ACT, (const bfu*)(ws + WS_WCIN), NTOK, 8192, DMOD, E); }
    fgate_phase(p);
    GSYNC();
    qknorm_phase(p);
    GSYNC();
    attn_phase(p, (char*)lds_raw);
    GSYNC();
    { pg8::EpiResF32 E{p.out, p.out, DMOD}; run_gemm(lds, ACT, (const bfu*)(ws + WS_WCOUT), NTOK, DMOD, DMOD, E); }
    GSYNC();
    ffn_block<1>(p, lds, xbar);
}

extern "C" void kernel_launch(void* const* d_in, const int* in_sizes, int n_in, void* d_out, int out_size, void* d_ws, size_t ws_size, hipStream_t stream) {
    static int grid = 0;
    if (grid == 0) {
        if (n_in != 19 || in_sizes[0] != NTOK * DMOD || out_size != NTOK * DMOD || ws_size < WS_TOTAL) {
            fprintf(stderr, "kernel_launch: shape/workspace mismatch (n_in %d, in0 %d, out %d, ws %zu, need %zu)\n", n_in, n_in > 0 ? in_sizes[0] : -1, out_size, ws_size, (size_t)WS_TOTAL); grid = -1; return; }
        int dev = 0, cus = 0, per_cu = 0;
        (void)hipGetDevice(&dev); (void)hipDeviceGetAttribute(&cus, hipDeviceAttributeMultiprocessorCount, dev);
        if (hipFuncSetAttribute((const void*)fwd_mega, hipFuncAttributeMaxDynamicSharedMemorySize, LDS_BYTES) != hipSuccess) { fprintf(stderr, "kernel_launch: hipFuncSetAttribute failed\n"); grid = -1; return; }
        if (hipOccupancyMaxActiveBlocksPerMultiprocessor(&per_cu, (const void*)fwd_mega, 512, LDS_BYTES) != hipSuccess || per_cu < 1) { fprintf(stderr, "kernel_launch: occupancy query says %d\n", per_cu); per_cu = 1; }
        (void)hipGetLastError();
        grid = cus > 0 ? cus : 256;
    }
    if (grid < 0) return;
    Params prm{};
    for (int i = 0; i < 19; ++i) prm.in[i] = (const float*)d_in[i];
    prm.out = (float*)d_out; prm.ws = (unsigned char*)d_ws;
    void* args[] = {&prm};
    hipError_t e = hipLaunchCooperativeKernel((const void*)fwd_mega, dim3(grid), dim3(512), args, LDS_BYTES, stream);
    if (e != hipSuccess) fprintf(stderr, "kernel_launch: cooperative launch failed: %s (grid %d)\n", hipGetErrorString(e), grid);
}
```

```cpp
#include <hip/hip_runtime.h>
#include <hip/hip_bf16.h>
#include <hip/hip_cooperative_groups.h>
#include <cstdio>
#include <cstdint>
#include <cmath>
namespace cg = cooperative_groups;
namespace pg8 {
#define PG8_LAS __attribute__((address_space(3)))
typedef unsigned short bf16_t;
typedef short bf16x8 __attribute__((ext_vector_type(8)));
typedef float f32x4 __attribute__((ext_vector_type(4)));
typedef unsigned u32x4 __attribute__((ext_vector_type(4)));
constexpr int BM = 256, BK = 64, HALF = 128, HTB = HALF * BK * 2  , STAGE_BYTES = 8 * HTB, NXCD = 8, WGM = 8;

__host__ __device__ __forceinline__ int lds_byte(int r, int c) { const int st = (r >> 4) * 2 + (c >> 5), rr = r & 15, cc = c & 31, ob = rr * 64 + cc * 2; return st * 1024 + (ob ^ (((ob >> 9) & 1) << 5)); }
__host__ __device__ __forceinline__ void stage_rc(int b, int& R, int& C) { const int st = b / 1024, sb = b % 1024, swz = sb ^ (((sb >> 9) & 1) << 5); R = (st >> 1) * 16 + swz / 64; C = (st & 1) * 32 + (swz % 64) / 2; }
__host__ __device__ __forceinline__ int perm32(int rho) { const int n = rho >> 4, i = rho & 15; return 8 * (i >> 2) + 4 * n + (i & 3); }

struct Unit { int pm, pn; };
struct Gemm { const bf16_t* A; const bf16_t* Bt; int M, N, K; };

struct StaticOrder {
    int nM, nN, nwg, G, c; bool revn = false;
    __host__ __device__ void init(int M, int N, int G_, int c_) { nM = M / BM; nN = N / BM; nwg = nM * nN; G = G_; c = c_; }
    __host__ __device__ bool next(int i, Unit& u) const {
        const long L = (long)i * G + c; if (L >= nwg) return false;
        int wgid = (int)L; { const int q = nwg / NXCD, r = nwg % NXCD, xcd = wgid % NXCD, off = wgid / NXCD; wgid = (xcd < r ? xcd * (q + 1) : r * (q + 1) + (xcd - r) * q) + off; }
        const int nig = WGM * nN, gid = wgid / nig, fm = gid * WGM, gsz = (nM - fm) < WGM ? (nM - fm) : WGM;
        u.pm = fm + ((wgid % nig) % gsz); u.pn = (wgid % nig) / gsz; if (revn) u.pn = nN - 1 - u.pn; return true;
    }
    __device__ __forceinline__ void a_ready(const Unit&) const {}
    __device__ __forceinline__ void done(const Unit&) const {}
};

__device__ __forceinline__ unsigned cvt_pk_bf16(float lo, float hi) { unsigned r; asm volatile("v_cvt_pk_bf16_f32 %0, %1, %2" : "=v"(r) : "v"(lo), "v"(hi)); return r; }
typedef float f32x2 __attribute__((ext_vector_type(2)));
__device__ __forceinline__ f32x2 gelu_pk(f32x2 v) {
    const f32x2 av = __builtin_elementwise_abs(v), d = av * 0.2316418882f + 1.0f;
    f32x2 t; t.x = __builtin_amdgcn_rcpf(d.x); t.y = __builtin_amdgcn_rcpf(d.y);
    f32x2 q = t * 0.5307027145f + (-0.7265760135f); q = q * t + 0.7107068705f; q = q * t + (-0.142248368f); q = q * t + 0.127414796f; q = q * t;
    const f32x2 s = (v * v) * (-0.72134752044f);
    f32x2 e; e.x = __builtin_amdgcn_exp2f(s.x); e.y = __builtin_amdgcn_exp2f(s.y);
    const f32x2 m = v * (q * e), r = v - m;
    f32x2 o; o.x = v.x < 0.f ? m.x : r.x; o.y = v.y < 0.f ? m.y : r.y; return o;
}

template <int ACT  > struct EpiBf16 {
    static constexpr bool PERM = true, AFTER_DRAIN = false; static_assert(ACT == 0 || ACT == 1, "EpiBf16: ACT is 0 (none) or 1 (gelu_pk)");
    bf16_t* O; int ldc; const float* bias; int split_cols; size_t split_stride; float scale0;
    __device__ __forceinline__ void operator()(const f32x4 (&acc)[2][2][4][2], const Unit& u, int wr, int wc, int fr, int fq) const {
        const int row0 = u.pm * BM + wr * 64 + fr; int colt = u.pn * BM; bf16_t* base = O;
        float sc = 1.f; if (split_cols) { const int t = colt / split_cols; base += (size_t)t * split_stride; colt -= t * split_cols; if (t == 0) sc = scale0; }
        const int col0 = colt + wc * 32 + 8 * fq, bcol0 = u.pn * BM + wc * 32 + 8 * fq;
        f32x4 bv[2][2];
#pragma unroll
        for (int bj = 0; bj < 2; ++bj)
#pragma unroll
            for (int n = 0; n < 2; ++n) bv[bj][n] = bias ? *(const f32x4*)(bias + bcol0 + bj * HALF + 4 * n) : (f32x4){0.f, 0.f, 0.f, 0.f};
#pragma unroll
        for (int ai = 0; ai < 2; ++ai)
#pragma unroll
            for (int m = 0; m < 4; ++m) { bf16_t* rowp = base + (size_t)(row0 + ai * HALF + m * 16) * ldc + col0;
#pragma unroll
                for (int bj = 0; bj < 2; ++bj) { f32x4 v0 = acc[ai][bj][m][0] + bv[bj][0], v1 = acc[ai][bj][m][1] + bv[bj][1];
                    if (ACT == 1) { f32x2 a = gelu_pk((f32x2){v0[0], v0[1]}), b = gelu_pk((f32x2){v0[2], v0[3]}), c = gelu_pk((f32x2){v1[0], v1[1]}), d = gelu_pk((f32x2){v1[2], v1[3]});
                        v0 = (f32x4){a.x, a.y, b.x, b.y}; v1 = (f32x4){c.x, c.y, d.x, d.y}; }
                    v0 = v0 * sc; v1 = v1 * sc; u32x4 w; w.x = cvt_pk_bf16(v0[0], v0[1]); w.y = cvt_pk_bf16(v0[2], v0[3]); w.z = cvt_pk_bf16(v1[0], v1[1]); w.w = cvt_pk_bf16(v1[2], v1[3]);
                    *(u32x4*)(rowp + bj * HALF) = w; } }
    }
};
struct EpiResF32 {
    static constexpr bool PERM = false, AFTER_DRAIN = false;
    const float* res; float* out; int ldc;
    __device__ __forceinline__ void operator()(const f32x4 (&acc)[2][2][4][2], const Unit& u, int wr, int wc, int fr, int fq) const {
        const int col0 = u.pn * BM + wc * 32 + 4 * fq;
#pragma unroll
        for (int ai = 0; ai < 2; ++ai)
#pragma unroll
            for (int m = 0; m < 4; ++m) { const size_t off = (size_t)(u.pm * BM + ai * HALF + wr * 64 + m * 16 + fr) * ldc + col0;
#pragma unroll
                for (int bj = 0; bj < 2; ++bj)
#pragma unroll
                    for (int n = 0; n < 2; ++n) { const f32x4 bs = *(const f32x4*)(res + off + bj * HALF + n * 16); *(f32x4*)(out + off + bj * HALF + n * 16) = bs + acc[ai][bj][m][n]; } }
    }
};
struct EpiCin {
    static constexpr bool PERM = true, AFTER_DRAIN = false;
    bf16_t* O; const float* qg; const float* kg; PG8_LAS float* X;
    __device__ __forceinline__ void operator()(const f32x4 (&acc)[2][2][4][2], const Unit& u, int wr, int wc, int fr, int fq) const {
        const int sec = u.pn >> 3, h0 = (u.pn & 7) * 2, b = u.pm >> 4, s0 = (u.pm & 15) * BM + wr * 64 + fr;
        bf16_t* base = O + (size_t)sec * ((size_t)16384 * 2048) + ((size_t)(b * 16 + h0) * 4096) * 128 + wc * 32 + 8 * fq;
        const bool nrm = sec < 2;
        f32x4 g0 = (f32x4){1.f, 1.f, 1.f, 1.f}, g1 = g0;
        if (nrm) {
            const float* gp = (sec ? kg : qg) + wc * 32 + 8 * fq; g0 = *(const f32x4*)gp; g1 = *(const f32x4*)(gp + 4);
#pragma unroll
            for (int ai = 0; ai < 2; ++ai)
#pragma unroll
                for (int m = 0; m < 4; ++m)
#pragma unroll
                    for (int bj = 0; bj < 2; ++bj) { const f32x4 v0 = acc[ai][bj][m][0], v1 = acc[ai][bj][m][1];
                        float ss = ((v0[0] * v0[0] + v0[1] * v0[1]) + (v0[2] * v0[2] + v0[3] * v0[3])) + ((v1[0] * v1[0] + v1[1] * v1[1]) + (v1[2] * v1[2] + v1[3] * v1[3]));
                        ss += __shfl_xor(ss, 16); ss += __shfl_xor(ss, 32);
                        if (fq == 0) X[((ai * HALF + wr * 64 + m * 16 + fr) * 2 + bj) * 4 + wc] = ss; }
            asm volatile("s_waitcnt lgkmcnt(0)" ::: "memory"); __builtin_amdgcn_s_barrier(); asm volatile("" ::: "memory");
        }
#pragma unroll
        for (int ai = 0; ai < 2; ++ai)
#pragma unroll
            for (int m = 0; m < 4; ++m) { bf16_t* rowp = base + (size_t)(s0 + ai * HALF + m * 16) * 128;
#pragma unroll
                for (int bj = 0; bj < 2; ++bj) { f32x4 v0 = acc[ai][bj][m][0], v1 = acc[ai][bj][m][1];
                    if (nrm) { const f32x4 pp = *(const PG8_LAS f32x4*)(X + ((ai * HALF + wr * 64 + m * 16 + fr) * 2 + bj) * 4);
                        const float r = __builtin_amdgcn_rsqf(((pp[0] + pp[1]) + (pp[2] + pp[3])) * (1.0f / 128.0f) + 1e-6f); v0 = v0 * r * g0; v1 = v1 * r * g1; }
                    u32x4 w; w.x = cvt_pk_bf16(v0[0], v0[1]); w.y = cvt_pk_bf16(v0[2], v0[3]); w.z = cvt_pk_bf16(v1[0], v1[1]); w.w = cvt_pk_bf16(v1[2], v1[3]);
                    *(u32x4*)(rowp + (size_t)bj * 4096 * 128) = w; } }
    }
};
__device__ __forceinline__ float dpp_ror1(float v) { return __builtin_bit_cast(float, __builtin_amdgcn_update_dpp(0, __builtin_bit_cast(int, v), 0x121, 0xF, 0xF, false)); }
__device__ __forceinline__ float dpp_ror2(float v) { return __builtin_bit_cast(float, __builtin_amdgcn_update_dpp(0, __builtin_bit_cast(int, v), 0x122, 0xF, 0xF, false)); }
struct EpiConvGate {
    static constexpr bool PERM = true, AFTER_DRAIN = false;
    bf16_t* GA; float* HALO; const float* cw; const float* cb;
    __device__ __forceinline__ void operator()(const f32x4 (&acc)[2][2][4][2], const Unit& u, int wr, int wc, int fr, int fq) const {
        constexpr int F2 = 11264, FH = 5632;
        const int cl = wc * 32 + 8 * fq, ca = u.pn * 128 + cl, ct = u.pn * 256 + cl;
        const bool f1 = fr >= 1, f2 = fr >= 2;
#pragma unroll
        for (int n = 0; n < 2; ++n) {
            const f32x4 wa0 = *(const f32x4*)(cw + ca + 4 * n), wa1 = *(const f32x4*)(cw + F2 + ca + 4 * n), wa2 = *(const f32x4*)(cw + 2 * F2 + ca + 4 * n), ba = *(const f32x4*)(cb + ca + 4 * n);
            const f32x4 wb0 = *(const f32x4*)(cw + FH + ca + 4 * n), wb1 = *(const f32x4*)(cw + F2 + FH + ca + 4 * n), wb2 = *(const f32x4*)(cw + 2 * F2 + FH + ca + 4 * n), bb = *(const f32x4*)(cb + FH + ca + 4 * n);
#pragma unroll
            for (int ai = 0; ai < 2; ++ai) {
                const int grp = u.pm * 4 + ai * 2 + wr;
                f32x4 pa1 = (f32x4){0.f, 0.f, 0.f, 0.f}, pa2 = pa1, pb1 = pa1, pb2 = pa1;
#pragma unroll
                for (int m = 0; m < 4; ++m) {
                    const f32x4 za = acc[ai][0][m][n], zb = acc[ai][1][m][n];
                    f32x4 ra1, ra2, rb1, rb2;
#pragma unroll
                    for (int i = 0; i < 4; ++i) { ra1[i] = dpp_ror1(za[i]); ra2[i] = dpp_ror2(za[i]); rb1[i] = dpp_ror1(zb[i]); rb2[i] = dpp_ror2(zb[i]); }
                    f32x4 a, b;
#pragma unroll
                    for (int i = 0; i < 4; ++i) { const float a1 = f1 ? ra1[i] : pa1[i], a2 = f2 ? ra2[i] : pa2[i], b1 = f1 ? rb1[i] : pb1[i], b2 = f2 ? rb2[i] : pb2[i];
                        a[i] = ba[i] + wa0[i] * a2 + wa1[i] * a1 + wa2[i] * za[i]; b[i] = bb[i] + wb0[i] * b2 + wb1[i] * b1 + wb2[i] * zb[i]; }
                    pa1 = ra1; pa2 = ra2; pb1 = rb1; pb2 = rb2;
                    float g[4];
#pragma unroll
                    for (int i = 0; i < 4; ++i) g[i] = a[i] * __builtin_amdgcn_rcpf(1.0f + __expf(-a[i])) * b[i];
                    const size_t row = (size_t)grp * 64 + m * 16 + fr;
                    unsigned long long w = (unsigned long long)cvt_pk_bf16(g[0], g[1]) | ((unsigned long long)cvt_pk_bf16(g[2], g[3]) << 32);
                    *(unsigned long long*)(GA + row * FH + ca + 4 * n) = w;
                    if (m == 0 && fr < 2) { float* hp = HALO + ((size_t)grp * 4 + fr) * F2 + ct + 4 * n; *(f32x4*)hp = za; *(f32x4*)(hp + 128) = zb; }
                    if (m == 3 && fr >= 14) { float* hp = HALO + ((size_t)grp * 4 + (fr - 12)) * F2 + ct + 4 * n; *(f32x4*)hp = za; *(f32x4*)(hp + 128) = zb; }
                }
            }
        }
    }
};
template <class Epi, class Sched, bool ALIGN_EPI = false, bool SP2 = false>
__device__ __forceinline__ void gemm_phase(PG8_LAS unsigned char* lds, const Gemm g, const Sched& S, const Epi& E) {
    int tid_l = threadIdx.x; asm volatile("" : "+v"(tid_l)); const int tid = tid_l, wid = __builtin_amdgcn_readfirstlane(tid >> 6), lane = tid & 63, wr = wid >> 2, wc = wid & 3, fr = lane & 15, fq = lane >> 4;
    const int K = g.K, nt = K / BK;
    unsigned voffA[2], voffB[2];
#pragma unroll
    for (int i = 0; i < 2; ++i) { int R, C; stage_rc(tid * 16 + i * 8192, R, C); const int Rb = Epi::PERM ? ((R & ~31) + perm32(R & 31)) : R;
        voffA[i] = (unsigned)(R * K + C) * 2u; voffB[i] = (unsigned)(Rb * K + C) * 2u; }
    const size_t kstep = (size_t)(BK * 2);
    const size_t hstep = (size_t)HALF * K * 2;
    const size_t tstep = 2 * hstep;
    const unsigned ldsw = (unsigned)wid * 1024u;
    const int aoff = lds_byte(wr * 64 + fr, fq * 8), boff = lds_byte(wc * 32 + fr, fq * 8);
#define PG8_SA(b, h) (((b) * 2 + (h)) * HTB)
#define PG8_SB(b, h) ((4 + (b) * 2 + (h)) * HTB)
#define PG8_STAGE(bufoff, gbase, voff) do { _Pragma("unroll") for (int _i = 0; _i < 2; ++_i) \
        __builtin_amdgcn_global_load_lds((const unsigned*)((const char*)(gbase) + (voff)[_i]), (PG8_LAS unsigned*)(lds + (bufoff) + ldsw + _i * 8192), 16, 0, 0); } while (0)
#define PG8_LDA(dst, b, h) do { _Pragma("unroll") for (int m = 0; m < 4; ++m) _Pragma("unroll") for (int k = 0; k < 2; ++k) dst[m][k] = *(const PG8_LAS bf16x8*)(lds + PG8_SA(b, h) + aoff + m * 2048 + k * 1024); } while (0)
#define PG8_LDB(dst, b, h) do { _Pragma("unroll") for (int n = 0; n < 2; ++n) _Pragma("unroll") for (int k = 0; k < 2; ++k) dst[n][k] = *(const PG8_LAS bf16x8*)(lds + PG8_SB(b, h) + boff + n * 2048 + k * 1024); } while (0)
#define PG8_MMA(ai, bj, At, Bt) do { __builtin_amdgcn_s_setprio(1); _Pragma("unroll") for (int m = 0; m < 4; ++m) _Pragma("unroll") for (int n = 0; n < 2; ++n) _Pragma("unroll") for (int k = 0; k < 2; ++k) \
        acc[ai][bj][m][n] = __builtin_amdgcn_mfma_f32_16x16x32_bf16(Bt[n][k], At[m][k], acc[ai][bj][m][n], 0, 0, 0); __builtin_amdgcn_s_setprio(0); } while (0)
#define PG8_WAIT_V(n) asm volatile("s_waitcnt vmcnt(" #n ")" ::: "memory")
#define PG8_WAIT_L(n) asm volatile("s_waitcnt lgkmcnt(" #n ")" ::: "memory")
#define PG8_BAR __builtin_amdgcn_s_barrier()
#define PG8_SCHED __builtin_amdgcn_sched_barrier(0)
    Unit cur, nxt; int ui = 0;
    if (!S.next(0, cur)) return;
    f32x4 acc[2][2][4][2];
#pragma unroll
    for (int a = 0; a < 2; ++a)
#pragma unroll
        for (int b = 0; b < 2; ++b)
#pragma unroll
            for (int m = 0; m < 4; ++m)
#pragma unroll
                for (int n = 0; n < 2; ++n) acc[a][b][m][n] = (f32x4){0.f, 0.f, 0.f, 0.f};
    bf16x8 At[4][2], B0[2][2], B1[2][2];
    const char* cA = (const char*)g.A + (size_t)cur.pm * tstep; const char* cB = (const char*)g.Bt + (size_t)cur.pn * tstep;
    S.a_ready(cur);
    if constexpr (SP2) {
        PG8_STAGE(PG8_SB(0, 0), cB, voffB); PG8_STAGE(PG8_SB(0, 1), cB + hstep, voffB); PG8_STAGE(PG8_SA(0, 0), cA, voffA); PG8_STAGE(PG8_SA(0, 1), cA + hstep, voffA);
        if (wr == 1) PG8_BAR;
        PG8_WAIT_V(2); PG8_BAR;
        PG8_STAGE(PG8_SB(1, 0), cB + kstep, voffB); PG8_STAGE(PG8_SA(1, 0), cA + kstep, voffA); PG8_STAGE(PG8_SB(1, 1), cB + hstep + kstep, voffB);
        PG8_WAIT_V(6); PG8_BAR;
    } else {
        PG8_STAGE(PG8_SB(0, 0), cB, voffB); PG8_STAGE(PG8_SA(0, 0), cA, voffA); PG8_STAGE(PG8_SB(0, 1), cB + hstep, voffB); PG8_STAGE(PG8_SA(0, 1), cA + hstep, voffA);
        if (wr == 1) PG8_BAR;
        PG8_WAIT_V(4); PG8_BAR;
        PG8_STAGE(PG8_SB(1, 0), cB + kstep, voffB); PG8_STAGE(PG8_SA(1, 0), cA + kstep, voffA); PG8_STAGE(PG8_SB(1, 1), cB + hstep + kstep, voffB);
        PG8_WAIT_V(6); PG8_BAR;
    }
    for (;;) {
        const bool has_next = S.next(ui + 1, nxt);
        const char* nA = has_next ? (const char*)g.A + (size_t)nxt.pm * tstep : cA; const char* nB = has_next ? (const char*)g.Bt + (size_t)nxt.pn * tstep : cB;
        for (int t = 0; t < nt; t += 2) {
            const bool last = (t == nt - 2);
            const char* a1 = cA + (size_t)(t + 1) * kstep;
            const char* a2 = last ? nA : cA + (size_t)(t + 2) * kstep; const char* b2 = last ? nB : cB + (size_t)(t + 2) * kstep;
            const char* a3 = a2 + kstep; const char* b3 = b2 + kstep;
            if (last && has_next) S.a_ready(nxt);
            if constexpr (SP2) {
            PG8_LDB(B0, 0, 0); PG8_LDB(B1, 0, 1); PG8_SCHED; PG8_LDA(At, 0, 0); PG8_STAGE(PG8_SA(1, 1), a1 + hstep, voffA);
            PG8_WAIT_V(8); PG8_WAIT_L(0); PG8_BAR; PG8_MMA(0, 0, At, B0); PG8_MMA(0, 1, At, B1); PG8_BAR; PG8_SCHED;
            PG8_LDA(At, 0, 1); PG8_STAGE(PG8_SB(0, 0), b2, voffB); PG8_STAGE(PG8_SB(0, 1), b2 + hstep, voffB); PG8_STAGE(PG8_SA(0, 0), a2, voffA);
            PG8_WAIT_V(8); PG8_WAIT_L(0); PG8_BAR; PG8_MMA(1, 0, At, B0); PG8_MMA(1, 1, At, B1); PG8_BAR; PG8_SCHED;
            PG8_LDB(B0, 1, 0); PG8_LDB(B1, 1, 1); PG8_SCHED; PG8_LDA(At, 1, 0); PG8_STAGE(PG8_SA(0, 1), a2 + hstep, voffA);
            PG8_WAIT_V(8); PG8_WAIT_L(0); PG8_BAR; PG8_MMA(0, 0, At, B0); PG8_MMA(0, 1, At, B1); PG8_BAR; PG8_SCHED;
            PG8_LDA(At, 1, 1); PG8_STAGE(PG8_SB(1, 0), b3, voffB); PG8_STAGE(PG8_SB(1, 1), b3 + hstep, voffB); PG8_STAGE(PG8_SA(1, 0), a3, voffA);
            PG8_WAIT_V(8); PG8_WAIT_L(0); PG8_BAR; PG8_MMA(1, 0, At, B0); PG8_MMA(1, 1, At, B1); PG8_BAR; PG8_SCHED;
            } else {
            PG8_LDB(B0, 0, 0); PG8_SCHED; PG8_LDA(At, 0, 0); PG8_STAGE(PG8_SA(1, 1), a1 + hstep, voffA);
            PG8_WAIT_L(8); PG8_BAR; PG8_WAIT_L(0); PG8_MMA(0, 0, At, B0); PG8_BAR; PG8_SCHED;
            PG8_LDB(B1, 0, 1); PG8_STAGE(PG8_SB(0, 0), b2, voffB);
            PG8_BAR; PG8_WAIT_L(0); PG8_MMA(0, 1, At, B1); PG8_BAR;
            PG8_LDA(At, 0, 1); PG8_STAGE(PG8_SA(0, 0), a2, voffA);
            PG8_BAR; PG8_WAIT_L(0); PG8_MMA(1, 0, At, B0); PG8_BAR; PG8_SCHED;
            PG8_STAGE(PG8_SB(0, 1), b2 + hstep, voffB);
            PG8_WAIT_V(6); PG8_BAR; PG8_MMA(1, 1, At, B1); PG8_BAR;
            PG8_LDB(B0, 1, 0); PG8_SCHED; PG8_LDA(At, 1, 0); PG8_STAGE(PG8_SA(0, 1), a2 + hstep, voffA);
            PG8_WAIT_L(8); PG8_BAR; PG8_WAIT_L(0); PG8_MMA(0, 0, At, B0); PG8_BAR; PG8_SCHED;
            PG8_LDB(B1, 1, 1); PG8_STAGE(PG8_SB(1, 0), b3, voffB);
            PG8_BAR; PG8_WAIT_L(0); PG8_MMA(0, 1, At, B1); PG8_BAR;
            PG8_LDA(At, 1, 1); PG8_STAGE(PG8_SA(1, 0), a3, voffA);
            PG8_BAR; PG8_WAIT_L(0); PG8_MMA(1, 0, At, B0); PG8_BAR; PG8_SCHED;
            PG8_STAGE(PG8_SB(1, 1), b3 + hstep, voffB);
            PG8_WAIT_V(6); PG8_BAR; PG8_MMA(1, 1, At, B1); PG8_BAR;
            }
        }
        if constexpr (ALIGN_EPI) { if (wr == 0) PG8_BAR; }
        if constexpr (!Epi::AFTER_DRAIN) { E(acc, cur, wr, wc, fr, fq); S.done(cur); }
        if (!has_next) break;
#pragma unroll
        for (int a = 0; a < 2; ++a)
#pragma unroll
            for (int b = 0; b < 2; ++b)
#pragma unroll
                for (int m = 0; m < 4; ++m)
#pragma unroll
                    for (int n = 0; n < 2; ++n) acc[a][b][m][n] = (f32x4){0.f, 0.f, 0.f, 0.f};
        cur = nxt; cA = nA; cB = nB; ++ui;
        if constexpr (ALIGN_EPI) { if (wr == 1) PG8_BAR; }
    }
    PG8_WAIT_V(0);
    if constexpr (!ALIGN_EPI) { if (wr == 0) PG8_BAR; }
    PG8_BAR;
    if constexpr (Epi::AFTER_DRAIN) { E.fused(acc, cur, wr, wc, fr, fq, lds, wid, lane); S.done(cur); }
#undef PG8_SA
#undef PG8_SB
#undef PG8_STAGE
#undef PG8_LDA
#undef PG8_LDB
#undef PG8_MMA
#undef PG8_WAIT_V
#undef PG8_WAIT_L
#undef PG8_BAR
#undef PG8_SCHED
}
}
namespace fox {
constexpr int D = 128, PQ = 128, PO = 2048;
constexpr float THR = 8.f; constexpr bool WSKIP = false;
constexpr float SCALE = 0.08838834764831845f;
constexpr int NW = 8, QBLK = 32, KVBLK = 64, QB = NW * QBLK;
constexpr int SHM_V = KVBLK * D * 2, SHM_K = KVBLK * D * 2;
constexpr int LDS_CB = 2 * SHM_V + 2 * SHM_K + NW * 64 * 4;
constexpr int LDS_BYTES = LDS_CB + 4096 * 4;

using bf16 = __hip_bfloat16;
typedef short bf16x8 __attribute__((ext_vector_type(8)));
typedef short s16x4 __attribute__((ext_vector_type(4)));
typedef float f32x16 __attribute__((ext_vector_type(16)));
typedef float f32x4 __attribute__((ext_vector_type(4)));
typedef unsigned u32x4 __attribute__((ext_vector_type(4)));
template <class A, class Bt> struct same_t { static constexpr bool v = false; };
template <class A> struct same_t<A, A> { static constexpr bool v = true; };

#define KSWZ(row, colB) ((row) * 256 + ((colB) ^ (((row) & 7) << 4)))
#define SBAR() __builtin_amdgcn_sched_barrier(0)
__device__ __forceinline__ int v_st(int k, int c) { const int kk = (k & ~0xC) | ((k & 4) << 1) | ((k & 8) >> 1); return ((kk >> 3) * 4 + (c >> 5)) * 512 + ((kk & 7) * 32 + (c & 31)) * 2; }
__device__ __forceinline__ int v_rd_base(int lane) { return ((lane & 3) << 3) | (((lane >> 2) & 3) << 6) | (((lane >> 4) & 1) << 5) | (((lane >> 5) & 1) << 8); }
constexpr int v_rd_off(int d0, int ks, int half) { return d0 * 512 + ks * 4096 + half * 2048; }
__device__ __forceinline__ int crow(int r, int hi) { return (r & 3) + 8 * (r >> 2) + 4 * hi; }
__device__ __forceinline__ unsigned cvtpk(float lo, float hi) {
    unsigned r; asm volatile("v_cvt_pk_bf16_f32 %0, %1, %2" : "=v"(r) : "v"(lo), "v"(hi)); return r;
}
__device__ __forceinline__ bf16x8 pack8(f32x4 a, f32x4 b) {
    u32x4 w = {cvtpk(a[0], a[1]), cvtpk(a[2], a[3]), cvtpk(b[0], b[1]), cvtpk(b[2], b[3])};
    return *reinterpret_cast<bf16x8*>(&w);
}
template <class T> __device__ __forceinline__ bf16x8 load8(const T* p) {
    if constexpr (same_t<T, float>::v) { return pack8(*(const f32x4*)p, *(const f32x4*)(p + 4)); }
    else { return *reinterpret_cast<const bf16x8*>(p); }
}
__device__ __forceinline__ void mask_tile(f32x16& p0, f32x16& p1, int dq, unsigned W) {
    const float NEG = -__builtin_inff();
#pragma unroll
    for (int r = 0; r < 16; ++r) {
        const int c = (r & 3) + 8 * (r >> 2);
        if ((unsigned)(dq - c) >= W) p0[r] = NEG;
        if ((unsigned)(dq - c - 32) >= W) p1[r] = NEG;
    }
}
__device__ __forceinline__ void partialSM(f32x16& p0, f32x16& p1, float& m_reg, float& mn, float& alpha) {
    float pmax = p0[0]; for (int r = 1; r < 16; ++r) pmax = fmaxf(pmax, p0[r]); for (int r = 0; r < 16; ++r) pmax = fmaxf(pmax, p1[r]);
    { auto rr = __builtin_amdgcn_permlane32_swap(__float_as_uint(pmax), __float_as_uint(pmax), false, false);
      pmax = fmaxf(__uint_as_float(rr[0]), __uint_as_float(rr[1])); }
    constexpr float C2 = 1.4426950408889634f * SCALE;
    if (__builtin_expect(__all((pmax - m_reg) * SCALE <= THR), 1)) { mn = m_reg; alpha = 1.f; }
    else { mn = fmaxf(m_reg, pmax); alpha = __builtin_amdgcn_exp2f((m_reg - mn) * C2); m_reg = mn; }
    const float mnL = -mn * C2;
    for (int r = 0; r < 16; ++r) p0[r] = fmaf(p0[r], C2, mnL); for (int r = 0; r < 16; ++r) p1[r] = fmaf(p1[r], C2, mnL);
    for (int r = 0; r < 16; ++r) p0[r] = __builtin_amdgcn_exp2f(p0[r]);
}
__device__ __forceinline__ void finishSM(f32x16& p0, f32x16& p1, float alpha, float& l_reg, bf16x8& pa0, bf16x8& pa1, bf16x8& pa2, bf16x8& pa3) {
    for (int r = 0; r < 16; ++r) p1[r] = __builtin_amdgcn_exp2f(p1[r]);
    float ps = 0; for (int r = 0; r < 16; ++r) ps += p0[r]; for (int r = 0; r < 16; ++r) ps += p1[r];
    { auto rr = __builtin_amdgcn_permlane32_swap(__float_as_uint(ps), __float_as_uint(ps), false, false);
      ps = __uint_as_float(rr[0]) + __uint_as_float(rr[1]); }
    l_reg = l_reg * alpha + ps;
#define PK4(P, B_, OUT) do { unsigned a0 = cvtpk(P[B_+0], P[B_+1]), a1 = cvtpk(P[B_+2], P[B_+3]);                          \
        unsigned b0 = cvtpk(P[B_+4], P[B_+5]), b1 = cvtpk(P[B_+6], P[B_+7]);                                             \
        auto r0 = __builtin_amdgcn_permlane32_swap(a0, b0, false, false); auto r1 = __builtin_amdgcn_permlane32_swap(a1, b1, false, false); \
        u32x4 w = {r0[0], r1[0], r0[1], r1[1]}; OUT = *reinterpret_cast<bf16x8*>(&w); } while (0)
    PK4(p0, 0, pa0); PK4(p0, 8, pa1); PK4(p1, 0, pa2); PK4(p1, 8, pa3);
#undef PK4
}
__device__ __forceinline__ void bias_init(f32x16& p0, f32x16& p1, const float* cbt) {
#pragma unroll
    for (int g = 0; g < 4; ++g) { const f32x4 b0v = *(const f32x4*)(cbt + 8 * g), b1v = *(const f32x4*)(cbt + 32 + 8 * g);
        p0[4 * g] = b0v[0]; p0[4 * g + 1] = b0v[1]; p0[4 * g + 2] = b0v[2]; p0[4 * g + 3] = b0v[3];
        p1[4 * g] = b1v[0]; p1[4 * g + 1] = b1v[1]; p1[4 * g + 2] = b1v[2]; p1[4 * g + 3] = b1v[3]; }
}
template <int KB, bool SK>
__device__ __forceinline__ void qkt(f32x16& p0, f32x16& p1, const char* K_lds, int r32, int hi, const bf16x8* qr, bool act, const float* cbt) {
    if (SK && !act) { const float NEG = -__builtin_inff();
#pragma unroll
        for (int r = 0; r < 16; ++r) { p0[r] = NEG; p1[r] = NEG; } return; }
    (void)cbt;
    const char* kb[4];
#pragma unroll
    for (int dd = 0; dd < 4; ++dd) kb[dd] = K_lds + KB * SHM_K + KSWZ(r32, (dd * 16 + hi * 8) * 2);
#pragma unroll
    for (int d0 = 0; d0 < 8; ++d0) { const char* a = kb[d0 & 3] + (d0 >> 2) * 128;
        bf16x8 b0 = *reinterpret_cast<const bf16x8*>(a);
        bf16x8 b1 = *reinterpret_cast<const bf16x8*>(a + 32 * 256);
        p0 = __builtin_amdgcn_mfma_f32_32x32x16_bf16(b0, qr[d0], p0, 0, 0, 0);
        p1 = __builtin_amdgcn_mfma_f32_32x32x16_bf16(b1, qr[d0], p1, 0, 0, 0); }
}
template <int VB, bool SK>
__device__ __forceinline__ void pv_tile(f32x16* o, int vb0, bf16x8 pa0, bf16x8 pa1, bf16x8 pa2, bf16x8 pa3, bool act) {
    if (SK && !act) return;
#define TRRD(dst, off) asm volatile("ds_read_b64_tr_b16 %0, %1 offset:%2" : "=&v"(dst) : "v"(vb0), "i"(off) : "memory")
#define PV_D0(d0) do { s16x4 l0, l1, l2, l3, h0, h1, h2, h3; constexpr int b_ = VB * SHM_V + v_rd_off(d0, 0, 0);     \
        TRRD(l0, b_); TRRD(h0, b_ + 2048); TRRD(l1, b_ + 4096); TRRD(h1, b_ + 6144); TRRD(l2, b_ + 8192); TRRD(h2, b_ + 10240); TRRD(l3, b_ + 12288); TRRD(h3, b_ + 14336); \
        asm volatile("s_waitcnt lgkmcnt(0)" ::: "memory"); SBAR();                 \
        o[d0] = __builtin_amdgcn_mfma_f32_32x32x16_bf16(pa0, (bf16x8){l0[0], l0[1], l0[2], l0[3], h0[0], h0[1], h0[2], h0[3]}, o[d0], 0, 0, 0);   \
        o[d0] = __builtin_amdgcn_mfma_f32_32x32x16_bf16(pa1, (bf16x8){l1[0], l1[1], l1[2], l1[3], h1[0], h1[1], h1[2], h1[3]}, o[d0], 0, 0, 0);   \
        o[d0] = __builtin_amdgcn_mfma_f32_32x32x16_bf16(pa2, (bf16x8){l2[0], l2[1], l2[2], l2[3], h2[0], h2[1], h2[2], h2[3]}, o[d0], 0, 0, 0);   \
        o[d0] = __builtin_amdgcn_mfma_f32_32x32x16_bf16(pa3, (bf16x8){l3[0], l3[1], l3[2], l3[3], h3[0], h3[1], h3[2], h3[3]}, o[d0], 0, 0, 0); } while (0)
    PV_D0(0); PV_D0(1); PV_D0(2); PV_D0(3);
#undef PV_D0
#undef TRRD
}

__device__ __forceinline__ int fox_jlo(const float* cb, int P0, float margin) {
    const int lane = threadIdx.x & 63, nt0 = P0 / KVBLK;
    const float thr = cb[P0] + margin;
    bool dead = false; if (lane < nt0) dead = cb[KVBLK * lane + KVBLK - 1] > thr;
    const unsigned long long m = __ballot(dead);
    return __builtin_amdgcn_readfirstlane((int)__builtin_ctzll(~m));
}
template <class TIn, class TOut> struct BlockRef { const TIn* Q; const TIn* K; const TIn* V; TOut* O; int P0; const float* cb; const TIn* Gt; };
template <class TIn> struct Seam {
    bf16x8 qr[8];
    bf16x8 st_v0, st_v1, st_k0, st_k1; f32x4 sf0, sf1, sf2, sf3;
    f32x4 tq[16];
};
__device__ __forceinline__ int swa_jlo(int P0, int W) { const int lowk = P0 - W + 1; return lowk > 0 ? lowk / KVBLK : 0; }
#define ROW(p, k0, rr) ((p) + (size_t)((k0) + (rr)) * PQ + sc)
#define VMW() asm volatile("s_waitcnt vmcnt(0)" ::: "memory")
#define VMWN(n) asm volatile("s_waitcnt vmcnt(%0)" :: "i"(n) : "memory")
#define SLOAD_H(Kp, Vp, k0) do { S.st_v0 = load8<TIn>(ROW(Vp, k0, sr)); S.st_v1 = load8<TIn>(ROW(Vp, k0, 32 + sr));              \
                         S.st_k0 = load8<TIn>(ROW(Kp, k0, sr)); S.st_k1 = load8<TIn>(ROW(Kp, k0, 32 + sr)); } while (0)
#define SWRITE_HK(bf) do { *(bf16x8*)(K_lds + (bf) * SHM_K + kws) = S.st_k0; *(bf16x8*)(K_lds + (bf) * SHM_K + kws + 32 * 256) = S.st_k1; } while (0)
#define SWRITE_HV(bf) do { *(bf16x8*)(V_lds + (bf) * SHM_V + vst0) = S.st_v0; *(bf16x8*)(V_lds + (bf) * SHM_V + vst1) = S.st_v1; } while (0)
#define SWRITE_H(bf) do { SWRITE_HV(bf); SWRITE_HK(bf); } while (0)
#define SLOAD_F(p, k0) do { S.sf0 = *(const f32x4*)ROW(p, k0, sr); S.sf1 = *(const f32x4*)(ROW(p, k0, sr) + 4);                \
                            S.sf2 = *(const f32x4*)ROW(p, k0, 32 + sr); S.sf3 = *(const f32x4*)(ROW(p, k0, 32 + sr) + 4); } while (0)
#define SWRITE_KF(bf) do { *(bf16x8*)(K_lds + (bf) * SHM_K + kws) = pack8(S.sf0, S.sf1); *(bf16x8*)(K_lds + (bf) * SHM_K + kws + 32 * 256) = pack8(S.sf2, S.sf3); } while (0)
#define SWRITE_VF(bf) do { *(bf16x8*)(V_lds + (bf) * SHM_V + vst0) = pack8(S.sf0, S.sf1); *(bf16x8*)(V_lds + (bf) * SHM_V + vst1) = pack8(S.sf2, S.sf3); } while (0)
template <class TIn, class TOut>
__device__ __forceinline__ void causal_swa_prime(const BlockRef<TIn, TOut>& cur, int W, char* lds, Seam<TIn>& S) {
    constexpr bool F32 = same_t<TIn, float>::v;
    int tid_l = threadIdx.x; asm volatile("" : "+v"(tid_l)); const int tid = tid_l, wid = __builtin_amdgcn_readfirstlane(tid >> 6), lane = tid & 63, r32 = lane & 31, hi = lane >> 5;
    const int sr = tid >> 4, sc = (tid & 15) * 8, kws = KSWZ(sr, sc * 2); char* K_lds = lds + 2 * SHM_V;
    const int kb0 = swa_jlo(cur.P0, W) * KVBLK;
    for (int d0 = 0; d0 < 8; ++d0) S.qr[d0] = load8<TIn>(cur.Q + (size_t)(wid * QBLK + r32) * PQ + d0 * 16 + hi * 8);
    if constexpr (F32) { SLOAD_F((const float*)cur.K, kb0); VMW(); SWRITE_KF(0); SBAR(); SLOAD_F((const float*)cur.V, kb0); }
    else { SLOAD_H(cur.K, cur.V, kb0); VMW(); SWRITE_HK(0); }
    __syncthreads();
}
template <class TIn, class TOut>
__device__ __forceinline__ void causal_swa_block(const BlockRef<TIn, TOut>& cur, const BlockRef<TIn, TOut>& nxt, int skv, int W, char* lds, Seam<TIn>& S) {
    constexpr bool F32 = same_t<TIn, float>::v;
    int tid_l = threadIdx.x; asm volatile("" : "+v"(tid_l)); const int tid = tid_l, wid = __builtin_amdgcn_readfirstlane(tid >> 6), lane = tid & 63, r32 = lane & 31, hi = lane >> 5;
    const int j_lo = swa_jlo(cur.P0, W);
    int j_hi = (cur.P0 + QB - 1) / KVBLK + 1; if (j_hi > skv / KVBLK) j_hi = skv / KVBLK;
    const int NT = j_hi - j_lo;
    const int kbn = swa_jlo(nxt.P0, W) * KVBLK;
    const int qlo = cur.P0 + wid * QBLK, qm = qlo + r32 - 4 * hi;
    char* V_lds = lds; char* K_lds = lds + 2 * SHM_V;
    float* ws = (float*)(lds + 2 * SHM_V + 2 * SHM_K) + wid * 64; float* li_l = ws, * al_l = ws + 32;
    float m_reg = -1e30f, l_reg = 0; f32x16 o[4] = {};
    float* cbl = (float*)(lds + LDS_CB);
    { const float cref = cur.cb[cur.P0]; const float rs = 1.0f / SCALE;
      for (int i = tid; i < cur.P0 + QB; i += 64 * NW) cbl[i] = (cref - cur.cb[i]) * rs;
      __syncthreads(); }
    const float* cbh = cbl + 4 * hi;
    const int sr = tid >> 4, sc = (tid & 15) * 8, vst0 = v_st(sr, sc), vst1 = v_st(32 + sr, sc), kws = KSWZ(sr, sc * 2);
    const int vb0 = (int)(uintptr_t)V_lds + v_rd_base(lane);
    const TIn* Kh = cur.K; const TIn* Vh = cur.V;
#define RESC(a) do { if (__any((a) < 1.f)) { if (hi == 0) al_l[r32] = (a); asm volatile("s_waitcnt lgkmcnt(0)" ::: "memory");              \
                     for (int d_ = 0; d_ < 4; ++d_) for (int r = 0; r < 16; ++r) o[d_][r] *= al_l[crow(r, hi)]; } } while (0)
#define KBASE(t) ((j_lo + (t)) * KVBLK)
#define ACT(t) (KBASE(t) <= qlo + QBLK - 1 && KBASE(t) + KVBLK - 1 >= qlo - W + 1)
#define MASKT(P0_, P1_, t) do { const int kb_ = KBASE(t); if ((!SK || ACT(t)) && (kb_ + KVBLK - 1 > qlo || kb_ <= qlo + QBLK - 1 - W)) mask_tile(P0_, P1_, qm - kb_, (unsigned)W); } while (0)
    constexpr int NQL = F32 ? 16 : 8;
    constexpr bool SK = WSKIP && !F32;
#define SEAM_K0() do { VMWN(NQL); if constexpr (F32) { SWRITE_KF(0); SBAR(); SLOAD_F((const float*)nxt.V, kbn); } else { SWRITE_HK(0); } SBAR(); } while (0)
    f32x16 pA0, pA1, pB0, pB1; float mnA, mnB, alA, alB; bf16x8 pa0, pa1, pa2, pa3;
    if constexpr (F32) { VMW(); SWRITE_VF(0); SBAR(); } else { SWRITE_HV(0); SBAR(); }
    if (NT > 1) { if constexpr (F32) SLOAD_F((const float*)Kh, KBASE(1)); else SLOAD_H(Kh, Vh, KBASE(1)); }
    bias_init(pA0, pA1, cbh + KBASE(0)); if (NT > 1) bias_init(pB0, pB1, cbh + KBASE(1));
    SBAR(); qkt<0, SK>(pA0, pA1, K_lds, r32, hi, S.qr, ACT(0), cbh + KBASE(0));
    if constexpr (F32) { if (NT > 1) { VMW(); SWRITE_KF(1); SBAR(); SLOAD_F((const float*)Vh, KBASE(1)); } }
    MASKT(pA0, pA1, 0); partialSM(pA0, pA1, m_reg, mnA, alA);
    if (NT > 1) { VMW(); if constexpr (F32) { SWRITE_VF(1); SBAR(); if (NT > 2) SLOAD_F((const float*)Kh, KBASE(2)); } else SWRITE_H(1); }
    __syncthreads();
#define HALF_STEP(PX0, PX1, mnX, alX, PY0, PY1, alY, t, KB, VB, SB) do {                                                      \
        SBAR(); qkt<KB, SK>(PX0, PX1, K_lds, r32, hi, S.qr, ACT(t), cbh + KBASE(t));                             \
        finishSM(PY0, PY1, alY, l_reg, pa0, pa1, pa2, pa3); SBAR();                                                           \
        if ((t) + 1 < NT) bias_init(PY0, PY1, cbh + KBASE((t) + 1));                                                          \
        if ((t) + 1 < NT) { if constexpr (F32) { VMW(); SWRITE_KF(SB); SBAR(); SLOAD_F((const float*)Vh, KBASE((t) + 1)); }  \
                            else { SLOAD_H(Kh, Vh, KBASE((t) + 1)); } SBAR(); }                                               \
        pv_tile<VB, SK>(o, vb0, pa0, pa1, pa2, pa3, ACT((t) - 1)); MASKT(PX0, PX1, (t)); partialSM(PX0, PX1, m_reg, mnX, alX);                                        \
        __syncthreads();                                                                                                      \
        if ((t) + 1 < NT) { VMW(); if constexpr (F32) { SWRITE_VF(SB); SBAR(); if ((t) + 2 < NT) SLOAD_F((const float*)Kh, KBASE((t) + 2)); } \
                            else { SWRITE_H(SB); } }                                                                          \
        RESC(alX); __syncthreads(); } while (0)
    for (int t = 1; t + 1 < NT; t += 2) {
        HALF_STEP(pB0, pB1, mnB, alB, pA0, pA1, alA, t, 1, 0, 0);
        HALF_STEP(pA0, pA1, mnA, alA, pB0, pB1, alB, t + 1, 0, 1, 1);
    }
    const bool even = (NT & 1) == 0;
    if (even) { SBAR(); qkt<1, SK>(pB0, pB1, K_lds, r32, hi, S.qr, ACT(NT - 1), cbh + KBASE(NT - 1)); SBAR(); }
#define QROW(e) (nxt.Q + (size_t)(wid * QBLK + r32) * PQ + ((e) >> 1) * 16 + hi * 8 + ((e) & 1) * 4)
    if constexpr (F32) { SLOAD_F((const float*)nxt.K, kbn); SBAR();
#pragma unroll
        for (int e = 0; e < 8; ++e) S.tq[e] = *(const f32x4*)QROW(e); }
    else { SLOAD_H(nxt.K, nxt.V, kbn); SBAR();
#pragma unroll
        for (int d0 = 0; d0 < 8; ++d0) S.qr[d0] = load8<TIn>(nxt.Q + (size_t)(wid * QBLK + r32) * PQ + d0 * 16 + hi * 8); }
    SBAR();
    finishSM(pA0, pA1, alA, l_reg, pa0, pa1, pa2, pa3); SBAR();
    if constexpr (F32) {
#pragma unroll
        for (int e = 8; e < 16; ++e) S.tq[e] = *(const f32x4*)QROW(e); SBAR(); }
#undef QROW
    pv_tile<0, SK>(o, vb0, pa0, pa1, pa2, pa3, ACT(even ? NT - 2 : NT - 1));
    if (even) { MASKT(pB0, pB1, NT - 1); partialSM(pB0, pB1, m_reg, mnB, alB); __syncthreads(); RESC(alB);
        finishSM(pB0, pB1, alB, l_reg, pa0, pa1, pa2, pa3); SBAR(); pv_tile<1, SK>(o, vb0, pa0, pa1, pa2, pa3, ACT(NT - 1)); }
    SBAR(); SEAM_K0();
    if (hi == 0) li_l[r32] = l_reg; asm volatile("s_waitcnt lgkmcnt(0)" ::: "memory");
    float rli[16];
#pragma unroll
    for (int r = 0; r < 16; ++r) rli[r] = __builtin_amdgcn_rcpf(li_l[crow(r, hi)]);
    TOut* Ow = cur.O + (size_t)(wid * QBLK) * PO; const TIn* Gw = cur.Gt + (size_t)(wid * QBLK) * PQ;
#pragma unroll
    for (int r = 0; r < 16; ++r) { const int orow = crow(r, hi);
#pragma unroll
        for (int d0 = 0; d0 < 4; ++d0) { const float gv = (float)Gw[(size_t)orow * PQ + d0 * 32 + r32]; const float v = o[d0][r] * rli[r] * __builtin_amdgcn_rcpf(1.0f + __expf(-gv));
            if constexpr (same_t<TOut, float>::v) { Ow[(size_t)orow * PO + d0 * 32 + r32] = v; }
            else { const float vn = __shfl_xor(v, 1);
                   if ((r32 & 1) == 0) *(unsigned*)(Ow + (size_t)orow * PO + d0 * 32 + r32) = cvtpk(v, vn); } } }
    if constexpr (F32) {
#pragma unroll
        for (int d0 = 0; d0 < 8; ++d0) S.qr[d0] = pack8(S.tq[2 * d0], S.tq[2 * d0 + 1]); }
    __syncthreads();
#undef RESC
#undef KBASE
#undef ACT
#undef MASKT
#undef SEAM_K0
#undef HALF_STEP
}
#undef ROW
#undef VMW
#undef VMWN
#undef SLOAD_H
#undef SWRITE_HK
#undef SWRITE_HV
#undef SWRITE_H
#undef SLOAD_F
#undef SWRITE_KF
#undef SWRITE_VF

}
constexpr int NTOK = 16384, DMOD = 2048, SEQL = 4096, NBAT = 4;
constexpr int ABIN = 6144, FFH = 5632, FF2 = 11264, CINW = 8208, CINP = 8448;
constexpr float RMS_EPS = 1e-6f;
constexpr size_t WS_WABIN = 0;
constexpr size_t WS_WABOUT = WS_WABIN + (size_t)ABIN * DMOD * 2;
constexpr size_t WS_WCIN = WS_WABOUT + (size_t)DMOD * DMOD * 2;
constexpr size_t WS_WCOUT = WS_WCIN + (size_t)CINP * DMOD * 2;
constexpr size_t WS_WUP0 = WS_WCOUT + (size_t)DMOD * DMOD * 2;
constexpr size_t WS_WUP1 = WS_WUP0 + (size_t)FF2 * DMOD * 2;
constexpr size_t WS_WDN0 = WS_WUP1 + (size_t)FF2 * DMOD * 2;
constexpr size_t WS_WDN1 = WS_WDN0 + (size_t)DMOD * FFH * 2;
constexpr size_t WS_ACT = WS_WDN1 + (size_t)DMOD * FFH * 2;
constexpr size_t WS_BIG = WS_ACT + (size_t)NTOK * DMOD * 2;
constexpr size_t WS_Z1 = WS_BIG;
constexpr size_t WS_HL = WS_Z1 + (size_t)NTOK * ABIN * 2;
constexpr size_t WS_DEC = WS_HL + (size_t)32 * 64 * 128 * 128 * 2;
constexpr size_t WS_END_AB = WS_DEC + (size_t)32 * 64 * 128 * 4;
constexpr size_t WS_GA = WS_BIG;
constexpr size_t WS_HALO = WS_GA + (size_t)NTOK * FFH * 2;
constexpr size_t WS_END_FFN = WS_HALO + (size_t)256 * 4 * FF2 * 4;
constexpr size_t WS_QKVG = WS_BIG;
constexpr size_t WS_F = WS_QKVG + (size_t)NTOK * 8192 * 2;
constexpr size_t WS_C = WS_F + (size_t)2 * NTOK * 16 * 4;
constexpr size_t WS_END_C = WS_C + (size_t)64 * 4096 * 4;
constexpr size_t WS_NEED = WS_END_FFN > WS_END_AB ? (WS_END_FFN > WS_END_C ? WS_END_FFN : WS_END_C) : (WS_END_AB > WS_END_C ? WS_END_AB : WS_END_C);
constexpr size_t WS_BAR = (WS_NEED + 255) / 256 * 256;
constexpr size_t WS_TOTAL = WS_BAR + 16384;
constexpr int LDS_BYTES = 147456, LDS_MISC = LDS_BYTES - 128;
constexpr int LDS_BYTES_UNUSED = 0;

#define LAS __attribute__((address_space(3)))
typedef unsigned short bfu;
typedef unsigned v4u __attribute__((ext_vector_type(4)));
typedef float f32x4 __attribute__((ext_vector_type(4)));
typedef short bf16x8 __attribute__((ext_vector_type(8)));
#define LDS_WAIT() asm volatile("s_waitcnt lgkmcnt(0)" ::: "memory")
typedef float f32x2_t __attribute__((ext_vector_type(2))); typedef __bf16 bf16x2_t __attribute__((ext_vector_type(2)));
__device__ __forceinline__ unsigned pk2(float lo, float hi) { f32x2_t v = {lo, hi}; bf16x2_t b = __builtin_convertvector(v, bf16x2_t); return __builtin_bit_cast(unsigned, b); }
__device__ __forceinline__ unsigned f2bf(float f) { return pk2(f, 0.f) & 0xffffu; }
__device__ __forceinline__ float bf2f(unsigned h) { return __builtin_bit_cast(float, h << 16); }
__device__ __forceinline__ float bflo(unsigned w) { return __builtin_bit_cast(float, w << 16); }
__device__ __forceinline__ float bfhi(unsigned w) { return __builtin_bit_cast(float, w & 0xffff0000u); }
__device__ __forceinline__ float sigmoidf_(float x) { return __builtin_amdgcn_rcpf(1.0f + __expf(-x)); }
__device__ __forceinline__ float gelu_erf(float x) { return 0.5f * x * (1.0f + erff(x * 0.70710678118654752f)); }
__device__ __forceinline__ void gelu2(float& a, float& b) { const pg8::f32x2 r = pg8::gelu_pk((pg8::f32x2){a, b}); a = r.x; b = r.y; }
__device__ __forceinline__ float wave_sum(float v) {
#pragma unroll
    for (int o = 1; o < 64; o <<= 1) v += __shfl_xor(v, o);
    return v;
}
__device__ __forceinline__ bf16x8 pack8f(f32x4 a, f32x4 b) { v4u w = {pk2(a[0], a[1]), pk2(a[2], a[3]), pk2(b[0], b[1]), pk2(b[2], b[3])}; return __builtin_bit_cast(bf16x8, w); }
#define MFMA16(a, b, c) __builtin_amdgcn_mfma_f32_16x16x32_bf16((a), (b), (c), 0, 0, 0)

__device__ __forceinline__ void tr_item64(const float* W, int ldw, int K, bfu* WT, int nblk, int item, LAS float* scr, int lane, bool ab_remap = false) {
    const int kb = item / nblk, nb = item - kb * nblk, k0 = 64 * kb, n0 = 64 * nb;
    int d0 = n0; if (ab_remap) { const int bj = n0 >= FFH ? 1 : 0, rem = n0 - bj * FFH; d0 = (rem >> 7) * 256 + bj * 128 + (rem & 127); }
    const int q = lane & 15, kr = lane >> 4;
    f32x4 v[16];
#pragma unroll
    for (int i = 0; i < 16; ++i) v[i] = *(const f32x4*)(W + (size_t)(k0 + 4 * i + kr) * ldw + n0 + 4 * q);
#pragma unroll
    for (int i = 0; i < 16; ++i) { LAS float* s = scr + (4 * i + kr) * 65 + 4 * q; s[0] = v[i][0]; s[1] = v[i][1]; s[2] = v[i][2]; s[3] = v[i][3]; }
    LDS_WAIT(); asm volatile("" ::: "memory");
    const int c = lane & 7;
#pragma unroll
    for (int j = 0; j < 8; ++j) { const int n = (lane >> 3) + 8 * j; const LAS float* s = scr + (8 * c) * 65 + n;
        v4u o; o.x = pk2(s[0], s[65]); o.y = pk2(s[130], s[195]); o.z = pk2(s[260], s[325]); o.w = pk2(s[390], s[455]);
        *(v4u*)(WT + (size_t)(d0 + n) * K + k0 + 8 * c) = o; }
    LDS_WAIT(); asm volatile("" ::: "memory");
}
template <bool NT = false> __device__ __forceinline__ void rms_rows(const float* X, const float* gain, bfu* O, int gw, int NGW, int lane) {
    f32x4 gv[8];
#pragma unroll
    for (int j = 0; j < 8; ++j) gv[j] = ((const f32x4*)gain)[64 * j + lane];
    for (int m = gw; m < NTOK; m += NGW) {
        const f32x4* xr = (const f32x4*)(X + (size_t)m * DMOD) + lane;
        f32x4 v[8]; float s = 0.f;
#pragma unroll
        for (int j = 0; j < 8; ++j) { v[j] = NT ? __builtin_nontemporal_load(xr + 64 * j) : xr[64 * j]; s += (v[j][0] * v[j][0] + v[j][1] * v[j][1]) + (v[j][2] * v[j][2] + v[j][3] * v[j][3]); }
        const float r = rsqrtf(wave_sum(s) * (1.0f / DMOD) + RMS_EPS);
        unsigned long long* o8 = (unsigned long long*)(O + (size_t)m * DMOD) + lane;
#pragma unroll
        for (int j = 0; j < 8; ++j) { const f32x4 y = v[j] * r * gv[j]; o8[64 * j] = (unsigned long long)pk2(y[0], y[1]) | ((unsigned long long)pk2(y[2], y[3]) << 32); }
    }
}

__device__ __forceinline__ void gmlp_tile(int tile, const bfu* Z1, const float* spw, const float* spb, const float* vgain, bfu* Y, LAS unsigned char* lds, int tid, int wave, int lane) {
    const int h = tile & 7, bc = tile >> 3; const size_t tok0 = (size_t)bc * 128;
    LAS bfu* vnT = (LAS bfu*)lds;
    { const int s = tid >> 2, part = tid & 3;
      const bfu* src = Z1 + (tok0 + s) * ABIN + 1024 + h * 128 + 32 * part;
      v4u raw[4];
#pragma unroll
      for (int i = 0; i < 4; ++i) raw[i] = ((const v4u*)src)[i];
      float g[32]; float ss = 0.f;
#pragma unroll
      for (int i = 0; i < 4; ++i)
#pragma unroll
          for (int j = 0; j < 4; ++j) { float a = bflo(raw[i][j]), b = bfhi(raw[i][j]); gelu2(a, b); g[8 * i + 2 * j] = a; g[8 * i + 2 * j + 1] = b; ss += a * a + b * b; }
      ss += __shfl_xor(ss, 1); ss += __shfl_xor(ss, 2);
      const float r = rsqrtf(ss * (1.0f / 128.0f) + RMS_EPS);
      const float* gp = vgain + h * 128 + 32 * part;
#pragma unroll
      for (int e = 0; e < 32; ++e) vnT[(32 * part + e) * 136 + s] = (bfu)f2bf(g[e] * r * gp[e]);
    }
    __syncthreads();
    const int fr = lane & 15, fq = lane >> 4, t0 = 16 * wave, trow = t0 + fr;
    f32x4 acc[8];
#pragma unroll
    for (int nb = 0; nb < 8; ++nb) acc[nb] = (f32x4){0.f, 0.f, 0.f, 0.f};
    const float* wrow = spw + (size_t)(h * 128 + trow) * 128;
    const int nks = (t0 + 15) / 32 + 1;
    for (int ks = 0; ks < nks; ++ks) {
        const int s0 = 32 * ks + 8 * fq;
        f32x4 w0 = *(const f32x4*)(wrow + s0), w1 = *(const f32x4*)(wrow + s0 + 4);
#pragma unroll
        for (int j = 0; j < 4; ++j) { if (s0 + j > trow) w0[j] = 0.f; if (s0 + 4 + j > trow) w1[j] = 0.f; }
        const bf16x8 a = pack8f(w0, w1);
#pragma unroll
        for (int nb = 0; nb < 8; ++nb) { const bf16x8 b = *(const LAS bf16x8*)(vnT + (16 * nb + fr) * 136 + 32 * ks + 8 * fq); acc[nb] = MFMA16(a, b, acc[nb]); }
    }
#pragma unroll
    for (int i = 0; i < 4; ++i) { const int t = t0 + 4 * fq + i; const float bias = spb[h * 128 + t];
        const bfu* up = Z1 + (tok0 + t) * ABIN + h * 128 + fr; bfu* yp = Y + (tok0 + t) * DMOD + h * 128 + fr;
#pragma unroll
        for (int nb = 0; nb < 8; nb += 2) { float u0 = bf2f(up[16 * nb]), u1 = bf2f(up[16 * nb + 16]); gelu2(u0, u1);
            yp[16 * nb] = (bfu)f2bf(u0 * (acc[nb][i] + bias)); yp[16 * nb + 16] = (bfu)f2bf(u1 * (acc[nb + 1][i] + bias)); } }
    __syncthreads();
}

__device__ __forceinline__ float hgrn_lb(const float* gamma, int col) {
    const float g0 = gamma[col], g1 = gamma[1024 + col], g2 = gamma[2048 + col]; const float mx = fmaxf(g0, fmaxf(g1, g2));
    const float e0 = __expf(g0 - mx), e1 = __expf(g1 - mx), e2 = __expf(g2 - mx); return e0 / (e0 + e1 + e2);
}
__device__ __forceinline__ void hgrn_local_tile(int tile, const bfu* Z1, const float* gamma, bfu* HL, float* DEC, LAS unsigned char* lds, int tid, int wave, int lane) {
    const int bh = tile >> 6, c = tile & 63, b = bh >> 3, h = bh & 7; const size_t tok0 = (size_t)b * SEQL + c * 64;
    LAS float* segsum = (LAS float*)lds; LAS bfu* keT = (LAS bfu*)(lds + 2048); LAS bfu* vT = (LAS bfu*)(lds + 2048 + 18432);
    const int seg = tid >> 7, k = tid & 127;
    const float lb = hgrn_lb(gamma, h * 128 + k);
    float fl[16], G[16]; float run = 0.f;
#pragma unroll
    for (int i = 0; i < 16; ++i) { fl[i] = bf2f(Z1[(tok0 + 16 * seg + i) * ABIN + 3072 + h * 128 + k]); run += __logf(lb + (1.0f - lb) * sigmoidf_(fl[i])); G[i] = run; }
    segsum[seg * 128 + k] = run;
    unsigned vw[8];
#pragma unroll
    for (int i = 0; i < 8; ++i) vw[i] = (unsigned)Z1[(tok0 + 16 * seg + 2 * i) * ABIN + 4096 + h * 128 + k] | ((unsigned)Z1[(tok0 + 16 * seg + 2 * i + 1) * ABIN + 4096 + h * 128 + k] << 16);
    *(LAS v4u*)(vT + k * 72 + 16 * seg) = (v4u){vw[0], vw[1], vw[2], vw[3]}; *(LAS v4u*)(vT + k * 72 + 16 * seg + 8) = (v4u){vw[4], vw[5], vw[6], vw[7]};
    __syncthreads();
    float pre = 0.f, tot = 0.f;
#pragma unroll
    for (int s = 0; s < 4; ++s) { const float v = segsum[s * 128 + k]; if (s < seg) pre += v; tot += v; }
    unsigned kw[8];
#pragma unroll
    for (int i = 0; i < 8; ++i) { const float k0 = (1.0f - lb) * sigmoidf_(-fl[2 * i]) * __expf(tot - (pre + G[2 * i])), k1 = (1.0f - lb) * sigmoidf_(-fl[2 * i + 1]) * __expf(tot - (pre + G[2 * i + 1])); kw[i] = pk2(k0, k1); }
    *(LAS v4u*)(keT + k * 72 + 16 * seg) = (v4u){kw[0], kw[1], kw[2], kw[3]}; *(LAS v4u*)(keT + k * 72 + 16 * seg + 8) = (v4u){kw[4], kw[5], kw[6], kw[7]};
    if (seg == 3) DEC[(size_t)(bh * 64 + c) * 128 + k] = __expf(tot);
    __syncthreads();
    const int fr = lane & 15, fq = lane >> 4;
    f32x4 acc[8];
#pragma unroll
    for (int nb = 0; nb < 8; ++nb) acc[nb] = (f32x4){0.f, 0.f, 0.f, 0.f};
#pragma unroll
    for (int ks = 0; ks < 2; ++ks) { const bf16x8 a = *(const LAS bf16x8*)(vT + (16 * wave + fr) * 72 + 32 * ks + 8 * fq);
#pragma unroll
        for (int nb = 0; nb < 8; ++nb) { const bf16x8 bb = *(const LAS bf16x8*)(keT + (16 * nb + fr) * 72 + 32 * ks + 8 * fq); acc[nb] = MFMA16(a, bb, acc[nb]); } }
    LAS bfu* Lt = (LAS bfu*)(lds + 40960);
#pragma unroll
    for (int i = 0; i < 4; ++i)
#pragma unroll
        for (int nb = 0; nb < 8; ++nb) Lt[(16 * wave + 4 * fq + i) * 136 + 16 * nb + fr] = (bfu)f2bf(acc[nb][i]);
    __syncthreads();
    bfu* Lp = HL + (size_t)(bh * 64 + c) * 16384;
#pragma unroll
    for (int j = 0; j < 4; ++j) { const int idx = tid + 512 * j, row = idx >> 4, ch = idx & 15; *(v4u*)(Lp + row * 128 + ch * 8) = *(const LAS v4u*)(Lt + row * 136 + ch * 8); }
    __syncthreads();
}
__device__ __forceinline__ void hgrn_out_tile(int tile, const bfu* Z1, const float* gamma, const float* ogain, const bfu* HL, bfu* Y, LAS unsigned char* lds, int tid, int wave, int lane) {
    const int bh = tile >> 6, c = tile & 63, b = bh >> 3, h = bh & 7; const size_t tok0 = (size_t)b * SEQL + c * 64;
    LAS float* segsum = (LAS float*)lds; LAS float* ssq = (LAS float*)(lds + 2048);
    LAS bfu* qd = (LAS bfu*)(lds + 4096); LAS bfu* kd = qd + 64 * 136; LAS bfu* vT = kd + 64 * 136; LAS bfu* Pm = vT + 128 * 72;
    const int seg = tid >> 7, k = tid & 127;
    const int fr = lane & 15, fq = lane >> 4, tb = wave >> 1, wh = wave & 1;
    const float lb = hgrn_lb(gamma, h * 128 + k);
    unsigned flraw[16], qraw[16], vraw[16], graw[4][4];
#pragma unroll
    for (int i = 0; i < 16; ++i) { const bfu* rp = Z1 + (tok0 + 16 * seg + i) * ABIN + h * 128 + k; flraw[i] = rp[3072]; vraw[i] = rp[4096]; qraw[i] = rp[2048]; }
#pragma unroll
    for (int i = 0; i < 4; ++i)
#pragma unroll
        for (int j = 0; j < 4; ++j) graw[i][j] = Z1[(tok0 + 16 * tb + 4 * fq + i) * ABIN + 5120 + h * 128 + 16 * (4 * wh + j) + fr];
    float fl[16], G[16]; float run = 0.f;
#pragma unroll
    for (int i = 0; i < 16; ++i) { fl[i] = bf2f(flraw[i]); run += __logf(lb + (1.0f - lb) * sigmoidf_(fl[i])); G[i] = run; }
    segsum[seg * 128 + k] = run;
    unsigned vw[8];
#pragma unroll
    for (int i = 0; i < 8; ++i) vw[i] = vraw[2 * i] | (vraw[2 * i + 1] << 16);
    *(LAS v4u*)(vT + k * 72 + 16 * seg) = (v4u){vw[0], vw[1], vw[2], vw[3]}; *(LAS v4u*)(vT + k * 72 + 16 * seg + 8) = (v4u){vw[4], vw[5], vw[6], vw[7]};
    __syncthreads();
    float pre = 0.f;
#pragma unroll
    for (int s = 0; s < 3; ++s) { const float v = segsum[s * 128 + k]; if (s < seg) pre += v; }
#pragma unroll
    for (int i = 0; i < 16; ++i) { const int t = 16 * seg + i; const float Gt = pre + G[i]; const float qv = bf2f(qraw[i]);
        qd[t * 136 + k] = (bfu)f2bf(qv * __expf(Gt)); kd[t * 136 + k] = (bfu)f2bf((1.0f - lb) * sigmoidf_(-fl[i]) * __expf(-Gt)); }
    const bfu* Sg = HL + (size_t)(bh * 64 + c) * 16384;
    bf16x8 sfr[4][4];
#pragma unroll
    for (int ks = 0; ks < 4; ++ks)
#pragma unroll
        for (int j = 0; j < 4; ++j) sfr[ks][j] = *(const bf16x8*)(Sg + (16 * (4 * wh + j) + fr) * 128 + 32 * ks + 8 * fq);
    __syncthreads();
#pragma unroll
    for (int jj = 0; jj < 2; ++jj) { const int sb = 2 * wh + jj; f32x4 sc = (f32x4){0.f, 0.f, 0.f, 0.f};
        if (sb <= tb) {
#pragma unroll
            for (int ks = 0; ks < 4; ++ks) { const bf16x8 a = *(const LAS bf16x8*)(qd + (16 * tb + fr) * 136 + 32 * ks + 8 * fq), bb = *(const LAS bf16x8*)(kd + (16 * sb + fr) * 136 + 32 * ks + 8 * fq); sc = MFMA16(a, bb, sc); } }
#pragma unroll
        for (int i = 0; i < 4; ++i) { const int t = 16 * tb + 4 * fq + i, s = 16 * sb + fr; Pm[t * 72 + s] = (bfu)f2bf(s <= t ? sc[i] : 0.f); } }
    __syncthreads();
    f32x4 acc[4];
#pragma unroll
    for (int j = 0; j < 4; ++j) acc[j] = (f32x4){0.f, 0.f, 0.f, 0.f};
#pragma unroll
    for (int ks = 0; ks < 2; ++ks) { const bf16x8 a = *(const LAS bf16x8*)(Pm + (16 * tb + fr) * 72 + 32 * ks + 8 * fq);
#pragma unroll
        for (int j = 0; j < 4; ++j) { const bf16x8 bb = *(const LAS bf16x8*)(vT + (16 * (4 * wh + j) + fr) * 72 + 32 * ks + 8 * fq); acc[j] = MFMA16(a, bb, acc[j]); } }
#pragma unroll
    for (int ks = 0; ks < 4; ++ks) { const bf16x8 a = *(const LAS bf16x8*)(qd + (16 * tb + fr) * 136 + 32 * ks + 8 * fq);
#pragma unroll
        for (int j = 0; j < 4; ++j) acc[j] = MFMA16(a, sfr[ks][j], acc[j]); }
#pragma unroll
    for (int i = 0; i < 4; ++i) { float pp = (acc[0][i] * acc[0][i] + acc[1][i] * acc[1][i]) + (acc[2][i] * acc[2][i] + acc[3][i] * acc[3][i]);
        pp += __shfl_xor(pp, 1); pp += __shfl_xor(pp, 2); pp += __shfl_xor(pp, 4); pp += __shfl_xor(pp, 8);
        if (fr == 0) ssq[wave * 16 + 4 * fq + i] = pp; }
    __syncthreads();
#pragma unroll
    for (int i = 0; i < 4; ++i) { const int t = 16 * tb + 4 * fq + i; const float r = rsqrtf((ssq[wave * 16 + 4 * fq + i] + ssq[(wave ^ 1) * 16 + 4 * fq + i]) * (1.0f / 128.0f) + RMS_EPS);
#pragma unroll
        for (int j = 0; j < 4; ++j) { const int v = 16 * (4 * wh + j) + fr; const float gt = bf2f(graw[i][j]);
            Y[(tok0 + t) * DMOD + 1024 + h * 128 + v] = (bfu)f2bf(acc[j][i] * r * ogain[v] * gt * sigmoidf_(gt)); } }
    __syncthreads();
}


#ifndef EN_ATTN
#define EN_ATTN 1
#endif
#ifndef EN_MIXAB
#define EN_MIXAB 1
#endif
#ifndef EN_GEMM
#define EN_GEMM 1
#endif
#define XB_TMO      128
#define XB_XCNT(j)  (256  + 64 * (j))
#define XB_XSUB(j)  (1280 + 64 * (j))
#define XB_XGEN(j)  (2304 + 64 * (j))
#define XB_TOP      3328
#define XB_TOPGEN   3392
#define XCD_BAR_WORDS 3456
#define XB_SPIN_CAP (1u << 18)

__device__ __forceinline__ unsigned xb_ld(unsigned* p)              { return __hip_atomic_load(p, __ATOMIC_RELAXED, __HIP_MEMORY_SCOPE_AGENT); }
__device__ __forceinline__ unsigned xb_add(unsigned* p, unsigned v) { return __hip_atomic_fetch_add(p, v, __ATOMIC_RELAXED, __HIP_MEMORY_SCOPE_AGENT); }
__device__ __forceinline__ unsigned xb_xcc_id() { return (unsigned)__builtin_amdgcn_s_getreg((3 << 11) | 20) & 0xFu; }
#define XB_SPIN(cond, bar) do { unsigned _sp = 0; while (cond) { __builtin_amdgcn_s_sleep(1); \
    if ((++_sp & 255u) == 0u) { if (xb_ld(&(bar)[XB_TMO])) break; if (_sp > XB_SPIN_CAP) { atomicAdd(&(bar)[XB_TMO], 1u); break; } } } } while (0)

struct XcdBarrier {
    unsigned* bar; unsigned x;
    volatile LAS unsigned* st;
};

__device__ __forceinline__ XcdBarrier xcd_barrier_post(unsigned* bar, volatile LAS unsigned* st) {
    XcdBarrier b; b.bar = bar; b.x = xb_xcc_id(); b.st = st;
    if (threadIdx.x == 0) (void)xb_add(&bar[XB_XCNT(b.x)], 1u);
    return b;
}
__device__ __forceinline__ void xcd_barrier_complete(unsigned* bar, unsigned x, unsigned& nloc, unsigned& nx) {
    const unsigned G = gridDim.x * gridDim.y * gridDim.z;
    unsigned sum, cnt, mine, sp = 0u;
    for (;;) {
        sum = 0u; cnt = 0u; mine = 0u;
#pragma unroll
        for (unsigned j = 0; j < 16; ++j) { const unsigned c = xb_ld(&bar[XB_XCNT(j)]); sum += c; cnt += (c > 0u) ? 1u : 0u; mine = (j == x) ? c : mine; }
        if (sum == G) break;
        __builtin_amdgcn_s_sleep(1);
        if ((++sp & 255u) == 0u) { if (xb_ld(&bar[XB_TMO])) break; if (sp > XB_SPIN_CAP) { atomicAdd(&bar[XB_TMO], 1u); break; } }
    }
    nloc = mine > 0u ? mine : 1u; nx = cnt > 0u ? cnt : 1u;
}

__device__ __forceinline__ void xcd_barrier(const XcdBarrier& b) {
    asm volatile("s_waitcnt vmcnt(0)" ::: "memory");
    __syncthreads();
    if (threadIdx.x == 0) {
        unsigned* bar = b.bar;
        __builtin_amdgcn_s_waitcnt(0);
        unsigned nloc = b.st[0], nx = b.st[1];
        if (nloc == 0u) { xcd_barrier_complete(bar, b.x, nloc, nx); b.st[0] = nloc; b.st[1] = nx; }
        const unsigned old = xb_add(&bar[XB_XSUB(b.x)], 1u);
        const unsigned gen = old / nloc;
        if (old + 1u == (gen + 1u) * nloc) {
            __builtin_amdgcn_fence(__ATOMIC_RELEASE, "agent");
            asm volatile("s_waitcnt vmcnt(0)" ::: "memory");
            const unsigned og = xb_add(&bar[XB_TOP], 1u);
            const unsigned tg = og / nx;
            if (og + 1u == (tg + 1u) * nx) xb_add(&bar[XB_TOPGEN], 1u);
            else XB_SPIN(xb_ld(&bar[XB_TOPGEN]) == tg, bar);
            __builtin_amdgcn_fence(__ATOMIC_ACQUIRE, "agent");
            xb_add(&bar[XB_XGEN(b.x)], 1u);
            asm volatile("s_waitcnt vmcnt(0)" ::: "memory");
        } else {
            XB_SPIN(xb_ld(&bar[XB_XGEN(b.x)]) == gen, bar);
            __builtin_amdgcn_fence(__ATOMIC_ACQUIRE, "agent");
            asm volatile("s_waitcnt vmcnt(0)" ::: "memory");
        }
    }
    __syncthreads();
}

struct Params { const float* in[19]; float* out; unsigned char* ws; };
#define ARG(p_, i_) ([&]() -> const float* { int k_ = (i_); asm volatile("" : "+s"(k_)); return (p_).in[k_]; }())
#define PHASE_IDS() int tid = threadIdx.x; asm volatile("" : "+v"(tid)); const int lane = tid & 63, wave = __builtin_amdgcn_readfirstlane(tid >> 6); \
    const int G = gridDim.x, gw = blockIdx.x * 8 + wave, NGW = G * 8; const long gtid = (long)blockIdx.x * 512 + tid, NGT = (long)G * 512; (void)lane; (void)gw; (void)NGW; (void)gtid; (void)NGT

template <class Epi> __device__ __forceinline__ void run_gemm(LAS unsigned char* lds, const bfu* A, const bfu* Bt, int M, int N, int K, const Epi& E, bool revn = false) {
#if EN_GEMM
    pg8::Gemm g{A, Bt, M, N, K}; pg8::StaticOrder S; S.init(M, N, (int)gridDim.x, (int)blockIdx.x); S.revn = revn;
    pg8::gemm_phase<Epi, pg8::StaticOrder, true, true>(lds, g, S, E);
#endif
}

struct TrDesc { const float* src; bfu* dst; int ldw, K; };
__device__ __forceinline__ TrDesc tr_decode(const Params& p, int item) {
    constexpr int I0 = 96 * 32, I1 = 32 * 32, I2 = 128 * 32, I3 = 32 * 32, I4 = 176 * 32, I5 = 32 * 88;
    unsigned char* ws = p.ws; const float* W; bfu* WT; int ldw, K, nblk; bool remap = false; int r = item;
    if (r < I0) { W = ARG(p, 2); WT = (bfu*)(ws + WS_WABIN); ldw = ABIN; K = DMOD; nblk = 96; }
    else if ((r -= I0) < I1) { W = ARG(p, 8); WT = (bfu*)(ws + WS_WABOUT); ldw = DMOD; K = DMOD; nblk = 32; }
    else if ((r -= I1) < I2) { W = ARG(p, 9); WT = (bfu*)(ws + WS_WCIN); ldw = CINW; K = DMOD; nblk = 128; }
    else if ((r -= I2) < I3) { W = ARG(p, 13); WT = (bfu*)(ws + WS_WCOUT); ldw = DMOD; K = DMOD; nblk = 32; }
    else if ((r -= I3) < I4) { W = ARG(p, 15); WT = (bfu*)(ws + WS_WUP0); ldw = FF2; K = DMOD; nblk = 176; remap = true; }
    else if ((r -= I4) < I4) { W = ARG(p, 15) + (size_t)DMOD * FF2; WT = (bfu*)(ws + WS_WUP1); ldw = FF2; K = DMOD; nblk = 176; remap = true; }
    else if ((r -= I4) < I5) { W = ARG(p, 18); WT = (bfu*)(ws + WS_WDN0); ldw = DMOD; K = FFH; nblk = 32; }
    else { r -= I5; W = ARG(p, 18) + (size_t)FFH * DMOD; WT = (bfu*)(ws + WS_WDN1); ldw = DMOD; K = FFH; nblk = 32; }
    const int kb = r / nblk, nb = r - kb * nblk, k0 = 64 * kb, n0 = 64 * nb;
    int d0 = n0; if (remap) { const int bj = n0 >= FFH ? 1 : 0, rem = n0 - bj * FFH; d0 = (rem >> 7) * 256 + bj * 128 + (rem & 127); }
    TrDesc d; d.src = W + (size_t)k0 * ldw + n0; d.dst = WT + (size_t)d0 * K + k0; d.ldw = ldw; d.K = K; return d;
}
__device__ __forceinline__ void tr_load(const TrDesc& d, f32x4 (&v)[16], int lane) {
    const float* s = d.src + (size_t)(lane >> 4) * d.ldw + 4 * (lane & 15);
#pragma unroll
    for (int i = 0; i < 16; ++i) v[i] = __builtin_nontemporal_load((const f32x4*)(s + (size_t)(4 * i) * d.ldw));
}
__device__ __forceinline__ void tr_finish(const TrDesc& d, const f32x4 (&v)[16], LAS float* scr, int lane) {
    const int q = lane & 15, kr = lane >> 4;
#pragma unroll
    for (int i = 0; i < 16; ++i) { LAS float* s = scr + (4 * i + kr) * 65 + 4 * q; s[0] = v[i][0]; s[1] = v[i][1]; s[2] = v[i][2]; s[3] = v[i][3]; }
    LDS_WAIT(); asm volatile("" ::: "memory");
    const int c = lane & 7;
#pragma unroll
    for (int j = 0; j < 8; ++j) { const int n = (lane >> 3) + 8 * j; const LAS float* s = scr + (8 * c) * 65 + n;
        v4u o; o.x = pk2(s[0], s[65]); o.y = pk2(s[130], s[195]); o.z = pk2(s[260], s[325]); o.w = pk2(s[390], s[455]);
        *(v4u*)(d.dst + (size_t)n * d.K + 8 * c) = o; }
    LDS_WAIT(); asm volatile("" ::: "memory");
}
__device__ __forceinline__ void p0_phase(const Params& p, LAS unsigned char* lds) {
    PHASE_IDS(); unsigned char* ws = p.ws;
    bfu* Wcin = (bfu*)(ws + WS_WCIN);
    LAS float* scr = (LAS float*)(lds + wave * 16640);
    constexpr int NIT = 96 * 32 + 32 * 32 + 128 * 32 + 32 * 32 + 2 * 176 * 32 + 2 * 32 * 88;
    f32x4 va[16], vb[16]; TrDesc da, db; int it = gw;
    if (it < NIT) { da = tr_decode(p, it); tr_load(da, va, lane); }
    for (; it < NIT; it += 2 * NGW) {
        const int it1 = it + NGW, it2 = it + 2 * NGW;
        if (it1 < NIT) { db = tr_decode(p, it1); tr_load(db, vb, lane); }
        tr_finish(da, va, scr, lane);
        if (it2 < NIT) { da = tr_decode(p, it2); tr_load(da, va, lane); }
        if (it1 < NIT) tr_finish(db, vb, scr, lane);
    }
    for (long i = gtid; i < 16 * DMOD; i += NGT) { const int j = (int)(i / DMOD), kk = (int)(i % DMOD); Wcin[(size_t)(8192 + j) * DMOD + kk] = (bfu)f2bf(ARG(p, 9)[(size_t)kk * CINW + 8192 + j]); }
    rms_rows<true>(ARG(p, 0), ARG(p, 1), (bfu*)(ws + WS_ACT), gw, NGW, lane);
}
__device__ __forceinline__ void norm_phase(const float* X, const float* gain, bfu* O) { PHASE_IDS(); rms_rows<true>(X, gain, O, gw, NGW, lane); }

__device__ __forceinline__ void mixab_phase1(const Params& p, LAS unsigned char* lds) {
#if EN_MIXAB
    PHASE_IDS(); unsigned char* ws = p.ws; const bfu* Z1 = (const bfu*)(ws + WS_Z1);
    for (int t = blockIdx.x; t < 1024 + 2048; t += G) {
        if (t < 1024) gmlp_tile(t, Z1, ARG(p, 3), ARG(p, 4), ARG(p, 5), (bfu*)(ws + WS_ACT), lds, tid, wave, lane);
        else hgrn_local_tile(t - 1024, Z1, ARG(p, 6), (bfu*)(ws + WS_HL), (float*)(ws + WS_DEC), lds, tid, wave, lane);
    }
#endif
}
__device__ __forceinline__ void hgrn_scan_phase(const Params& p) {
    PHASE_IDS(); bfu* HL = (bfu*)(p.ws + WS_HL); const float* DEC = (const float*)(p.ws + WS_DEC);
    typedef unsigned u32x2 __attribute__((ext_vector_type(2)));
    for (long e = gtid; e < 32L * 128 * 32; e += NGT) {
        const int bh = (int)(e >> 12), vq = (int)(e & 4095);
        bfu* base = HL + (size_t)bh * 64 * 16384 + (size_t)vq * 4; const float* db = DEC + (size_t)bh * 64 * 128 + (vq & 31) * 4;
        f32x4 s = (f32x4){0.f, 0.f, 0.f, 0.f};
        for (int c0 = 0; c0 < 64; c0 += 16) {
            u32x2 Lc[16]; f32x4 dc[16];
#pragma unroll
            for (int u = 0; u < 16; ++u) { Lc[u] = *(const u32x2*)(base + (size_t)(c0 + u) * 16384); dc[u] = *(const f32x4*)(db + (c0 + u) * 128); }
#pragma unroll
            for (int u = 0; u < 16; ++u) { *(u32x2*)(base + (size_t)(c0 + u) * 16384) = (u32x2){pk2(s[0], s[1]), pk2(s[2], s[3])};
                s = dc[u] * s + (f32x4){bflo(Lc[u][0]), bfhi(Lc[u][0]), bflo(Lc[u][1]), bfhi(Lc[u][1])}; }
        }
    }
}
__device__ __forceinline__ void mixab_phase3(const Params& p, LAS unsigned char* lds) {
#if EN_MIXAB
    PHASE_IDS(); unsigned char* ws = p.ws;
    for (int t = blockIdx.x; t < 2048; t += G) hgrn_out_tile(t, (const bfu*)(ws + WS_Z1), ARG(p, 6), ARG(p, 7), (const bfu*)(ws + WS_HL), (bfu*)(ws + WS_ACT), lds, tid, wave, lane);
#endif
}
__device__ __forceinline__ void fgate_phase(const Params& p) {
    PHASE_IDS(); const bfu* A = (const bfu*)(p.ws + WS_ACT); const bfu* Bw = (const bfu*)(p.ws + WS_WCIN) + (size_t)8192 * DMOD; float* Fb = (float*)(p.ws + WS_F);
    const int fr = lane & 15, fq = lane >> 4;
    for (int it = gw; it < 2 * (NTOK / 16); it += NGW) {
        const int rb = it >> 1, kh = it & 1;
        const bfu* ap = A + (size_t)(16 * rb + fr) * DMOD + 8 * fq + 1024 * kh; const bfu* bp = Bw + (size_t)fr * DMOD + 8 * fq + 1024 * kh;
        f32x4 acc0 = (f32x4){0.f, 0.f, 0.f, 0.f}, acc1 = acc0;
#pragma unroll 8
        for (int ks = 0; ks < 32; ks += 2) {
            const bf16x8 a0 = *(const bf16x8*)(ap + 32 * ks), b0 = *(const bf16x8*)(bp + 32 * ks), a1 = *(const bf16x8*)(ap + 32 * ks + 32), b1 = *(const bf16x8*)(bp + 32 * ks + 32);
            acc0 = MFMA16(a0, b0, acc0); acc1 = MFMA16(a1, b1, acc1); }
#pragma unroll
        for (int i = 0; i < 4; ++i) Fb[(size_t)kh * NTOK * 16 + (size_t)(16 * rb + 4 * fq + i) * 16 + fr] = acc0[i] + acc1[i];
    }
}
__device__ __forceinline__ void qknorm_phase(const Params& p) {
    PHASE_IDS(); const float* Fb = (const float*)(p.ws + WS_F); float* Cb = (float*)(p.ws + WS_C);
    if (gw < 64) {
        const int bh = gw, b = bh >> 4, h = bh & 15; const float bf_ = ARG(p, 10)[h];
        const float* fp = Fb + ((size_t)b * SEQL + 64 * lane) * 16 + h;
        float tot = 0.f;
        for (int i = 0; i < 64; ++i) { const float z = fp[i * 16] + fp[(size_t)NTOK * 16 + i * 16] + bf_; tot += fminf(z, 0.f) - log1pf(__expf(-fabsf(z))); }
        float inc = tot;
#pragma unroll
        for (int o = 1; o < 64; o <<= 1) { const float u = __shfl_up(inc, o); if (lane >= o) inc += u; }
        float run = inc - tot;
        float* cp = Cb + (size_t)bh * SEQL + 64 * lane;
        for (int i = 0; i < 64; ++i) { const float z = fp[i * 16] + fp[(size_t)NTOK * 16 + i * 16] + bf_; run += fminf(z, 0.f) - log1pf(__expf(-fabsf(z))); cp[i] = run; }
    }
}
__device__ __forceinline__ void attn_phase(const Params& p, char* ldsg) {
#if EN_ATTN
    using bfh = __hip_bfloat16; typedef fox::BlockRef<bfh, bfh> BR;
    const bfh* Qb = (const bfh*)(p.ws + WS_QKVG); bfh* Yb = (bfh*)(p.ws + WS_ACT); const float* Cb = (const float*)(p.ws + WS_C);
    const int total = 512, stride = gridDim.x;
    float margin;
    { const float* qg = ARG(p, 11); const float* kg = ARG(p, 12); float a = 0.f, b = 0.f;
#pragma unroll 8
      for (int i = 0; i < 128; ++i) { a = fmaxf(a, fabsf(qg[i])); b = fmaxf(b, fabsf(kg[i])); }
      margin = 110.0f + 2.0f * 1.01f * 128.0f * a * b * fox::SCALE;
      margin = __builtin_bit_cast(float, __builtin_amdgcn_readfirstlane(__builtin_bit_cast(int, margin))); }
#define FOX_ID(L_, pass_) const int bh_ = ((L_) & 7) + 8 * ((L_) >> 6), x_ = ((L_) >> 3) & 7, qb_ = (pass_) ? 15 - x_ : x_, b_ = bh_ >> 4, h_ = bh_ & 15
#define FOX_REF(r, L_, pass_, sk_) do { FOX_ID(L_, pass_); \
        const size_t SEC_ = (size_t)NTOK * 2048, hb_ = (size_t)bh_ * SEQL * 128, rq_ = hb_ + (size_t)qb_ * 256 * 128; \
        (r).Q = Qb + rq_; (r).K = Qb + SEC_ + hb_ + (size_t)(sk_) * 128; (r).V = Qb + 2 * SEC_ + hb_ + (size_t)(sk_) * 128; (r).Gt = Qb + 3 * SEC_ + rq_; \
        (r).O = Yb + ((size_t)b_ * SEQL + (size_t)qb_ * 256) * 2048 + h_ * 128; (r).P0 = qb_ * 256 - (sk_); (r).cb = Cb + (size_t)bh_ * SEQL + (sk_); } while (0)
    int sk00 = 0, sk01 = 0, sk10 = 0, sk11 = 0;
#define FOX_SKIP(dst, L_, pass_) do { FOX_ID(L_, pass_); (void)b_; (void)h_; dst = fox::fox_jlo(Cb + (size_t)bh_ * SEQL, qb_ * 256, margin) * 64; } while (0)
    { const int L0 = blockIdx.x, L1 = blockIdx.x + stride;
      if (L0 < total) { FOX_SKIP(sk00, L0, 0); FOX_SKIP(sk01, L0, 1); }
      if (L1 < total) { FOX_SKIP(sk10, L1, 0); FOX_SKIP(sk11, L1, 1); } }
#define FOX_SK(L_, pass_) ((L_) == (int)blockIdx.x ? ((pass_) ? sk01 : sk00) : (L_) == (int)blockIdx.x + stride ? ((pass_) ? sk11 : sk10) : 0)
    int L = blockIdx.x;
    if (L < total) {
        int pass = 0; BR cur; FOX_REF(cur, L, 0, FOX_SK(L, 0));
        fox::Seam<bfh> S;
        fox::causal_swa_prime<bfh, bfh>(cur, SEQL, ldsg, S);
        for (;;) {
            const bool more_pass = pass == 0, more_item = L + stride < total, last = !more_pass && !more_item;
            int passn = pass + 1, Ln = L;
            if (!more_pass) { passn = 0; Ln = more_item ? L + stride : L; }
            BR nxt = cur; if (!last) FOX_REF(nxt, Ln, passn, FOX_SK(Ln, passn));
            fox::causal_swa_block<bfh, bfh>(cur, nxt, SEQL, SEQL, ldsg, S);
            if (last) break;
            cur = nxt; pass = passn; L = Ln;
        }
#undef FOX_SK
#undef FOX_SKIP
#undef FOX_ID
#undef FOX_REF
    }
#endif
}
__device__ __forceinline__ void conv_fix_phase(const float* HALO, const float* cw, const float* cbv, bfu* GA) {
    PHASE_IDS();
    for (long e = gtid; e < 256L * 2 * 1408; e += NGT) {
        const int cq = (int)(e % 1408), gr = (int)(e / 1408), r = gr & 1, g = gr >> 1;
        const int c = cq * 4, cp = (c >> 7) * 256 + (c & 127);
        const bool first = (g & 63) == 0;
        const float* H = HALO + (size_t)g * 4 * FF2 + cp; const float* Hp = first ? H : H - 4 * FF2;
        const f32x4 zero = (f32x4){0.f, 0.f, 0.f, 0.f};
        const f32x4 za = *(const f32x4*)(H + r * FF2), zb = *(const f32x4*)(H + r * FF2 + 128);
        f32x4 za1, zb1, za2, zb2;
        if (r == 0) { za1 = *(const f32x4*)(Hp + 3 * FF2); zb1 = *(const f32x4*)(Hp + 3 * FF2 + 128); za2 = *(const f32x4*)(Hp + 2 * FF2); zb2 = *(const f32x4*)(Hp + 2 * FF2 + 128); if (first) { za1 = zero; zb1 = zero; za2 = zero; zb2 = zero; } }
        else { za1 = *(const f32x4*)(H); zb1 = *(const f32x4*)(H + 128); za2 = *(const f32x4*)(Hp + 3 * FF2); zb2 = *(const f32x4*)(Hp + 3 * FF2 + 128); if (first) { za2 = zero; zb2 = zero; } }
        const f32x4 a = *(const f32x4*)(cbv + c) + *(const f32x4*)(cw + c) * za2 + *(const f32x4*)(cw + FF2 + c) * za1 + *(const f32x4*)(cw + 2 * FF2 + c) * za;
        const f32x4 b = *(const f32x4*)(cbv + FFH + c) + *(const f32x4*)(cw + FFH + c) * zb2 + *(const f32x4*)(cw + FF2 + FFH + c) * zb1 + *(const f32x4*)(cw + 2 * FF2 + FFH + c) * zb;
        float gv[4];
#pragma unroll
        for (int i = 0; i < 4; ++i) gv[i] = a[i] * sigmoidf_(a[i]) * b[i];
        *(unsigned long long*)(GA + ((size_t)g * 64 + r) * FFH + c) = (unsigned long long)pk2(gv[0], gv[1]) | ((unsigned long long)pk2(gv[2], gv[3]) << 32);
    }
}
#define GSYNC() xcd_barrier(xbar)
template <int LAYER> __device__ __forceinline__ void ffn_block(const Params& p, LAS unsigned char* lds, const XcdBarrier& xbar) {
    unsigned char* ws = p.ws; bfu* ACT = (bfu*)(ws + WS_ACT); bfu* GA = (bfu*)(ws + WS_GA); float* HALO = (float*)(ws + WS_HALO);
    const bfu* Wup = (const bfu*)(ws + (LAYER ? WS_WUP1 : WS_WUP0)); const bfu* Wdn = (const bfu*)(ws + (LAYER ? WS_WDN1 : WS_WDN0));
    const float* cw = ARG(p, 16) + (size_t)LAYER * 3 * FF2; const float* cbv = ARG(p, 17) + (size_t)LAYER * FF2;
    norm_phase(p.out, ARG(p, 14) + (size_t)LAYER * DMOD, ACT);
    GSYNC();
    { pg8::EpiConvGate E{GA, HALO, cw, cbv}; run_gemm(lds, ACT, Wup, NTOK, FF2, DMOD, E, true); }
    GSYNC();
    conv_fix_phase(HALO, cw, cbv, GA);
    GSYNC();
    { pg8::EpiResF32 E{p.out, p.out, DMOD}; run_gemm(lds, GA, Wdn, NTOK, DMOD, FFH, E); }
}

__global__ void __launch_bounds__(512, 2) fwd_mega(Params p) {
    extern __shared__ __attribute__((aligned(16))) unsigned char lds_raw[];
    LAS unsigned char* lds = (LAS unsigned char*)lds_raw;
    unsigned char* ws = p.ws; bfu* ACT = (bfu*)(ws + WS_ACT);
    unsigned* barw = (unsigned*)(ws + WS_BAR);
    if (blockIdx.x == 0) for (int i = threadIdx.x; i < 4096; i += 512) barw[i] = 0u;
    if (threadIdx.x < 32) ((LAS unsigned*)(lds + LDS_MISC))[threadIdx.x] = 0u;
    cg::this_grid().sync();
    const XcdBarrier xbar = xcd_barrier_post(barw, (volatile LAS unsigned*)(lds + LDS_MISC));
    p0_phase(p, lds);
    GSYNC();
    { pg8::EpiBf16<0> E{(bfu*)(ws + WS_Z1), ABIN, nullptr, 0, 0, 1.f}; run_gemm(lds, ACT, (const bfu*)(ws + WS_WABIN), NTOK, ABIN, DMOD, E); }
    GSYNC();
    mixab_phase1(p, lds);
    GSYNC();
    hgrn_scan_phase(p);
    GSYNC();
    mixab_phase3(p, lds);
    GSYNC();
    { pg8::EpiResF32 E{ARG(p, 0), p.out, DMOD}; run_gemm(lds, ACT, (const bfu*)(ws + WS_WABOUT), NTOK, DMOD, DMOD, E); }
    GSYNC();
    ffn_block<0>(p, lds, xbar);
    GSYNC();
    norm_phase(p.out, ARG(p, 1) + DMOD, ACT);
    GSYNC();
    { pg8::EpiCin E{(bfu*)(ws + WS_QKVG), ARG(p, 11), ARG(p, 12), (LAS float*)(lds + 131072)}; run_gemm(lds, ACT, (const bfu*)(ws + WS_WCIN), NTOK, 8192, DMOD, E); }
    fgate_phase(p);
    GSYNC();
    qknorm_phase(p);
    GSYNC();
    attn_phase(p, (char*)lds_raw);
    GSYNC();
    { pg8::EpiResF32 E{p.out, p.out, DMOD}; run_gemm(lds, ACT, (const bfu*)(ws + WS_WCOUT), NTOK, DMOD, DMOD, E); }
    GSYNC();
    ffn_block<1>(p, lds, xbar);
}

extern "C" void kernel_launch(void* const* d_in, const int* in_sizes, int n_in, void* d_out, int out_size, void* d_ws, size_t ws_size, hipStream_t stream) {
    static int grid = 0;
    if (grid == 0) {
        if (n_in != 19 || in_sizes[0] != NTOK * DMOD || out_size != NTOK * DMOD || ws_size < WS_TOTAL) {
            fprintf(stderr, "kernel_launch: shape/workspace mismatch (n_in %d, in0 %d, out %d, ws %zu, need %zu)\n", n_in, n_in > 0 ? in_sizes[0] : -1, out_size, ws_size, (size_t)WS_TOTAL); grid = -1; return; }
        int dev = 0, cus = 0, per_cu = 0;
        (void)hipGetDevice(&dev); (void)hipDeviceGetAttribute(&cus, hipDeviceAttributeMultiprocessorCount, dev);
        if (hipFuncSetAttribute((const void*)fwd_mega, hipFuncAttributeMaxDynamicSharedMemorySize, LDS_BYTES) != hipSuccess) { fprintf(stderr, "kernel_launch: hipFuncSetAttribute failed\n"); grid = -1; return; }
        if (hipOccupancyMaxActiveBlocksPerMultiprocessor(&per_cu, (const void*)fwd_mega, 512, LDS_BYTES) != hipSuccess || per_cu < 1) { fprintf(stderr, "kernel_launch: occupancy query says %d\n", per_cu); per_cu = 1; }
        (void)hipGetLastError();
        grid = cus > 0 ? cus : 256;
    }
    if (grid < 0) return;
    Params prm{};
    for (int i = 0; i < 19; ++i) prm.in[i] = (const float*)d_in[i];
    prm.out = (float*)d_out; prm.ws = (unsigned char*)d_ws;
    void* args[] = {&prm};
    hipError_t e = hipLaunchCooperativeKernel((const void*)fwd_mega, dim3(grid), dim3(512), args, LDS_BYTES, stream);
    if (e != hipSuccess) fprintf(stderr, "kernel_launch: cooperative launch failed: %s (grid %d)\n", hipGetErrorString(e), grid);
}
```

```cpp
#include <hip/hip_runtime.h>
#include <hip/hip_bf16.h>
#include <hip/hip_cooperative_groups.h>
#include <cstdio>
#include <cstdint>
#include <cmath>
namespace cg = cooperative_groups;
namespace pg8 {
#define PG8_LAS __attribute__((address_space(3)))
typedef unsigned short bf16_t;
typedef short bf16x8 __attribute__((ext_vector_type(8)));
typedef float f32x4 __attribute__((ext_vector_type(4)));
typedef unsigned u32x4 __attribute__((ext_vector_type(4)));
constexpr int BM = 256, BK = 64, HALF = 128, HTB = HALF * BK * 2  , STAGE_BYTES = 8 * HTB, NXCD = 8, WGM = 8;

__host__ __device__ __forceinline__ int lds_byte(int r, int c) { const int st = (r >> 4) * 2 + (c >> 5), rr = r & 15, cc = c & 31, ob = rr * 64 + cc * 2; return st * 1024 + (ob ^ (((ob >> 9) & 1) << 5)); }
__host__ __device__ __forceinline__ void stage_rc(int b, int& R, int& C) { const int st = b / 1024, sb = b % 1024, swz = sb ^ (((sb >> 9) & 1) << 5); R = (st >> 1) * 16 + swz / 64; C = (st & 1) * 32 + (swz % 64) / 2; }
__host__ __device__ __forceinline__ int perm32(int rho) { const int n = rho >> 4, i = rho & 15; return 8 * (i >> 2) + 4 * n + (i & 3); }

struct Unit { int pm, pn; };
struct Gemm { const bf16_t* A; const bf16_t* Bt; int M, N, K; };

struct StaticOrder {
    int nM, nN, nwg, G, c;
    __host__ __device__ void init(int M, int N, int G_, int c_) { nM = M / BM; nN = N / BM; nwg = nM * nN; G = G_; c = c_; }
    __host__ __device__ bool next(int i, Unit& u) const {
        const long L = (long)i * G + c; if (L >= nwg) return false;
        int wgid = (int)L; { const int q = nwg / NXCD, r = nwg % NXCD, xcd = wgid % NXCD, off = wgid / NXCD; wgid = (xcd < r ? xcd * (q + 1) : r * (q + 1) + (xcd - r) * q) + off; }
        const int nig = WGM * nN, gid = wgid / nig, fm = gid * WGM, gsz = (nM - fm) < WGM ? (nM - fm) : WGM;
        u.pm = fm + ((wgid % nig) % gsz); u.pn = (wgid % nig) / gsz; return true;
    }
    __device__ __forceinline__ void a_ready(const Unit&) const {}
    __device__ __forceinline__ void done(const Unit&) const {}
};

__device__ __forceinline__ unsigned cvt_pk_bf16(float lo, float hi) { unsigned r; asm volatile("v_cvt_pk_bf16_f32 %0, %1, %2" : "=v"(r) : "v"(lo), "v"(hi)); return r; }
typedef float f32x2 __attribute__((ext_vector_type(2)));
__device__ __forceinline__ f32x2 gelu_pk(f32x2 v) {
    const f32x2 av = __builtin_elementwise_abs(v), d = av * 0.2316418882f + 1.0f;
    f32x2 t; t.x = __builtin_amdgcn_rcpf(d.x); t.y = __builtin_amdgcn_rcpf(d.y);
    f32x2 q = t * 0.5307027145f + (-0.7265760135f); q = q * t + 0.7107068705f; q = q * t + (-0.142248368f); q = q * t + 0.127414796f; q = q * t;
    const f32x2 s = (v * v) * (-0.72134752044f);
    f32x2 e; e.x = __builtin_amdgcn_exp2f(s.x); e.y = __builtin_amdgcn_exp2f(s.y);
    const f32x2 m = v * (q * e), r = v - m;
    f32x2 o; o.x = v.x < 0.f ? m.x : r.x; o.y = v.y < 0.f ? m.y : r.y; return o;
}

template <int ACT  > struct EpiBf16 {
    static constexpr bool PERM = true, AFTER_DRAIN = false; static_assert(ACT == 0 || ACT == 1, "EpiBf16: ACT is 0 (none) or 1 (gelu_pk)");
    bf16_t* O; int ldc; const float* bias; int split_cols; size_t split_stride; float scale0;
    __device__ __forceinline__ void operator()(const f32x4 (&acc)[2][2][4][2], const Unit& u, int wr, int wc, int fr, int fq) const {
        const int row0 = u.pm * BM + wr * 64 + fr; int colt = u.pn * BM; bf16_t* base = O;
        float sc = 1.f; if (split_cols) { const int t = colt / split_cols; base += (size_t)t * split_stride; colt -= t * split_cols; if (t == 0) sc = scale0; }
        const int col0 = colt + wc * 32 + 8 * fq, bcol0 = u.pn * BM + wc * 32 + 8 * fq;
        f32x4 bv[2][2];
#pragma unroll
        for (int bj = 0; bj < 2; ++bj)
#pragma unroll
            for (int n = 0; n < 2; ++n) bv[bj][n] = bias ? *(const f32x4*)(bias + bcol0 + bj * HALF + 4 * n) : (f32x4){0.f, 0.f, 0.f, 0.f};
#pragma unroll
        for (int ai = 0; ai < 2; ++ai)
#pragma unroll
            for (int m = 0; m < 4; ++m) { bf16_t* rowp = base + (size_t)(row0 + ai * HALF + m * 16) * ldc + col0;
#pragma unroll
                for (int bj = 0; bj < 2; ++bj) { f32x4 v0 = acc[ai][bj][m][0] + bv[bj][0], v1 = acc[ai][bj][m][1] + bv[bj][1];
                    if (ACT == 1) { f32x2 a = gelu_pk((f32x2){v0[0], v0[1]}), b = gelu_pk((f32x2){v0[2], v0[3]}), c = gelu_pk((f32x2){v1[0], v1[1]}), d = gelu_pk((f32x2){v1[2], v1[3]});
                        v0 = (f32x4){a.x, a.y, b.x, b.y}; v1 = (f32x4){c.x, c.y, d.x, d.y}; }
                    v0 = v0 * sc; v1 = v1 * sc; u32x4 w; w.x = cvt_pk_bf16(v0[0], v0[1]); w.y = cvt_pk_bf16(v0[2], v0[3]); w.z = cvt_pk_bf16(v1[0], v1[1]); w.w = cvt_pk_bf16(v1[2], v1[3]);
                    *(u32x4*)(rowp + bj * HALF) = w; } }
    }
};
struct EpiResF32 {
    static constexpr bool PERM = false, AFTER_DRAIN = false;
    const float* res; float* out; int ldc;
    __device__ __forceinline__ void operator()(const f32x4 (&acc)[2][2][4][2], const Unit& u, int wr, int wc, int fr, int fq) const {
        const int col0 = u.pn * BM + wc * 32 + 4 * fq;
#pragma unroll
        for (int ai = 0; ai < 2; ++ai)
#pragma unroll
            for (int m = 0; m < 4; ++m) { const size_t off = (size_t)(u.pm * BM + ai * HALF + wr * 64 + m * 16 + fr) * ldc + col0;
#pragma unroll
                for (int bj = 0; bj < 2; ++bj)
#pragma unroll
                    for (int n = 0; n < 2; ++n) { const f32x4 bs = *(const f32x4*)(res + off + bj * HALF + n * 16); *(f32x4*)(out + off + bj * HALF + n * 16) = bs + acc[ai][bj][m][n]; } }
    }
};
struct EpiCin {
    static constexpr bool PERM = true, AFTER_DRAIN = false;
    bf16_t* O; const float* qg; const float* kg; PG8_LAS float* X;
    __device__ __forceinline__ void operator()(const f32x4 (&acc)[2][2][4][2], const Unit& u, int wr, int wc, int fr, int fq) const {
        const int sec = u.pn >> 3, h0 = (u.pn & 7) * 2, b = u.pm >> 4, s0 = (u.pm & 15) * BM + wr * 64 + fr;
        bf16_t* base = O + (size_t)sec * ((size_t)16384 * 2048) + ((size_t)(b * 16 + h0) * 4096) * 128 + wc * 32 + 8 * fq;
        const bool nrm = sec < 2;
        f32x4 g0 = (f32x4){1.f, 1.f, 1.f, 1.f}, g1 = g0;
        if (nrm) {
            const float* gp = (sec ? kg : qg) + wc * 32 + 8 * fq; g0 = *(const f32x4*)gp; g1 = *(const f32x4*)(gp + 4);
#pragma unroll
            for (int ai = 0; ai < 2; ++ai)
#pragma unroll
                for (int m = 0; m < 4; ++m)
#pragma unroll
                    for (int bj = 0; bj < 2; ++bj) { const f32x4 v0 = acc[ai][bj][m][0], v1 = acc[ai][bj][m][1];
                        float ss = ((v0[0] * v0[0] + v0[1] * v0[1]) + (v0[2] * v0[2] + v0[3] * v0[3])) + ((v1[0] * v1[0] + v1[1] * v1[1]) + (v1[2] * v1[2] + v1[3] * v1[3]));
                        ss += __shfl_xor(ss, 16); ss += __shfl_xor(ss, 32);
                        if (fq == 0) X[((ai * HALF + wr * 64 + m * 16 + fr) * 2 + bj) * 4 + wc] = ss; }
            asm volatile("s_waitcnt lgkmcnt(0)" ::: "memory"); __builtin_amdgcn_s_barrier(); asm volatile("" ::: "memory");
        }
#pragma unroll
        for (int ai = 0; ai < 2; ++ai)
#pragma unroll
            for (int m = 0; m < 4; ++m) { bf16_t* rowp = base + (size_t)(s0 + ai * HALF + m * 16) * 128;
#pragma unroll
                for (int bj = 0; bj < 2; ++bj) { f32x4 v0 = acc[ai][bj][m][0], v1 = acc[ai][bj][m][1];
                    if (nrm) { const f32x4 pp = *(const PG8_LAS f32x4*)(X + ((ai * HALF + wr * 64 + m * 16 + fr) * 2 + bj) * 4);
                        const float r = __builtin_amdgcn_rsqf(((pp[0] + pp[1]) + (pp[2] + pp[3])) * (1.0f / 128.0f) + 1e-6f); v0 = v0 * r * g0; v1 = v1 * r * g1; }
                    u32x4 w; w.x = cvt_pk_bf16(v0[0], v0[1]); w.y = cvt_pk_bf16(v0[2], v0[3]); w.z = cvt_pk_bf16(v1[0], v1[1]); w.w = cvt_pk_bf16(v1[2], v1[3]);
                    *(u32x4*)(rowp + (size_t)bj * 4096 * 128) = w; } }
    }
};
__device__ __forceinline__ float dpp_ror1(float v) { return __builtin_bit_cast(float, __builtin_amdgcn_update_dpp(0, __builtin_bit_cast(int, v), 0x121, 0xF, 0xF, false)); }
__device__ __forceinline__ float dpp_ror2(float v) { return __builtin_bit_cast(float, __builtin_amdgcn_update_dpp(0, __builtin_bit_cast(int, v), 0x122, 0xF, 0xF, false)); }
struct EpiConvGate {
    static constexpr bool PERM = true, AFTER_DRAIN = false;
    bf16_t* GA; float* HALO; const float* cw; const float* cb;
    __device__ __forceinline__ void operator()(const f32x4 (&acc)[2][2][4][2], const Unit& u, int wr, int wc, int fr, int fq) const {
        constexpr int F2 = 11264, FH = 5632;
        const int cl = wc * 32 + 8 * fq, ca = u.pn * 128 + cl, ct = u.pn * 256 + cl;
        const bool f1 = fr >= 1, f2 = fr >= 2;
#pragma unroll
        for (int n = 0; n < 2; ++n) {
            const f32x4 wa0 = *(const f32x4*)(cw + ca + 4 * n), wa1 = *(const f32x4*)(cw + F2 + ca + 4 * n), wa2 = *(const f32x4*)(cw + 2 * F2 + ca + 4 * n), ba = *(const f32x4*)(cb + ca + 4 * n);
            const f32x4 wb0 = *(const f32x4*)(cw + FH + ca + 4 * n), wb1 = *(const f32x4*)(cw + F2 + FH + ca + 4 * n), wb2 = *(const f32x4*)(cw + 2 * F2 + FH + ca + 4 * n), bb = *(const f32x4*)(cb + FH + ca + 4 * n);
#pragma unroll
            for (int ai = 0; ai < 2; ++ai) {
                const int grp = u.pm * 4 + ai * 2 + wr;
                f32x4 pa1 = (f32x4){0.f, 0.f, 0.f, 0.f}, pa2 = pa1, pb1 = pa1, pb2 = pa1;
#pragma unroll
                for (int m = 0; m < 4; ++m) {
                    const f32x4 za = acc[ai][0][m][n], zb = acc[ai][1][m][n];
                    f32x4 ra1, ra2, rb1, rb2;
#pragma unroll
                    for (int i = 0; i < 4; ++i) { ra1[i] = dpp_ror1(za[i]); ra2[i] = dpp_ror2(za[i]); rb1[i] = dpp_ror1(zb[i]); rb2[i] = dpp_ror2(zb[i]); }
                    f32x4 a, b;
#pragma unroll
                    for (int i = 0; i < 4; ++i) { const float a1 = f1 ? ra1[i] : pa1[i], a2 = f2 ? ra2[i] : pa2[i], b1 = f1 ? rb1[i] : pb1[i], b2 = f2 ? rb2[i] : pb2[i];
                        a[i] = ba[i] + wa0[i] * a2 + wa1[i] * a1 + wa2[i] * za[i]; b[i] = bb[i] + wb0[i] * b2 + wb1[i] * b1 + wb2[i] * zb[i]; }
                    pa1 = ra1; pa2 = ra2; pb1 = rb1; pb2 = rb2;
                    float g[4];
#pragma unroll
                    for (int i = 0; i < 4; ++i) g[i] = a[i] * __builtin_amdgcn_rcpf(1.0f + __expf(-a[i])) * b[i];
                    const size_t row = (size_t)grp * 64 + m * 16 + fr;
                    unsigned long long w = (unsigned long long)cvt_pk_bf16(g[0], g[1]) | ((unsigned long long)cvt_pk_bf16(g[2], g[3]) << 32);
                    *(unsigned long long*)(GA + row * FH + ca + 4 * n) = w;
                    if (m == 0 && fr < 2) { float* hp = HALO + ((size_t)grp * 4 + fr) * F2 + ct + 4 * n; *(f32x4*)hp = za; *(f32x4*)(hp + 128) = zb; }
                    if (m == 3 && fr >= 14) { float* hp = HALO + ((size_t)grp * 4 + (fr - 12)) * F2 + ct + 4 * n; *(f32x4*)hp = za; *(f32x4*)(hp + 128) = zb; }
                }
            }
        }
    }
};
template <class Epi, class Sched, bool ALIGN_EPI = false, bool SP2 = false>
__device__ __forceinline__ void gemm_phase(PG8_LAS unsigned char* lds, const Gemm g, const Sched& S, const Epi& E) {
    int tid_l = threadIdx.x; asm volatile("" : "+v"(tid_l)); const int tid = tid_l, wid = __builtin_amdgcn_readfirstlane(tid >> 6), lane = tid & 63, wr = wid >> 2, wc = wid & 3, fr = lane & 15, fq = lane >> 4;
    const int K = g.K, nt = K / BK;
    unsigned voffA[2], voffB[2];
#pragma unroll
    for (int i = 0; i < 2; ++i) { int R, C; stage_rc(tid * 16 + i * 8192, R, C); const int Rb = Epi::PERM ? ((R & ~31) + perm32(R & 31)) : R;
        voffA[i] = (unsigned)(R * K + C) * 2u; voffB[i] = (unsigned)(Rb * K + C) * 2u; }
    const size_t kstep = (size_t)(BK * 2);
    const size_t hstep = (size_t)HALF * K * 2;
    const size_t tstep = 2 * hstep;
    const unsigned ldsw = (unsigned)wid * 1024u;
    const int aoff = lds_byte(wr * 64 + fr, fq * 8), boff = lds_byte(wc * 32 + fr, fq * 8);
#define PG8_SA(b, h) (((b) * 2 + (h)) * HTB)
#define PG8_SB(b, h) ((4 + (b) * 2 + (h)) * HTB)
#define PG8_STAGE(bufoff, gbase, voff) do { _Pragma("unroll") for (int _i = 0; _i < 2; ++_i) \
        __builtin_amdgcn_global_load_lds((const unsigned*)((const char*)(gbase) + (voff)[_i]), (PG8_LAS unsigned*)(lds + (bufoff) + ldsw + _i * 8192), 16, 0, 0); } while (0)
#define PG8_LDA(dst, b, h) do { _Pragma("unroll") for (int m = 0; m < 4; ++m) _Pragma("unroll") for (int k = 0; k < 2; ++k) dst[m][k] = *(const PG8_LAS bf16x8*)(lds + PG8_SA(b, h) + aoff + m * 2048 + k * 1024); } while (0)
#define PG8_LDB(dst, b, h) do { _Pragma("unroll") for (int n = 0; n < 2; ++n) _Pragma("unroll") for (int k = 0; k < 2; ++k) dst[n][k] = *(const PG8_LAS bf16x8*)(lds + PG8_SB(b, h) + boff + n * 2048 + k * 1024); } while (0)
#define PG8_MMA(ai, bj, At, Bt) do { __builtin_amdgcn_s_setprio(1); _Pragma("unroll") for (int m = 0; m < 4; ++m) _Pragma("unroll") for (int n = 0; n < 2; ++n) _Pragma("unroll") for (int k = 0; k < 2; ++k) \
        acc[ai][bj][m][n] = __builtin_amdgcn_mfma_f32_16x16x32_bf16(Bt[n][k], At[m][k], acc[ai][bj][m][n], 0, 0, 0); __builtin_amdgcn_s_setprio(0); } while (0)
#define PG8_WAIT_V(n) asm volatile("s_waitcnt vmcnt(" #n ")" ::: "memory")
#define PG8_WAIT_L(n) asm volatile("s_waitcnt lgkmcnt(" #n ")" ::: "memory")
#define PG8_BAR __builtin_amdgcn_s_barrier()
#define PG8_SCHED __builtin_amdgcn_sched_barrier(0)
    Unit cur, nxt; int ui = 0;
    if (!S.next(0, cur)) return;
    f32x4 acc[2][2][4][2];
#pragma unroll
    for (int a = 0; a < 2; ++a)
#pragma unroll
        for (int b = 0; b < 2; ++b)
#pragma unroll
            for (int m = 0; m < 4; ++m)
#pragma unroll
                for (int n = 0; n < 2; ++n) acc[a][b][m][n] = (f32x4){0.f, 0.f, 0.f, 0.f};
    bf16x8 At[4][2], B0[2][2], B1[2][2];
    const char* cA = (const char*)g.A + (size_t)cur.pm * tstep; const char* cB = (const char*)g.Bt + (size_t)cur.pn * tstep;
    S.a_ready(cur);
    if constexpr (SP2) {
        PG8_STAGE(PG8_SB(0, 0), cB, voffB); PG8_STAGE(PG8_SB(0, 1), cB + hstep, voffB); PG8_STAGE(PG8_SA(0, 0), cA, voffA); PG8_STAGE(PG8_SA(0, 1), cA + hstep, voffA);
        if (wr == 1) PG8_BAR;
        PG8_WAIT_V(2); PG8_BAR;
        PG8_STAGE(PG8_SB(1, 0), cB + kstep, voffB); PG8_STAGE(PG8_SA(1, 0), cA + kstep, voffA); PG8_STAGE(PG8_SB(1, 1), cB + hstep + kstep, voffB);
        PG8_WAIT_V(6); PG8_BAR;
    } else {
        PG8_STAGE(PG8_SB(0, 0), cB, voffB); PG8_STAGE(PG8_SA(0, 0), cA, voffA); PG8_STAGE(PG8_SB(0, 1), cB + hstep, voffB); PG8_STAGE(PG8_SA(0, 1), cA + hstep, voffA);
        if (wr == 1) PG8_BAR;
        PG8_WAIT_V(4); PG8_BAR;
        PG8_STAGE(PG8_SB(1, 0), cB + kstep, voffB); PG8_STAGE(PG8_SA(1, 0), cA + kstep, voffA); PG8_STAGE(PG8_SB(1, 1), cB + hstep + kstep, voffB);
        PG8_WAIT_V(6); PG8_BAR;
    }
    for (;;) {
        const bool has_next = S.next(ui + 1, nxt);
        const char* nA = has_next ? (const char*)g.A + (size_t)nxt.pm * tstep : cA; const char* nB = has_next ? (const char*)g.Bt + (size_t)nxt.pn * tstep : cB;
        for (int t = 0; t < nt; t += 2) {
            const bool last = (t == nt - 2);
            const char* a1 = cA + (size_t)(t + 1) * kstep;
            const char* a2 = last ? nA : cA + (size_t)(t + 2) * kstep; const char* b2 = last ? nB : cB + (size_t)(t + 2) * kstep;
            const char* a3 = a2 + kstep; const char* b3 = b2 + kstep;
            if (last && has_next) S.a_ready(nxt);
            if constexpr (SP2) {
            PG8_LDB(B0, 0, 0); PG8_LDB(B1, 0, 1); PG8_SCHED; PG8_LDA(At, 0, 0); PG8_STAGE(PG8_SA(1, 1), a1 + hstep, voffA);
            PG8_WAIT_V(8); PG8_WAIT_L(0); PG8_BAR; PG8_MMA(0, 0, At, B0); PG8_MMA(0, 1, At, B1); PG8_BAR; PG8_SCHED;
            PG8_LDA(At, 0, 1); PG8_STAGE(PG8_SB(0, 0), b2, voffB); PG8_STAGE(PG8_SB(0, 1), b2 + hstep, voffB); PG8_STAGE(PG8_SA(0, 0), a2, voffA);
            PG8_WAIT_V(8); PG8_WAIT_L(0); PG8_BAR; PG8_MMA(1, 0, At, B0); PG8_MMA(1, 1, At, B1); PG8_BAR; PG8_SCHED;
            PG8_LDB(B0, 1, 0); PG8_LDB(B1, 1, 1); PG8_SCHED; PG8_LDA(At, 1, 0); PG8_STAGE(PG8_SA(0, 1), a2 + hstep, voffA);
            PG8_WAIT_V(8); PG8_WAIT_L(0); PG8_BAR; PG8_MMA(0, 0, At, B0); PG8_MMA(0, 1, At, B1); PG8_BAR; PG8_SCHED;
            PG8_LDA(At, 1, 1); PG8_STAGE(PG8_SB(1, 0), b3, voffB); PG8_STAGE(PG8_SB(1, 1), b3 + hstep, voffB); PG8_STAGE(PG8_SA(1, 0), a3, voffA);
            PG8_WAIT_V(8); PG8_WAIT_L(0); PG8_BAR; PG8_MMA(1, 0, At, B0); PG8_MMA(1, 1, At, B1); PG8_BAR; PG8_SCHED;
            } else {
            PG8_LDB(B0, 0, 0); PG8_SCHED; PG8_LDA(At, 0, 0); PG8_STAGE(PG8_SA(1, 1), a1 + hstep, voffA);
            PG8_WAIT_L(8); PG8_BAR; PG8_WAIT_L(0); PG8_MMA(0, 0, At, B0); PG8_BAR; PG8_SCHED;
            PG8_LDB(B1, 0, 1); PG8_STAGE(PG8_SB(0, 0), b2, voffB);
            PG8_BAR; PG8_WAIT_L(0); PG8_MMA(0, 1, At, B1); PG8_BAR;
            PG8_LDA(At, 0, 1); PG8_STAGE(PG8_SA(0, 0), a2, voffA);
            PG8_BAR; PG8_WAIT_L(0); PG8_MMA(1, 0, At, B0); PG8_BAR; PG8_SCHED;
            PG8_STAGE(PG8_SB(0, 1), b2 + hstep, voffB);
            PG8_WAIT_V(6); PG8_BAR; PG8_MMA(1, 1, At, B1); PG8_BAR;
            PG8_LDB(B0, 1, 0); PG8_SCHED; PG8_LDA(At, 1, 0); PG8_STAGE(PG8_SA(0, 1), a2 + hstep, voffA);
            PG8_WAIT_L(8); PG8_BAR; PG8_WAIT_L(0); PG8_MMA(0, 0, At, B0); PG8_BAR; PG8_SCHED;
            PG8_LDB(B1, 1, 1); PG8_STAGE(PG8_SB(1, 0), b3, voffB);
            PG8_BAR; PG8_WAIT_L(0); PG8_MMA(0, 1, At, B1); PG8_BAR;
            PG8_LDA(At, 1, 1); PG8_STAGE(PG8_SA(1, 0), a3, voffA);
            PG8_BAR; PG8_WAIT_L(0); PG8_MMA(1, 0, At, B0); PG8_BAR; PG8_SCHED;
            PG8_STAGE(PG8_SB(1, 1), b3 + hstep, voffB);
            PG8_WAIT_V(6); PG8_BAR; PG8_MMA(1, 1, At, B1); PG8_BAR;
            }
        }
        if constexpr (ALIGN_EPI) { if (wr == 0) PG8_BAR; }
        if constexpr (!Epi::AFTER_DRAIN) { E(acc, cur, wr, wc, fr, fq); S.done(cur); }
        if (!has_next) break;
#pragma unroll
        for (int a = 0; a < 2; ++a)
#pragma unroll
            for (int b = 0; b < 2; ++b)
#pragma unroll
                for (int m = 0; m < 4; ++m)
#pragma unroll
                    for (int n = 0; n < 2; ++n) acc[a][b][m][n] = (f32x4){0.f, 0.f, 0.f, 0.f};
        cur = nxt; cA = nA; cB = nB; ++ui;
        if constexpr (ALIGN_EPI) { if (wr == 1) PG8_BAR; }
    }
    PG8_WAIT_V(0);
    if constexpr (!ALIGN_EPI) { if (wr == 0) PG8_BAR; }
    PG8_BAR;
    if constexpr (Epi::AFTER_DRAIN) { E.fused(acc, cur, wr, wc, fr, fq, lds, wid, lane); S.done(cur); }
#undef PG8_SA
#undef PG8_SB
#undef PG8_STAGE
#undef PG8_LDA
#undef PG8_LDB
#undef PG8_MMA
#undef PG8_WAIT_V
#undef PG8_WAIT_L
#undef PG8_BAR
#undef PG8_SCHED
}
}
namespace fox {
constexpr int D = 128, PQ = 128, PO = 2048;
constexpr float THR = 8.f; constexpr bool WSKIP = false;
constexpr float SCALE = 0.08838834764831845f;
constexpr int NW = 8, QBLK = 32, KVBLK = 64, QB = NW * QBLK;
constexpr int SHM_V = KVBLK * D * 2, SHM_K = KVBLK * D * 2;
constexpr int LDS_CB = 2 * SHM_V + 2 * SHM_K + NW * 64 * 4;
constexpr int LDS_BYTES = LDS_CB + 4096 * 4;

using bf16 = __hip_bfloat16;
typedef short bf16x8 __attribute__((ext_vector_type(8)));
typedef short s16x4 __attribute__((ext_vector_type(4)));
typedef float f32x16 __attribute__((ext_vector_type(16)));
typedef float f32x4 __attribute__((ext_vector_type(4)));
typedef unsigned u32x4 __attribute__((ext_vector_type(4)));
template <class A, class Bt> struct same_t { static constexpr bool v = false; };
template <class A> struct same_t<A, A> { static constexpr bool v = true; };

#define KSWZ(row, colB) ((row) * 256 + ((colB) ^ (((row) & 7) << 4)))
#define SBAR() __builtin_amdgcn_sched_barrier(0)
__device__ __forceinline__ int v_st(int k, int c) { const int kk = (k & ~0xC) | ((k & 4) << 1) | ((k & 8) >> 1); return ((kk >> 3) * 4 + (c >> 5)) * 512 + ((kk & 7) * 32 + (c & 31)) * 2; }
__device__ __forceinline__ int v_rd_base(int lane) { return ((lane & 3) << 3) | (((lane >> 2) & 3) << 6) | (((lane >> 4) & 1) << 5) | (((lane >> 5) & 1) << 8); }
constexpr int v_rd_off(int d0, int ks, int half) { return d0 * 512 + ks * 4096 + half * 2048; }
__device__ __forceinline__ int crow(int r, int hi) { return (r & 3) + 8 * (r >> 2) + 4 * hi; }
__device__ __forceinline__ unsigned cvtpk(float lo, float hi) {
    unsigned r; asm volatile("v_cvt_pk_bf16_f32 %0, %1, %2" : "=v"(r) : "v"(lo), "v"(hi)); return r;
}
__device__ __forceinline__ bf16x8 pack8(f32x4 a, f32x4 b) {
    u32x4 w = {cvtpk(a[0], a[1]), cvtpk(a[2], a[3]), cvtpk(b[0], b[1]), cvtpk(b[2], b[3])};
    return *reinterpret_cast<bf16x8*>(&w);
}
template <class T> __device__ __forceinline__ bf16x8 load8(const T* p) {
    if constexpr (same_t<T, float>::v) { return pack8(*(const f32x4*)p, *(const f32x4*)(p + 4)); }
    else { return *reinterpret_cast<const bf16x8*>(p); }
}
__device__ __forceinline__ void mask_tile(f32x16& p0, f32x16& p1, int dq, unsigned W) {
    const float NEG = -__builtin_inff();
#pragma unroll
    for (int r = 0; r < 16; ++r) {
        const int c = (r & 3) + 8 * (r >> 2);
        if ((unsigned)(dq - c) >= W) p0[r] = NEG;
        if ((unsigned)(dq - c - 32) >= W) p1[r] = NEG;
    }
}
__device__ __forceinline__ void partialSM(f32x16& p0, f32x16& p1, float& m_reg, float& mn, float& alpha) {
    float pmax = p0[0]; for (int r = 1; r < 16; ++r) pmax = fmaxf(pmax, p0[r]); for (int r = 0; r < 16; ++r) pmax = fmaxf(pmax, p1[r]);
    { auto rr = __builtin_amdgcn_permlane32_swap(__float_as_uint(pmax), __float_as_uint(pmax), false, false);
      pmax = fmaxf(__uint_as_float(rr[0]), __uint_as_float(rr[1])); }
    constexpr float C2 = 1.4426950408889634f * SCALE;
    if (__builtin_expect(__all((pmax - m_reg) * SCALE <= THR), 1)) { mn = m_reg; alpha = 1.f; }
    else { mn = fmaxf(m_reg, pmax); alpha = __builtin_amdgcn_exp2f((m_reg - mn) * C2); m_reg = mn; }
    const float mnL = -mn * C2;
    for (int r = 0; r < 16; ++r) p0[r] = fmaf(p0[r], C2, mnL); for (int r = 0; r < 16; ++r) p1[r] = fmaf(p1[r], C2, mnL);
    for (int r = 0; r < 16; ++r) p0[r] = __builtin_amdgcn_exp2f(p0[r]);
}
__device__ __forceinline__ void finishSM(f32x16& p0, f32x16& p1, float alpha, float& l_reg, bf16x8& pa0, bf16x8& pa1, bf16x8& pa2, bf16x8& pa3) {
    for (int r = 0; r < 16; ++r) p1[r] = __builtin_amdgcn_exp2f(p1[r]);
    float ps = 0; for (int r = 0; r < 16; ++r) ps += p0[r]; for (int r = 0; r < 16; ++r) ps += p1[r];
    { auto rr = __builtin_amdgcn_permlane32_swap(__float_as_uint(ps), __float_as_uint(ps), false, false);
      ps = __uint_as_float(rr[0]) + __uint_as_float(rr[1]); }
    l_reg = l_reg * alpha + ps;
#define PK4(P, B_, OUT) do { unsigned a0 = cvtpk(P[B_+0], P[B_+1]), a1 = cvtpk(P[B_+2], P[B_+3]);                          \
        unsigned b0 = cvtpk(P[B_+4], P[B_+5]), b1 = cvtpk(P[B_+6], P[B_+7]);                                             \
        auto r0 = __builtin_amdgcn_permlane32_swap(a0, b0, false, false); auto r1 = __builtin_amdgcn_permlane32_swap(a1, b1, false, false); \
        u32x4 w = {r0[0], r1[0], r0[1], r1[1]}; OUT = *reinterpret_cast<bf16x8*>(&w); } while (0)
    PK4(p0, 0, pa0); PK4(p0, 8, pa1); PK4(p1, 0, pa2); PK4(p1, 8, pa3);
#undef PK4
}
__device__ __forceinline__ void bias_init(f32x16& p0, f32x16& p1, const float* cbt) {
#pragma unroll
    for (int g = 0; g < 4; ++g) { const f32x4 b0v = *(const f32x4*)(cbt + 8 * g), b1v = *(const f32x4*)(cbt + 32 + 8 * g);
        p0[4 * g] = b0v[0]; p0[4 * g + 1] = b0v[1]; p0[4 * g + 2] = b0v[2]; p0[4 * g + 3] = b0v[3];
        p1[4 * g] = b1v[0]; p1[4 * g + 1] = b1v[1]; p1[4 * g + 2] = b1v[2]; p1[4 * g + 3] = b1v[3]; }
}
template <int KB, bool SK>
__device__ __forceinline__ void qkt(f32x16& p0, f32x16& p1, const char* K_lds, int r32, int hi, const bf16x8* qr, bool act, const float* cbt) {
    if (SK && !act) { const float NEG = -__builtin_inff();
#pragma unroll
        for (int r = 0; r < 16; ++r) { p0[r] = NEG; p1[r] = NEG; } return; }
    (void)cbt;
    const char* kb[4];
#pragma unroll
    for (int dd = 0; dd < 4; ++dd) kb[dd] = K_lds + KB * SHM_K + KSWZ(r32, (dd * 16 + hi * 8) * 2);
#pragma unroll
    for (int d0 = 0; d0 < 8; ++d0) { const char* a = kb[d0 & 3] + (d0 >> 2) * 128;
        bf16x8 b0 = *reinterpret_cast<const bf16x8*>(a);
        bf16x8 b1 = *reinterpret_cast<const bf16x8*>(a + 32 * 256);
        p0 = __builtin_amdgcn_mfma_f32_32x32x16_bf16(b0, qr[d0], p0, 0, 0, 0);
        p1 = __builtin_amdgcn_mfma_f32_32x32x16_bf16(b1, qr[d0], p1, 0, 0, 0); }
}
template <int VB, bool SK>
__device__ __forceinline__ void pv_tile(f32x16* o, int vb0, bf16x8 pa0, bf16x8 pa1, bf16x8 pa2, bf16x8 pa3, bool act) {
    if (SK && !act) return;
#define TRRD(dst, off) asm volatile("ds_read_b64_tr_b16 %0, %1 offset:%2" : "=&v"(dst) : "v"(vb0), "i"(off) : "memory")
#define PV_D0(d0) do { s16x4 l0, l1, l2, l3, h0, h1, h2, h3; constexpr int b_ = VB * SHM_V + v_rd_off(d0, 0, 0);     \
        TRRD(l0, b_); TRRD(h0, b_ + 2048); TRRD(l1, b_ + 4096); TRRD(h1, b_ + 6144); TRRD(l2, b_ + 8192); TRRD(h2, b_ + 10240); TRRD(l3, b_ + 12288); TRRD(h3, b_ + 14336); \
        asm volatile("s_waitcnt lgkmcnt(0)" ::: "memory"); SBAR();                 \
        o[d0] = __builtin_amdgcn_mfma_f32_32x32x16_bf16(pa0, (bf16x8){l0[0], l0[1], l0[2], l0[3], h0[0], h0[1], h0[2], h0[3]}, o[d0], 0, 0, 0);   \
        o[d0] = __builtin_amdgcn_mfma_f32_32x32x16_bf16(pa1, (bf16x8){l1[0], l1[1], l1[2], l1[3], h1[0], h1[1], h1[2], h1[3]}, o[d0], 0, 0, 0);   \
        o[d0] = __builtin_amdgcn_mfma_f32_32x32x16_bf16(pa2, (bf16x8){l2[0], l2[1], l2[2], l2[3], h2[0], h2[1], h2[2], h2[3]}, o[d0], 0, 0, 0);   \
        o[d0] = __builtin_amdgcn_mfma_f32_32x32x16_bf16(pa3, (bf16x8){l3[0], l3[1], l3[2], l3[3], h3[0], h3[1], h3[2], h3[3]}, o[d0], 0, 0, 0); } while (0)
    PV_D0(0); PV_D0(1); PV_D0(2); PV_D0(3);
#undef PV_D0
#undef TRRD
}

__device__ __forceinline__ int fox_jlo(const float* cb, int P0, float margin) {
    const int lane = threadIdx.x & 63, nt0 = P0 / KVBLK;
    const float thr = cb[P0] + margin;
    bool dead = false; if (lane < nt0) dead = cb[KVBLK * lane + KVBLK - 1] > thr;
    const unsigned long long m = __ballot(dead);
    return __builtin_amdgcn_readfirstlane((int)__builtin_ctzll(~m));
}
template <class TIn, class TOut> struct BlockRef { const TIn* Q; const TIn* K; const TIn* V; TOut* O; int P0; const float* cb; const TIn* Gt; };
template <class TIn> struct Seam {
    bf16x8 qr[8];
    bf16x8 st_v0, st_v1, st_k0, st_k1; f32x4 sf0, sf1, sf2, sf3;
    f32x4 tq[16];
};
__device__ __forceinline__ int swa_jlo(int P0, int W) { const int lowk = P0 - W + 1; return lowk > 0 ? lowk / KVBLK : 0; }
#define ROW(p, k0, rr) ((p) + (size_t)((k0) + (rr)) * PQ + sc)
#define VMW() asm volatile("s_waitcnt vmcnt(0)" ::: "memory")
#define VMWN(n) asm volatile("s_waitcnt vmcnt(%0)" :: "i"(n) : "memory")
#define SLOAD_H(Kp, Vp, k0) do { S.st_v0 = load8<TIn>(ROW(Vp, k0, sr)); S.st_v1 = load8<TIn>(ROW(Vp, k0, 32 + sr));              \
                         S.st_k0 = load8<TIn>(ROW(Kp, k0, sr)); S.st_k1 = load8<TIn>(ROW(Kp, k0, 32 + sr)); } while (0)
#define SWRITE_HK(bf) do { *(bf16x8*)(K_lds + (bf) * SHM_K + kws) = S.st_k0; *(bf16x8*)(K_lds + (bf) * SHM_K + kws + 32 * 256) = S.st_k1; } while (0)
#define SWRITE_HV(bf) do { *(bf16x8*)(V_lds + (bf) * SHM_V + vst0) = S.st_v0; *(bf16x8*)(V_lds + (bf) * SHM_V + vst1) = S.st_v1; } while (0)
#define SWRITE_H(bf) do { SWRITE_HV(bf); SWRITE_HK(bf); } while (0)
#define SLOAD_F(p, k0) do { S.sf0 = *(const f32x4*)ROW(p, k0, sr); S.sf1 = *(const f32x4*)(ROW(p, k0, sr) + 4);                \
                            S.sf2 = *(const f32x4*)ROW(p, k0, 32 + sr); S.sf3 = *(const f32x4*)(ROW(p, k0, 32 + sr) + 4); } while (0)
#define SWRITE_KF(bf) do { *(bf16x8*)(K_lds + (bf) * SHM_K + kws) = pack8(S.sf0, S.sf1); *(bf16x8*)(K_lds + (bf) * SHM_K + kws + 32 * 256) = pack8(S.sf2, S.sf3); } while (0)
#define SWRITE_VF(bf) do { *(bf16x8*)(V_lds + (bf) * SHM_V + vst0) = pack8(S.sf0, S.sf1); *(bf16x8*)(V_lds + (bf) * SHM_V + vst1) = pack8(S.sf2, S.sf3); } while (0)
template <class TIn, class TOut>
__device__ __forceinline__ void causal_swa_prime(const BlockRef<TIn, TOut>& cur, int W, char* lds, Seam<TIn>& S) {
    constexpr bool F32 = same_t<TIn, float>::v;
    int tid_l = threadIdx.x; asm volatile("" : "+v"(tid_l)); const int tid = tid_l, wid = __builtin_amdgcn_readfirstlane(tid >> 6), lane = tid & 63, r32 = lane & 31, hi = lane >> 5;
    const int sr = tid >> 4, sc = (tid & 15) * 8, kws = KSWZ(sr, sc * 2); char* K_lds = lds + 2 * SHM_V;
    const int kb0 = swa_jlo(cur.P0, W) * KVBLK;
    for (int d0 = 0; d0 < 8; ++d0) S.qr[d0] = load8<TIn>(cur.Q + (size_t)(wid * QBLK + r32) * PQ + d0 * 16 + hi * 8);
    if constexpr (F32) { SLOAD_F((const float*)cur.K, kb0); VMW(); SWRITE_KF(0); SBAR(); SLOAD_F((const float*)cur.V, kb0); }
    else { SLOAD_H(cur.K, cur.V, kb0); VMW(); SWRITE_HK(0); }
    __syncthreads();
}
template <class TIn, class TOut>
__device__ __forceinline__ void causal_swa_block(const BlockRef<TIn, TOut>& cur, const BlockRef<TIn, TOut>& nxt, int skv, int W, char* lds, Seam<TIn>& S) {
    constexpr bool F32 = same_t<TIn, float>::v;
    int tid_l = threadIdx.x; asm volatile("" : "+v"(tid_l)); const int tid = tid_l, wid = __builtin_amdgcn_readfirstlane(tid >> 6), lane = tid & 63, r32 = lane & 31, hi = lane >> 5;
    const int j_lo = swa_jlo(cur.P0, W);
    int j_hi = (cur.P0 + QB - 1) / KVBLK + 1; if (j_hi > skv / KVBLK) j_hi = skv / KVBLK;
    const int NT = j_hi - j_lo;
    const int kbn = swa_jlo(nxt.P0, W) * KVBLK;
    const int qlo = cur.P0 + wid * QBLK, qm = qlo + r32 - 4 * hi;
    char* V_lds = lds; char* K_lds = lds + 2 * SHM_V;
    float* ws = (float*)(lds + 2 * SHM_V + 2 * SHM_K) + wid * 64; float* li_l = ws, * al_l = ws + 32;
    float m_reg = -1e30f, l_reg = 0; f32x16 o[4] = {};
    float* cbl = (float*)(lds + LDS_CB);
    { const float cref = cur.cb[cur.P0]; const float rs = 1.0f / SCALE;
      for (int i = tid; i < cur.P0 + QB; i += 64 * NW) cbl[i] = (cref - cur.cb[i]) * rs;
      __syncthreads(); }
    const float* cbh = cbl + 4 * hi;
    const int sr = tid >> 4, sc = (tid & 15) * 8, vst0 = v_st(sr, sc), vst1 = v_st(32 + sr, sc), kws = KSWZ(sr, sc * 2);
    const int vb0 = (int)(uintptr_t)V_lds + v_rd_base(lane);
    const TIn* Kh = cur.K; const TIn* Vh = cur.V;
#define RESC(a) do { if (__any((a) < 1.f)) { if (hi == 0) al_l[r32] = (a); asm volatile("s_waitcnt lgkmcnt(0)" ::: "memory");              \
                     for (int d_ = 0; d_ < 4; ++d_) for (int r = 0; r < 16; ++r) o[d_][r] *= al_l[crow(r, hi)]; } } while (0)
#define KBASE(t) ((j_lo + (t)) * KVBLK)
#define ACT(t) (KBASE(t) <= qlo + QBLK - 1 && KBASE(t) + KVBLK - 1 >= qlo - W + 1)
#define MASKT(P0_, P1_, t) do { const int kb_ = KBASE(t); if ((!SK || ACT(t)) && (kb_ + KVBLK - 1 > qlo || kb_ <= qlo + QBLK - 1 - W)) mask_tile(P0_, P1_, qm - kb_, (unsigned)W); } while (0)
    constexpr int NQL = F32 ? 16 : 8;
    constexpr bool SK = WSKIP && !F32;
#define SEAM_K0() do { VMWN(NQL); if constexpr (F32) { SWRITE_KF(0); SBAR(); SLOAD_F((const float*)nxt.V, kbn); } else { SWRITE_HK(0); } SBAR(); } while (0)
    f32x16 pA0, pA1, pB0, pB1; float mnA, mnB, alA, alB; bf16x8 pa0, pa1, pa2, pa3;
    if constexpr (F32) { VMW(); SWRITE_VF(0); SBAR(); } else { SWRITE_HV(0); SBAR(); }
    if (NT > 1) { if constexpr (F32) SLOAD_F((const float*)Kh, KBASE(1)); else SLOAD_H(Kh, Vh, KBASE(1)); }
    bias_init(pA0, pA1, cbh + KBASE(0)); if (NT > 1) bias_init(pB0, pB1, cbh + KBASE(1));
    SBAR(); qkt<0, SK>(pA0, pA1, K_lds, r32, hi, S.qr, ACT(0), cbh + KBASE(0));
    if constexpr (F32) { if (NT > 1) { VMW(); SWRITE_KF(1); SBAR(); SLOAD_F((const float*)Vh, KBASE(1)); } }
    MASKT(pA0, pA1, 0); partialSM(pA0, pA1, m_reg, mnA, alA);
    if (NT > 1) { VMW(); if constexpr (F32) { SWRITE_VF(1); SBAR(); if (NT > 2) SLOAD_F((const float*)Kh, KBASE(2)); } else SWRITE_H(1); }
    __syncthreads();
#define HALF_STEP(PX0, PX1, mnX, alX, PY0, PY1, alY, t, KB, VB, SB) do {                                                      \
        SBAR(); qkt<KB, SK>(PX0, PX1, K_lds, r32, hi, S.qr, ACT(t), cbh + KBASE(t));                             \
        finishSM(PY0, PY1, alY, l_reg, pa0, pa1, pa2, pa3); SBAR();                                                           \
        if ((t) + 1 < NT) bias_init(PY0, PY1, cbh + KBASE((t) + 1));                                                          \
        if ((t) + 1 < NT) { if constexpr (F32) { VMW(); SWRITE_KF(SB); SBAR(); SLOAD_F((const float*)Vh, KBASE((t) + 1)); }  \
                            else { SLOAD_H(Kh, Vh, KBASE((t) + 1)); } SBAR(); }                                               \
        pv_tile<VB, SK>(o, vb0, pa0, pa1, pa2, pa3, ACT((t) - 1)); MASKT(PX0, PX1, (t)); partialSM(PX0, PX1, m_reg, mnX, alX);                                        \
        __syncthreads();                                                                                                      \
        if ((t) + 1 < NT) { VMW(); if constexpr (F32) { SWRITE_VF(SB); SBAR(); if ((t) + 2 < NT) SLOAD_F((const float*)Kh, KBASE((t) + 2)); } \
                            else { SWRITE_H(SB); } }                                                                          \
        RESC(alX); __syncthreads(); } while (0)
    for (int t = 1; t + 1 < NT; t += 2) {
        HALF_STEP(pB0, pB1, mnB, alB, pA0, pA1, alA, t, 1, 0, 0);
        HALF_STEP(pA0, pA1, mnA, alA, pB0, pB1, alB, t + 1, 0, 1, 1);
    }
    const bool even = (NT & 1) == 0;
    if (even) { SBAR(); qkt<1, SK>(pB0, pB1, K_lds, r32, hi, S.qr, ACT(NT - 1), cbh + KBASE(NT - 1)); SBAR(); }
#define QROW(e) (nxt.Q + (size_t)(wid * QBLK + r32) * PQ + ((e) >> 1) * 16 + hi * 8 + ((e) & 1) * 4)
    if constexpr (F32) { SLOAD_F((const float*)nxt.K, kbn); SBAR();
#pragma unroll
        for (int e = 0; e < 8; ++e) S.tq[e] = *(const f32x4*)QROW(e); }
    else { SLOAD_H(nxt.K, nxt.V, kbn); SBAR();
#pragma unroll
        for (int d0 = 0; d0 < 8; ++d0) S.qr[d0] = load8<TIn>(nxt.Q + (size_t)(wid * QBLK + r32) * PQ + d0 * 16 + hi * 8); }
    SBAR();
    finishSM(pA0, pA1, alA, l_reg, pa0, pa1, pa2, pa3); SBAR();
    if constexpr (F32) {
#pragma unroll
        for (int e = 8; e < 16; ++e) S.tq[e] = *(const f32x4*)QROW(e); SBAR(); }
#undef QROW
    pv_tile<0, SK>(o, vb0, pa0, pa1, pa2, pa3, ACT(even ? NT - 2 : NT - 1));
    if (even) { MASKT(pB0, pB1, NT - 1); partialSM(pB0, pB1, m_reg, mnB, alB); __syncthreads(); RESC(alB);
        finishSM(pB0, pB1, alB, l_reg, pa0, pa1, pa2, pa3); SBAR(); pv_tile<1, SK>(o, vb0, pa0, pa1, pa2, pa3, ACT(NT - 1)); }
    SBAR(); SEAM_K0();
    if (hi == 0) li_l[r32] = l_reg; asm volatile("s_waitcnt lgkmcnt(0)" ::: "memory");
    float rli[16];
#pragma unroll
    for (int r = 0; r < 16; ++r) rli[r] = __builtin_amdgcn_rcpf(li_l[crow(r, hi)]);
    TOut* Ow = cur.O + (size_t)(wid * QBLK) * PO; const TIn* Gw = cur.Gt + (size_t)(wid * QBLK) * PQ;
    const unsigned short* Gu = reinterpret_cast<const unsigned short*>(Gw);
#pragma unroll
    for (int rh = 0; rh < 2; ++rh) {
        unsigned gr[8][4];
#pragma unroll
        for (int r8 = 0; r8 < 8; ++r8)
#pragma unroll
            for (int d0 = 0; d0 < 4; ++d0) gr[r8][d0] = Gu[(size_t)crow(8 * rh + r8, hi) * PQ + d0 * 32 + r32];
        asm volatile("" ::: "memory");
#pragma unroll
        for (int r8 = 0; r8 < 8; ++r8) { const int r = 8 * rh + r8, orow = crow(r, hi);
#pragma unroll
            for (int d0 = 0; d0 < 4; ++d0) { const float gv = __uint_as_float(gr[r8][d0] << 16); const float v = o[d0][r] * rli[r] * __builtin_amdgcn_rcpf(1.0f + __expf(-gv));
                if constexpr (same_t<TOut, float>::v) { Ow[(size_t)orow * PO + d0 * 32 + r32] = v; }
                else { const float vn = __shfl_xor(v, 1);
                       if ((r32 & 1) == 0) *(unsigned*)(Ow + (size_t)orow * PO + d0 * 32 + r32) = cvtpk(v, vn); } } }
    }
    if constexpr (F32) {
#pragma unroll
        for (int d0 = 0; d0 < 8; ++d0) S.qr[d0] = pack8(S.tq[2 * d0], S.tq[2 * d0 + 1]); }
    __syncthreads();
#undef RESC
#undef KBASE
#undef ACT
#undef MASKT
#undef SEAM_K0
#undef HALF_STEP
}
#undef ROW
#undef VMW
#undef VMWN
#undef SLOAD_H
#undef SWRITE_HK
#undef SWRITE_HV
#undef SWRITE_H
#undef SLOAD_F
#undef SWRITE_KF
#undef SWRITE_VF

}
constexpr int NTOK = 16384, DMOD = 2048, SEQL = 4096, NBAT = 4;
constexpr int ABIN = 6144, FFH = 5632, FF2 = 11264, CINW = 8208, CINP = 8448;
constexpr float RMS_EPS = 1e-6f;
constexpr size_t WS_WABIN = 0;
constexpr size_t WS_WABOUT = WS_WABIN + (size_t)ABIN * DMOD * 2;
constexpr size_t WS_WCIN = WS_WABOUT + (size_t)DMOD * DMOD * 2;
constexpr size_t WS_WCOUT = WS_WCIN + (size_t)CINP * DMOD * 2;
constexpr size_t WS_WUP0 = WS_WCOUT + (size_t)DMOD * DMOD * 2;
constexpr size_t WS_WUP1 = WS_WUP0 + (size_t)FF2 * DMOD * 2;
constexpr size_t WS_WDN0 = WS_WUP1 + (size_t)FF2 * DMOD * 2;
constexpr size_t WS_WDN1 = WS_WDN0 + (size_t)DMOD * FFH * 2;
constexpr size_t WS_ACT = WS_WDN1 + (size_t)DMOD * FFH * 2;
constexpr size_t WS_BIG = WS_ACT + (size_t)NTOK * DMOD * 2;
constexpr size_t WS_Z1 = WS_BIG;
constexpr size_t WS_HL = WS_Z1 + (size_t)NTOK * ABIN * 2;
constexpr size_t WS_DEC = WS_HL + (size_t)32 * 64 * 128 * 128 * 2;
constexpr size_t WS_END_AB = WS_DEC + (size_t)32 * 64 * 128 * 4;
constexpr size_t WS_GA = WS_BIG;
constexpr size_t WS_HALO = WS_GA + (size_t)NTOK * FFH * 2;
constexpr size_t WS_END_FFN = WS_HALO + (size_t)256 * 4 * FF2 * 4;
constexpr size_t WS_QKVG = WS_BIG;
constexpr size_t WS_F = WS_QKVG + (size_t)NTOK * 8192 * 2;
constexpr size_t WS_C = WS_F + (size_t)2 * NTOK * 16 * 4;
constexpr size_t WS_END_C = WS_C + (size_t)64 * 4096 * 4;
constexpr size_t WS_NEED = WS_END_FFN > WS_END_AB ? (WS_END_FFN > WS_END_C ? WS_END_FFN : WS_END_C) : (WS_END_AB > WS_END_C ? WS_END_AB : WS_END_C);
constexpr size_t WS_BAR = (WS_NEED + 255) / 256 * 256;
constexpr size_t WS_TOTAL = WS_BAR + 16384;
constexpr int LDS_BYTES = 147456, LDS_MISC = LDS_BYTES - 128;
constexpr int LDS_BYTES_UNUSED = 0;

#define LAS __attribute__((address_space(3)))
typedef unsigned short bfu;
typedef unsigned v4u __attribute__((ext_vector_type(4)));
typedef float f32x4 __attribute__((ext_vector_type(4)));
typedef short bf16x8 __attribute__((ext_vector_type(8)));
#define LDS_WAIT() asm volatile("s_waitcnt lgkmcnt(0)" ::: "memory")
typedef float f32x2_t __attribute__((ext_vector_type(2))); typedef __bf16 bf16x2_t __attribute__((ext_vector_type(2)));
__device__ __forceinline__ unsigned pk2(float lo, float hi) { f32x2_t v = {lo, hi}; bf16x2_t b = __builtin_convertvector(v, bf16x2_t); return __builtin_bit_cast(unsigned, b); }
__device__ __forceinline__ unsigned f2bf(float f) { return pk2(f, 0.f) & 0xffffu; }
__device__ __forceinline__ float bf2f(unsigned h) { return __builtin_bit_cast(float, h << 16); }
__device__ __forceinline__ float bflo(unsigned w) { return __builtin_bit_cast(float, w << 16); }
__device__ __forceinline__ float bfhi(unsigned w) { return __builtin_bit_cast(float, w & 0xffff0000u); }
__device__ __forceinline__ float sigmoidf_(float x) { return __builtin_amdgcn_rcpf(1.0f + __expf(-x)); }
__device__ __forceinline__ float gelu_erf(float x) { return 0.5f * x * (1.0f + erff(x * 0.70710678118654752f)); }
__device__ __forceinline__ void gelu2(float& a, float& b) { const pg8::f32x2 r = pg8::gelu_pk((pg8::f32x2){a, b}); a = r.x; b = r.y; }
__device__ __forceinline__ float wave_sum(float v) {
#pragma unroll
    for (int o = 1; o < 64; o <<= 1) v += __shfl_xor(v, o);
    return v;
}
__device__ __forceinline__ bf16x8 pack8f(f32x4 a, f32x4 b) { v4u w = {pk2(a[0], a[1]), pk2(a[2], a[3]), pk2(b[0], b[1]), pk2(b[2], b[3])}; return __builtin_bit_cast(bf16x8, w); }
#define MFMA16(a, b, c) __builtin_amdgcn_mfma_f32_16x16x32_bf16((a), (b), (c), 0, 0, 0)

__device__ __forceinline__ void tr_item64(const float* W, int ldw, int K, bfu* WT, int nblk, int item, LAS float* scr, int lane, bool ab_remap = false) {
    const int kb = item / nblk, nb = item - kb * nblk, k0 = 64 * kb, n0 = 64 * nb;
    int d0 = n0; if (ab_remap) { const int bj = n0 >= FFH ? 1 : 0, rem = n0 - bj * FFH; d0 = (rem >> 7) * 256 + bj * 128 + (rem & 127); }
    const int q = lane & 15, kr = lane >> 4;
    f32x4 v[16];
#pragma unroll
    for (int i = 0; i < 16; ++i) v[i] = *(const f32x4*)(W + (size_t)(k0 + 4 * i + kr) * ldw + n0 + 4 * q);
#pragma unroll
    for (int i = 0; i < 16; ++i) { LAS float* s = scr + (4 * i + kr) * 65 + 4 * q; s[0] = v[i][0]; s[1] = v[i][1]; s[2] = v[i][2]; s[3] = v[i][3]; }
    LDS_WAIT(); asm volatile("" ::: "memory");
    const int c = lane & 7;
#pragma unroll
    for (int j = 0; j < 8; ++j) { const int n = (lane >> 3) + 8 * j; const LAS float* s = scr + (8 * c) * 65 + n;
        v4u o; o.x = pk2(s[0], s[65]); o.y = pk2(s[130], s[195]); o.z = pk2(s[260], s[325]); o.w = pk2(s[390], s[455]);
        *(v4u*)(WT + (size_t)(d0 + n) * K + k0 + 8 * c) = o; }
    LDS_WAIT(); asm volatile("" ::: "memory");
}
template <bool NT = false> __device__ __forceinline__ void rms_rows(const float* X, const float* gain, bfu* O, int gw, int NGW, int lane) {
    f32x4 gv[8];
#pragma unroll
    for (int j = 0; j < 8; ++j) gv[j] = ((const f32x4*)gain)[64 * j + lane];
    for (int m = gw; m < NTOK; m += NGW) {
        const f32x4* xr = (const f32x4*)(X + (size_t)m * DMOD) + lane;
        f32x4 v[8]; float s = 0.f;
#pragma unroll
        for (int j = 0; j < 8; ++j) { v[j] = NT ? __builtin_nontemporal_load(xr + 64 * j) : xr[64 * j]; s += (v[j][0] * v[j][0] + v[j][1] * v[j][1]) + (v[j][2] * v[j][2] + v[j][3] * v[j][3]); }
        const float r = rsqrtf(wave_sum(s) * (1.0f / DMOD) + RMS_EPS);
        unsigned long long* o8 = (unsigned long long*)(O + (size_t)m * DMOD) + lane;
#pragma unroll
        for (int j = 0; j < 8; ++j) { const f32x4 y = v[j] * r * gv[j]; o8[64 * j] = (unsigned long long)pk2(y[0], y[1]) | ((unsigned long long)pk2(y[2], y[3]) << 32); }
    }
}

__device__ __forceinline__ void gmlp_tile(int tile, const bfu* Z1, const float* spw, const float* spb, const float* vgain, bfu* Y, LAS unsigned char* lds, int tid, int wave, int lane) {
    const int h = tile & 7, bc = tile >> 3; const size_t tok0 = (size_t)bc * 128;
    LAS bfu* vnT = (LAS bfu*)lds;
    { const int s = tid >> 2, part = tid & 3;
      const bfu* src = Z1 + (tok0 + s) * ABIN + 1024 + h * 128 + 32 * part;
      v4u raw[4];
#pragma unroll
      for (int i = 0; i < 4; ++i) raw[i] = ((const v4u*)src)[i];
      float g[32]; float ss = 0.f;
#pragma unroll
      for (int i = 0; i < 4; ++i)
#pragma unroll
          for (int j = 0; j < 4; ++j) { float a = bflo(raw[i][j]), b = bfhi(raw[i][j]); gelu2(a, b); g[8 * i + 2 * j] = a; g[8 * i + 2 * j + 1] = b; ss += a * a + b * b; }
      ss += __shfl_xor(ss, 1); ss += __shfl_xor(ss, 2);
      const float r = rsqrtf(ss * (1.0f / 128.0f) + RMS_EPS);
      const float* gp = vgain + h * 128 + 32 * part;
#pragma unroll
      for (int e = 0; e < 32; ++e) vnT[(32 * part + e) * 136 + s] = (bfu)f2bf(g[e] * r * gp[e]);
    }
    __syncthreads();
    const int fr = lane & 15, fq = lane >> 4, t0 = 16 * wave, trow = t0 + fr;
    f32x4 acc[8];
#pragma unroll
    for (int nb = 0; nb < 8; ++nb) acc[nb] = (f32x4){0.f, 0.f, 0.f, 0.f};
    const float* wrow = spw + (size_t)(h * 128 + trow) * 128;
    const int nks = (t0 + 15) / 32 + 1;
    for (int ks = 0; ks < nks; ++ks) {
        const int s0 = 32 * ks + 8 * fq;
        f32x4 w0 = *(const f32x4*)(wrow + s0), w1 = *(const f32x4*)(wrow + s0 + 4);
#pragma unroll
        for (int j = 0; j < 4; ++j) { if (s0 + j > trow) w0[j] = 0.f; if (s0 + 4 + j > trow) w1[j] = 0.f; }
        const bf16x8 a = pack8f(w0, w1);
#pragma unroll
        for (int nb = 0; nb < 8; ++nb) { const bf16x8 b = *(const LAS bf16x8*)(vnT + (16 * nb + fr) * 136 + 32 * ks + 8 * fq); acc[nb] = MFMA16(a, b, acc[nb]); }
    }
#pragma unroll
    for (int i = 0; i < 4; ++i) { const int t = t0 + 4 * fq + i; const float bias = spb[h * 128 + t];
        const bfu* up = Z1 + (tok0 + t) * ABIN + h * 128 + fr; bfu* yp = Y + (tok0 + t) * DMOD + h * 128 + fr;
#pragma unroll
        for (int nb = 0; nb < 8; nb += 2) { float u0 = bf2f(up[16 * nb]), u1 = bf2f(up[16 * nb + 16]); gelu2(u0, u1);
            yp[16 * nb] = (bfu)f2bf(u0 * (acc[nb][i] + bias)); yp[16 * nb + 16] = (bfu)f2bf(u1 * (acc[nb + 1][i] + bias)); } }
    __syncthreads();
}

__device__ __forceinline__ float hgrn_lb(const float* gamma, int col) {
    const float g0 = gamma[col], g1 = gamma[1024 + col], g2 = gamma[2048 + col]; const float mx = fmaxf(g0, fmaxf(g1, g2));
    const float e0 = __expf(g0 - mx), e1 = __expf(g1 - mx), e2 = __expf(g2 - mx); return e0 / (e0 + e1 + e2);
}
__device__ __forceinline__ void hgrn_local_tile(int tile, const bfu* Z1, const float* gamma, bfu* HL, float* DEC, LAS unsigned char* lds, int tid, int wave, int lane) {
    const int bh = tile >> 6, c = tile & 63, b = bh >> 3, h = bh & 7; const size_t tok0 = (size_t)b * SEQL + c * 64;
    LAS float* segsum = (LAS float*)lds; LAS bfu* keT = (LAS bfu*)(lds + 2048); LAS bfu* vT = (LAS bfu*)(lds + 2048 + 18432);
    const int seg = tid >> 7, k = tid & 127;
    const float lb = hgrn_lb(gamma, h * 128 + k);
    float fl[16], G[16]; float run = 0.f;
#pragma unroll
    for (int i = 0; i < 16; ++i) { fl[i] = bf2f(Z1[(tok0 + 16 * seg + i) * ABIN + 3072 + h * 128 + k]); run += __logf(lb + (1.0f - lb) * sigmoidf_(fl[i])); G[i] = run; }
    segsum[seg * 128 + k] = run;
    unsigned vw[8];
#pragma unroll
    for (int i = 0; i < 8; ++i) vw[i] = (unsigned)Z1[(tok0 + 16 * seg + 2 * i) * ABIN + 4096 + h * 128 + k] | ((unsigned)Z1[(tok0 + 16 * seg + 2 * i + 1) * ABIN + 4096 + h * 128 + k] << 16);
    *(LAS v4u*)(vT + k * 72 + 16 * seg) = (v4u){vw[0], vw[1], vw[2], vw[3]}; *(LAS v4u*)(vT + k * 72 + 16 * seg + 8) = (v4u){vw[4], vw[5], vw[6], vw[7]};
    __syncthreads();
    float pre = 0.f, tot = 0.f;
#pragma unroll
    for (int s = 0; s < 4; ++s) { const float v = segsum[s * 128 + k]; if (s < seg) pre += v; tot += v; }
    unsigned kw[8];
#pragma unroll
    for (int i = 0; i < 8; ++i) { const float k0 = (1.0f - lb) * sigmoidf_(-fl[2 * i]) * __expf(tot - (pre + G[2 * i])), k1 = (1.0f - lb) * sigmoidf_(-fl[2 * i + 1]) * __expf(tot - (pre + G[2 * i + 1])); kw[i] = pk2(k0, k1); }
    *(LAS v4u*)(keT + k * 72 + 16 * seg) = (v4u){kw[0], kw[1], kw[2], kw[3]}; *(LAS v4u*)(keT + k * 72 + 16 * seg + 8) = (v4u){kw[4], kw[5], kw[6], kw[7]};
    if (seg == 3) DEC[(size_t)(bh * 64 + c) * 128 + k] = __expf(tot);
    __syncthreads();
    const int fr = lane & 15, fq = lane >> 4;
    f32x4 acc[8];
#pragma unroll
    for (int nb = 0; nb < 8; ++nb) acc[nb] = (f32x4){0.f, 0.f, 0.f, 0.f};
#pragma unroll
    for (int ks = 0; ks < 2; ++ks) { const bf16x8 a = *(const LAS bf16x8*)(vT + (16 * wave + fr) * 72 + 32 * ks + 8 * fq);
#pragma unroll
        for (int nb = 0; nb < 8; ++nb) { const bf16x8 bb = *(const LAS bf16x8*)(keT + (16 * nb + fr) * 72 + 32 * ks + 8 * fq); acc[nb] = MFMA16(a, bb, acc[nb]); } }
    LAS bfu* Lt = (LAS bfu*)(lds + 40960);
#pragma unroll
    for (int i = 0; i < 4; ++i)
#pragma unroll
        for (int nb = 0; nb < 8; ++nb) Lt[(16 * wave + 4 * fq + i) * 136 + 16 * nb + fr] = (bfu)f2bf(acc[nb][i]);
    __syncthreads();
    bfu* Lp = HL + (size_t)(bh * 64 + c) * 16384;
#pragma unroll
    for (int j = 0; j < 4; ++j) { const int idx = tid + 512 * j, row = idx >> 4, ch = idx & 15; *(v4u*)(Lp + row * 128 + ch * 8) = *(const LAS v4u*)(Lt + row * 136 + ch * 8); }
    __syncthreads();
}
__device__ __forceinline__ void hgrn_out_tile(int tile, const bfu* Z1, const float* gamma, const float* ogain, const bfu* HL, bfu* Y, LAS unsigned char* lds, int tid, int wave, int lane) {
    const int bh = tile >> 6, c = tile & 63, b = bh >> 3, h = bh & 7; const size_t tok0 = (size_t)b * SEQL + c * 64;
    LAS float* segsum = (LAS float*)lds; LAS float* ssq = (LAS float*)(lds + 2048);
    LAS bfu* qd = (LAS bfu*)(lds + 4096); LAS bfu* kd = qd + 64 * 136; LAS bfu* vT = kd + 64 * 136; LAS bfu* Pm = vT + 128 * 72;
    const int seg = tid >> 7, k = tid & 127;
    const int fr = lane & 15, fq = lane >> 4, tb = wave >> 1, wh = wave & 1;
    const float lb = hgrn_lb(gamma, h * 128 + k);
    unsigned flraw[16], qraw[16], vraw[16], graw[4][4];
#pragma unroll
    for (int i = 0; i < 16; ++i) { const bfu* rp = Z1 + (tok0 + 16 * seg + i) * ABIN + h * 128 + k; flraw[i] = rp[3072]; vraw[i] = rp[4096]; qraw[i] = rp[2048]; }
#pragma unroll
    for (int i = 0; i < 4; ++i)
#pragma unroll
        for (int j = 0; j < 4; ++j) graw[i][j] = Z1[(tok0 + 16 * tb + 4 * fq + i) * ABIN + 5120 + h * 128 + 16 * (4 * wh + j) + fr];
    float fl[16], G[16]; float run = 0.f;
#pragma unroll
    for (int i = 0; i < 16; ++i) { fl[i] = bf2f(flraw[i]); run += __logf(lb + (1.0f - lb) * sigmoidf_(fl[i])); G[i] = run; }
    segsum[seg * 128 + k] = run;
    unsigned vw[8];
#pragma unroll
    for (int i = 0; i < 8; ++i) vw[i] = vraw[2 * i] | (vraw[2 * i + 1] << 16);
    *(LAS v4u*)(vT + k * 72 + 16 * seg) = (v4u){vw[0], vw[1], vw[2], vw[3]}; *(LAS v4u*)(vT + k * 72 + 16 * seg + 8) = (v4u){vw[4], vw[5], vw[6], vw[7]};
    __syncthreads();
    float pre = 0.f;
#pragma unroll
    for (int s = 0; s < 3; ++s) { const float v = segsum[s * 128 + k]; if (s < seg) pre += v; }
#pragma unroll
    for (int i = 0; i < 16; ++i) { const int t = 16 * seg + i; const float Gt = pre + G[i]; const float qv = bf2f(qraw[i]);
        qd[t * 136 + k] = (bfu)f2bf(qv * __expf(Gt)); kd[t * 136 + k] = (bfu)f2bf((1.0f - lb) * sigmoidf_(-fl[i]) * __expf(-Gt)); }
    const bfu* Sg = HL + (size_t)(bh * 64 + c) * 16384;
    bf16x8 sfr[4][4];
#pragma unroll
    for (int ks = 0; ks < 4; ++ks)
#pragma unroll
        for (int j = 0; j < 4; ++j) sfr[ks][j] = *(const bf16x8*)(Sg + (16 * (4 * wh + j) + fr) * 128 + 32 * ks + 8 * fq);
    __syncthreads();
#pragma unroll
    for (int jj = 0; jj < 2; ++jj) { const int sb = 2 * wh + jj; f32x4 sc = (f32x4){0.f, 0.f, 0.f, 0.f};
        if (sb <= tb) {
#pragma unroll
            for (int ks = 0; ks < 4; ++ks) { const bf16x8 a = *(const LAS bf16x8*)(qd + (16 * tb + fr) * 136 + 32 * ks + 8 * fq), bb = *(const LAS bf16x8*)(kd + (16 * sb + fr) * 136 + 32 * ks + 8 * fq); sc = MFMA16(a, bb, sc); } }
#pragma unroll
        for (int i = 0; i < 4; ++i) { const int t = 16 * tb + 4 * fq + i, s = 16 * sb + fr; Pm[t * 72 + s] = (bfu)f2bf(s <= t ? sc[i] : 0.f); } }
    __syncthreads();
    f32x4 acc[4];
#pragma unroll
    for (int j = 0; j < 4; ++j) acc[j] = (f32x4){0.f, 0.f, 0.f, 0.f};
#pragma unroll
    for (int ks = 0; ks < 2; ++ks) { const bf16x8 a = *(const LAS bf16x8*)(Pm + (16 * tb + fr) * 72 + 32 * ks + 8 * fq);
#pragma unroll
        for (int j = 0; j < 4; ++j) { const bf16x8 bb = *(const LAS bf16x8*)(vT + (16 * (4 * wh + j) + fr) * 72 + 32 * ks + 8 * fq); acc[j] = MFMA16(a, bb, acc[j]); } }
#pragma unroll
    for (int ks = 0; ks < 4; ++ks) { const bf16x8 a = *(const LAS bf16x8*)(qd + (16 * tb + fr) * 136 + 32 * ks + 8 * fq);
#pragma unroll
        for (int j = 0; j < 4; ++j) acc[j] = MFMA16(a, sfr[ks][j], acc[j]); }
#pragma unroll
    for (int i = 0; i < 4; ++i) { float pp = (acc[0][i] * acc[0][i] + acc[1][i] * acc[1][i]) + (acc[2][i] * acc[2][i] + acc[3][i] * acc[3][i]);
        pp += __shfl_xor(pp, 1); pp += __shfl_xor(pp, 2); pp += __shfl_xor(pp, 4); pp += __shfl_xor(pp, 8);
        if (fr == 0) ssq[wave * 16 + 4 * fq + i] = pp; }
    __syncthreads();
#pragma unroll
    for (int i = 0; i < 4; ++i) { const int t = 16 * tb + 4 * fq + i; const float r = rsqrtf((ssq[wave * 16 + 4 * fq + i] + ssq[(wave ^ 1) * 16 + 4 * fq + i]) * (1.0f / 128.0f) + RMS_EPS);
#pragma unroll
        for (int j = 0; j < 4; ++j) { const int v = 16 * (4 * wh + j) + fr; const float gt = bf2f(graw[i][j]);
            Y[(tok0 + t) * DMOD + 1024 + h * 128 + v] = (bfu)f2bf(acc[j][i] * r * ogain[v] * gt * sigmoidf_(gt)); } }
    __syncthreads();
}


#ifndef EN_ATTN
#define EN_ATTN 1
#endif
#ifndef EN_MIXAB
#define EN_MIXAB 1
#endif
#ifndef EN_GEMM
#define EN_GEMM 1
#endif
#define XB_TMO      128
#define XB_XCNT(j)  (256  + 64 * (j))
#define XB_XSUB(j)  (1280 + 64 * (j))
#define XB_XGEN(j)  (2304 + 64 * (j))
#define XB_TOP      3328
#define XB_TOPGEN   3392
#define XCD_BAR_WORDS 3456
#define XB_SPIN_CAP (1u << 18)

__device__ __forceinline__ unsigned xb_ld(unsigned* p)              { return __hip_atomic_load(p, __ATOMIC_RELAXED, __HIP_MEMORY_SCOPE_AGENT); }
__device__ __forceinline__ unsigned xb_add(unsigned* p, unsigned v) { return __hip_atomic_fetch_add(p, v, __ATOMIC_RELAXED, __HIP_MEMORY_SCOPE_AGENT); }
__device__ __forceinline__ unsigned xb_xcc_id() { return (unsigned)__builtin_amdgcn_s_getreg((3 << 11) | 20) & 0xFu; }
#define XB_SPIN(cond, bar) do { unsigned _sp = 0; while (cond) { __builtin_amdgcn_s_sleep(1); \
    if ((++_sp & 255u) == 0u) { if (xb_ld(&(bar)[XB_TMO])) break; if (_sp > XB_SPIN_CAP) { atomicAdd(&(bar)[XB_TMO], 1u); break; } } } } while (0)

struct XcdBarrier {
    unsigned* bar; unsigned x;
    volatile LAS unsigned* st;
};

__device__ __forceinline__ XcdBarrier xcd_barrier_post(unsigned* bar, volatile LAS unsigned* st) {
    XcdBarrier b; b.bar = bar; b.x = xb_xcc_id(); b.st = st;
    if (threadIdx.x == 0) (void)xb_add(&bar[XB_XCNT(b.x)], 1u);
    return b;
}
__device__ __forceinline__ void xcd_barrier_complete(unsigned* bar, unsigned x, unsigned& nloc, unsigned& nx) {
    const unsigned G = gridDim.x * gridDim.y * gridDim.z;
    unsigned sum, cnt, mine, sp = 0u;
    for (;;) {
        sum = 0u; cnt = 0u; mine = 0u;
#pragma unroll
        for (unsigned j = 0; j < 16; ++j) { const unsigned c = xb_ld(&bar[XB_XCNT(j)]); sum += c; cnt += (c > 0u) ? 1u : 0u; mine = (j == x) ? c : mine; }
        if (sum == G) break;
        __builtin_amdgcn_s_sleep(1);
        if ((++sp & 255u) == 0u) { if (xb_ld(&bar[XB_TMO])) break; if (sp > XB_SPIN_CAP) { atomicAdd(&bar[XB_TMO], 1u); break; } }
    }
    nloc = mine > 0u ? mine : 1u; nx = cnt > 0u ? cnt : 1u;
}

__device__ __forceinline__ void xcd_barrier(const XcdBarrier& b) {
    asm volatile("s_waitcnt vmcnt(0)" ::: "memory");
    __syncthreads();
    if (threadIdx.x == 0) {
        unsigned* bar = b.bar;
        __builtin_amdgcn_s_waitcnt(0);
        unsigned nloc = b.st[0], nx = b.st[1];
        if (nloc == 0u) { xcd_barrier_complete(bar, b.x, nloc, nx); b.st[0] = nloc; b.st[1] = nx; }
        const unsigned old = xb_add(&bar[XB_XSUB(b.x)], 1u);
        const unsigned gen = old / nloc;
        if (old + 1u == (gen + 1u) * nloc) {
            __builtin_amdgcn_fence(__ATOMIC_RELEASE, "agent");
            asm volatile("s_waitcnt vmcnt(0)" ::: "memory");
            const unsigned og = xb_add(&bar[XB_TOP], 1u);
            const unsigned tg = og / nx;
            if (og + 1u == (tg + 1u) * nx) xb_add(&bar[XB_TOPGEN], 1u);
            else XB_SPIN(xb_ld(&bar[XB_TOPGEN]) == tg, bar);
            __builtin_amdgcn_fence(__ATOMIC_ACQUIRE, "agent");
            xb_add(&bar[XB_XGEN(b.x)], 1u);
            asm volatile("s_waitcnt vmcnt(0)" ::: "memory");
        } else {
            XB_SPIN(xb_ld(&bar[XB_XGEN(b.x)]) == gen, bar);
            __builtin_amdgcn_fence(__ATOMIC_ACQUIRE, "agent");
            asm volatile("s_waitcnt vmcnt(0)" ::: "memory");
        }
    }
    __syncthreads();
}

struct Params { const float* in[19]; float* out; unsigned char* ws; };
#define ARG(p_, i_) ([&]() -> const float* { int k_ = (i_); asm volatile("" : "+s"(k_)); return (p_).in[k_]; }())
#define PHASE_IDS() int tid = threadIdx.x; asm volatile("" : "+v"(tid)); const int lane = tid & 63, wave = __builtin_amdgcn_readfirstlane(tid >> 6); \
    const int G = gridDim.x, gw = blockIdx.x * 8 + wave, NGW = G * 8; const long gtid = (long)blockIdx.x * 512 + tid, NGT = (long)G * 512; (void)lane; (void)gw; (void)NGW; (void)gtid; (void)NGT

template <class Epi> __device__ __forceinline__ void run_gemm(LAS unsigned char* lds, const bfu* A, const bfu* Bt, int M, int N, int K, const Epi& E) {
#if EN_GEMM
    pg8::Gemm g{A, Bt, M, N, K}; pg8::StaticOrder S; S.init(M, N, (int)gridDim.x, (int)blockIdx.x);
    pg8::gemm_phase<Epi, pg8::StaticOrder, true, true>(lds, g, S, E);
#endif
}

struct TrDesc { const float* src; bfu* dst; int ldw, K; };
__device__ __forceinline__ TrDesc tr_decode(const Params& p, int item) {
    constexpr int I0 = 96 * 32, I1 = 32 * 32, I2 = 128 * 32, I3 = 32 * 32, I4 = 176 * 32, I5 = 32 * 88;
    unsigned char* ws = p.ws; const float* W; bfu* WT; int ldw, K, nblk; bool remap = false; int r = item;
    if (r < I0) { W = ARG(p, 2); WT = (bfu*)(ws + WS_WABIN); ldw = ABIN; K = DMOD; nblk = 96; }
    else if ((r -= I0) < I1) { W = ARG(p, 8); WT = (bfu*)(ws + WS_WABOUT); ldw = DMOD; K = DMOD; nblk = 32; }
    else if ((r -= I1) < I2) { W = ARG(p, 9); WT = (bfu*)(ws + WS_WCIN); ldw = CINW; K = DMOD; nblk = 128; }
    else if ((r -= I2) < I3) { W = ARG(p, 13); WT = (bfu*)(ws + WS_WCOUT); ldw = DMOD; K = DMOD; nblk = 32; }
    else if ((r -= I3) < I4) { W = ARG(p, 15); WT = (bfu*)(ws + WS_WUP0); ldw = FF2; K = DMOD; nblk = 176; remap = true; }
    else if ((r -= I4) < I4) { W = ARG(p, 15) + (size_t)DMOD * FF2; WT = (bfu*)(ws + WS_WUP1); ldw = FF2; K = DMOD; nblk = 176; remap = true; }
    else if ((r -= I4) < I5) { W = ARG(p, 18); WT = (bfu*)(ws + WS_WDN0); ldw = DMOD; K = FFH; nblk = 32; }
    else { r -= I5; W = ARG(p, 18) + (size_t)FFH * DMOD; WT = (bfu*)(ws + WS_WDN1); ldw = DMOD; K = FFH; nblk = 32; }
    const int kb = r / nblk, nb = r - kb * nblk, k0 = 64 * kb, n0 = 64 * nb;
    int d0 = n0; if (remap) { const int bj = n0 >= FFH ? 1 : 0, rem = n0 - bj * FFH; d0 = (rem >> 7) * 256 + bj * 128 + (rem & 127); }
    TrDesc d; d.src = W + (size_t)k0 * ldw + n0; d.dst = WT + (size_t)d0 * K + k0; d.ldw = ldw; d.K = K; return d;
}
__device__ __forceinline__ void tr_load(const TrDesc& d, f32x4 (&v)[16], int lane) {
    const float* s = d.src + (size_t)(lane >> 4) * d.ldw + 4 * (lane & 15);
#pragma unroll
    for (int i = 0; i < 16; ++i) v[i] = __builtin_nontemporal_load((const f32x4*)(s + (size_t)(4 * i) * d.ldw));
}
__device__ __forceinline__ void tr_finish(const TrDesc& d, const f32x4 (&v)[16], LAS float* scr, int lane) {
    const int q = lane & 15, kr = lane >> 4;
#pragma unroll
    for (int i = 0; i < 16; ++i) { LAS float* s = scr + (4 * i + kr) * 65 + 4 * q; s[0] = v[i][0]; s[1] = v[i][1]; s[2] = v[i][2]; s[3] = v[i][3]; }
    LDS_WAIT(); asm volatile("" ::: "memory");
    const int c = lane & 7;
#pragma unroll
    for (int j = 0; j < 8; ++j) { const int n = (lane >> 3) + 8 * j; const LAS float* s = scr + (8 * c) * 65 + n;
        v4u o; o.x = pk2(s[0], s[65]); o.y = pk2(s[130], s[195]); o.z = pk2(s[260], s[325]); o.w = pk2(s[390], s[455]);
        *(v4u*)(d.dst + (size_t)n * d.K + 8 * c) = o; }
    LDS_WAIT(); asm volatile("" ::: "memory");
}
__device__ __forceinline__ void p0_phase(const Params& p, LAS unsigned char* lds) {
    PHASE_IDS(); unsigned char* ws = p.ws;
    bfu* Wcin = (bfu*)(ws + WS_WCIN);
    LAS float* scr = (LAS float*)(lds + wave * 16640);
    constexpr int NIT = 96 * 32 + 32 * 32 + 128 * 32 + 32 * 32 + 2 * 176 * 32 + 2 * 32 * 88;
    f32x4 va[16], vb[16]; TrDesc da, db; int it = gw;
    if (it < NIT) { da = tr_decode(p, it); tr_load(da, va, lane); }
    for (; it < NIT; it += 2 * NGW) {
        const int it1 = it + NGW, it2 = it + 2 * NGW;
        if (it1 < NIT) { db = tr_decode(p, it1); tr_load(db, vb, lane); }
        tr_finish(da, va, scr, lane);
        if (it2 < NIT) { da = tr_decode(p, it2); tr_load(da, va, lane); }
        if (it1 < NIT) tr_finish(db, vb, scr, lane);
    }
    for (long i = gtid; i < 16 * DMOD; i += NGT) { const int j = (int)(i / DMOD), kk = (int)(i % DMOD); Wcin[(size_t)(8192 + j) * DMOD + kk] = (bfu)f2bf(ARG(p, 9)[(size_t)kk * CINW + 8192 + j]); }
    rms_rows<true>(ARG(p, 0), ARG(p, 1), (bfu*)(ws + WS_ACT), gw, NGW, lane);
}
__device__ __forceinline__ void norm_phase(const float* X, const float* gain, bfu* O) { PHASE_IDS(); rms_rows<true>(X, gain, O, gw, NGW, lane); }

__device__ __forceinline__ void mixab_phase1(const Params& p, LAS unsigned char* lds) {
#if EN_MIXAB
    PHASE_IDS(); unsigned char* ws = p.ws; const bfu* Z1 = (const bfu*)(ws + WS_Z1);
    for (int t = blockIdx.x; t < 1024 + 2048; t += G) {
        if (t < 1024) gmlp_tile(t, Z1, ARG(p, 3), ARG(p, 4), ARG(p, 5), (bfu*)(ws + WS_ACT), lds, tid, wave, lane);
        else hgrn_local_tile(t - 1024, Z1, ARG(p, 6), (bfu*)(ws + WS_HL), (float*)(ws + WS_DEC), lds, tid, wave, lane);
    }
#endif
}
__device__ __forceinline__ void hgrn_scan_phase(const Params& p) {
    PHASE_IDS(); bfu* HL = (bfu*)(p.ws + WS_HL); const float* DEC = (const float*)(p.ws + WS_DEC);
    typedef unsigned u32x2 __attribute__((ext_vector_type(2)));
    for (long e = gtid; e < 32L * 128 * 32; e += NGT) {
        const int bh = (int)(e >> 12), vq = (int)(e & 4095);
        bfu* base = HL + (size_t)bh * 64 * 16384 + (size_t)vq * 4; const float* db = DEC + (size_t)bh * 64 * 128 + (vq & 31) * 4;
        f32x4 s = (f32x4){0.f, 0.f, 0.f, 0.f};
        for (int c0 = 0; c0 < 64; c0 += 16) {
            u32x2 Lc[16]; f32x4 dc[16];
#pragma unroll
            for (int u = 0; u < 16; ++u) { Lc[u] = *(const u32x2*)(base + (size_t)(c0 + u) * 16384); dc[u] = *(const f32x4*)(db + (c0 + u) * 128); }
#pragma unroll
            for (int u = 0; u < 16; ++u) { *(u32x2*)(base + (size_t)(c0 + u) * 16384) = (u32x2){pk2(s[0], s[1]), pk2(s[2], s[3])};
                s = dc[u] * s + (f32x4){bflo(Lc[u][0]), bfhi(Lc[u][0]), bflo(Lc[u][1]), bfhi(Lc[u][1])}; }
        }
    }
}
__device__ __forceinline__ void mixab_phase3(const Params& p, LAS unsigned char* lds) {
#if EN_MIXAB
    PHASE_IDS(); unsigned char* ws = p.ws;
    for (int t = blockIdx.x; t < 2048; t += G) hgrn_out_tile(t, (const bfu*)(ws + WS_Z1), ARG(p, 6), ARG(p, 7), (const bfu*)(ws + WS_HL), (bfu*)(ws + WS_ACT), lds, tid, wave, lane);
#endif
}
__device__ __forceinline__ void fgate_phase(const Params& p) {
    PHASE_IDS(); const bfu* A = (const bfu*)(p.ws + WS_ACT); const bfu* Bw = (const bfu*)(p.ws + WS_WCIN) + (size_t)8192 * DMOD; float* Fb = (float*)(p.ws + WS_F);
    const int fr = lane & 15, fq = lane >> 4;
    for (int it = gw; it < 2 * (NTOK / 16); it += NGW) {
        const int rb = it >> 1, kh = it & 1;
        const bfu* ap = A + (size_t)(16 * rb + fr) * DMOD + 8 * fq + 1024 * kh; const bfu* bp = Bw + (size_t)fr * DMOD + 8 * fq + 1024 * kh;
        f32x4 acc0 = (f32x4){0.f, 0.f, 0.f, 0.f}, acc1 = acc0;
#pragma unroll 8
        for (int ks = 0; ks < 32; ks += 2) {
            const bf16x8 a0 = *(const bf16x8*)(ap + 32 * ks), b0 = *(const bf16x8*)(bp + 32 * ks), a1 = *(const bf16x8*)(ap + 32 * ks + 32), b1 = *(const bf16x8*)(bp + 32 * ks + 32);
            acc0 = MFMA16(a0, b0, acc0); acc1 = MFMA16(a1, b1, acc1); }
#pragma unroll
        for (int i = 0; i < 4; ++i) Fb[(size_t)kh * NTOK * 16 + (size_t)(16 * rb + 4 * fq + i) * 16 + fr] = acc0[i] + acc1[i];
    }
}
__device__ __forceinline__ void qknorm_phase(const Params& p) {
    PHASE_IDS(); const float* Fb = (const float*)(p.ws + WS_F); float* Cb = (float*)(p.ws + WS_C);
    if (gw < 64) {
        const int bh = gw, b = bh >> 4, h = bh & 15; const float bf_ = ARG(p, 10)[h];
        const float* fp = Fb + ((size_t)b * SEQL + 64 * lane) * 16 + h;
        float tot = 0.f;
        for (int i = 0; i < 64; ++i) { const float z = fp[i * 16] + fp[(size_t)NTOK * 16 + i * 16] + bf_; tot += fminf(z, 0.f) - log1pf(__expf(-fabsf(z))); }
        float inc = tot;
#pragma unroll
        for (int o = 1; o < 64; o <<= 1) { const float u = __shfl_up(inc, o); if (lane >= o) inc += u; }
        float run = inc - tot;
        float* cp = Cb + (size_t)bh * SEQL + 64 * lane;
        for (int i = 0; i < 64; ++i) { const float z = fp[i * 16] + fp[(size_t)NTOK * 16 + i * 16] + bf_; run += fminf(z, 0.f) - log1pf(__expf(-fabsf(z))); cp[i] = run; }
    }
}
__device__ __forceinline__ void attn_phase(const Params& p, char* ldsg) {
#if EN_ATTN
    using bfh = __hip_bfloat16; typedef fox::BlockRef<bfh, bfh> BR;
    const bfh* Qb = (const bfh*)(p.ws + WS_QKVG); bfh* Yb = (bfh*)(p.ws + WS_ACT); const float* Cb = (const float*)(p.ws + WS_C);
    const int total = 512, stride = gridDim.x;
    float margin;
    { const float* qg = ARG(p, 11); const float* kg = ARG(p, 12); float a = 0.f, b = 0.f;
#pragma unroll 8
      for (int i = 0; i < 128; ++i) { a = fmaxf(a, fabsf(qg[i])); b = fmaxf(b, fabsf(kg[i])); }
      margin = 110.0f + 2.0f * 1.01f * 128.0f * a * b * fox::SCALE;
      margin = __builtin_bit_cast(float, __builtin_amdgcn_readfirstlane(__builtin_bit_cast(int, margin))); }
#define FOX_ID(L_, pass_) const int bh_ = ((L_) & 7) + 8 * ((L_) >> 6), x_ = ((L_) >> 3) & 7, qb_ = (pass_) ? 15 - x_ : x_, b_ = bh_ >> 4, h_ = bh_ & 15
#define FOX_REF(r, L_, pass_, sk_) do { FOX_ID(L_, pass_); \
        const size_t SEC_ = (size_t)NTOK * 2048, hb_ = (size_t)bh_ * SEQL * 128, rq_ = hb_ + (size_t)qb_ * 256 * 128; \
        (r).Q = Qb + rq_; (r).K = Qb + SEC_ + hb_ + (size_t)(sk_) * 128; (r).V = Qb + 2 * SEC_ + hb_ + (size_t)(sk_) * 128; (r).Gt = Qb + 3 * SEC_ + rq_; \
        (r).O = Yb + ((size_t)b_ * SEQL + (size_t)qb_ * 256) * 2048 + h_ * 128; (r).P0 = qb_ * 256 - (sk_); (r).cb = Cb + (size_t)bh_ * SEQL + (sk_); } while (0)
    int sk00 = 0, sk01 = 0, sk10 = 0, sk11 = 0;
#define FOX_SKIP(dst, L_, pass_) do { FOX_ID(L_, pass_); (void)b_; (void)h_; dst = fox::fox_jlo(Cb + (size_t)bh_ * SEQL, qb_ * 256, margin) * 64; } while (0)
    { const int L0 = blockIdx.x, L1 = blockIdx.x + stride;
      if (L0 < total) { FOX_SKIP(sk00, L0, 0); FOX_SKIP(sk01, L0, 1); }
      if (L1 < total) { FOX_SKIP(sk10, L1, 0); FOX_SKIP(sk11, L1, 1); } }
#define FOX_SK(L_, pass_) ((L_) == (int)blockIdx.x ? ((pass_) ? sk01 : sk00) : (L_) == (int)blockIdx.x + stride ? ((pass_) ? sk11 : sk10) : 0)
    int L = blockIdx.x;
    if (L < total) {
        int pass = 0; BR cur; FOX_REF(cur, L, 0, FOX_SK(L, 0));
        fox::Seam<bfh> S;
        fox::causal_swa_prime<bfh, bfh>(cur, SEQL, ldsg, S);
        for (;;) {
            const bool more_pass = pass == 0, more_item = L + stride < total, last = !more_pass && !more_item;
            int passn = pass + 1, Ln = L;
            if (!more_pass) { passn = 0; Ln = more_item ? L + stride : L; }
            BR nxt = cur; if (!last) FOX_REF(nxt, Ln, passn, FOX_SK(Ln, passn));
            fox::causal_swa_block<bfh, bfh>(cur, nxt, SEQL, SEQL, ldsg, S);
            if (last) break;
            cur = nxt; pass = passn; L = Ln;
        }
#undef FOX_SK
#undef FOX_SKIP
#undef FOX_ID
#undef FOX_REF
    }
#endif
}
__device__ __forceinline__ void conv_fix_phase(const float* HALO, const float* cw, const float* cbv, bfu* GA) {
    PHASE_IDS();
    for (long e = gtid; e < 256L * 2 * 1408; e += NGT) {
        const int cq = (int)(e % 1408), gr = (int)(e / 1408), r = gr & 1, g = gr >> 1;
        const int c = cq * 4, cp = (c >> 7) * 256 + (c & 127);
        const bool first = (g & 63) == 0;
        const float* H = HALO + (size_t)g * 4 * FF2 + cp; const float* Hp = first ? H : H - 4 * FF2;
        const f32x4 zero = (f32x4){0.f, 0.f, 0.f, 0.f};
        const f32x4 za = *(const f32x4*)(H + r * FF2), zb = *(const f32x4*)(H + r * FF2 + 128);
        f32x4 za1, zb1, za2, zb2;
        if (r == 0) { za1 = *(const f32x4*)(Hp + 3 * FF2); zb1 = *(const f32x4*)(Hp + 3 * FF2 + 128); za2 = *(const f32x4*)(Hp + 2 * FF2); zb2 = *(const f32x4*)(Hp + 2 * FF2 + 128); if (first) { za1 = zero; zb1 = zero; za2 = zero; zb2 = zero; } }
        else { za1 = *(const f32x4*)(H); zb1 = *(const f32x4*)(H + 128); za2 = *(const f32x4*)(Hp + 3 * FF2); zb2 = *(const f32x4*)(Hp + 3 * FF2 + 128); if (first) { za2 = zero; zb2 = zero; } }
        const f32x4 a = *(const f32x4*)(cbv + c) + *(const f32x4*)(cw + c) * za2 + *(const f32x4*)(cw + FF2 + c) * za1 + *(const f32x4*)(cw + 2 * FF2 + c) * za;
        const f32x4 b = *(const f32x4*)(cbv + FFH + c) + *(const f32x4*)(cw + FFH + c) * zb2 + *(const f32x4*)(cw + FF2 + FFH + c) * zb1 + *(const f32x4*)(cw + 2 * FF2 + FFH + c) * zb;
        float gv[4];
#pragma unroll
        for (int i = 0; i < 4; ++i) gv[i] = a[i] * sigmoidf_(a[i]) * b[i];
        *(unsigned long long*)(GA + ((size_t)g * 64 + r) * FFH + c) = (unsigned long long)pk2(gv[0], gv[1]) | ((unsigned long long)pk2(gv[2], gv[3]) << 32);
    }
}
#define GSYNC() xcd_barrier(xbar)
template <int LAYER> __device__ __forceinline__ void ffn_block(const Params& p, LAS unsigned char* lds, const XcdBarrier& xbar) {
    unsigned char* ws = p.ws; bfu* ACT = (bfu*)(ws + WS_ACT); bfu* GA = (bfu*)(ws + WS_GA); float* HALO = (float*)(ws + WS_HALO);
    const bfu* Wup = (const bfu*)(ws + (LAYER ? WS_WUP1 : WS_WUP0)); const bfu* Wdn = (const bfu*)(ws + (LAYER ? WS_WDN1 : WS_WDN0));
    const float* cw = ARG(p, 16) + (size_t)LAYER * 3 * FF2; const float* cbv = ARG(p, 17) + (size_t)LAYER * FF2;
    norm_phase(p.out, ARG(p, 14) + (size_t)LAYER * DMOD, ACT);
    GSYNC();
    { pg8::EpiConvGate E{GA, HALO, cw, cbv}; run_gemm(lds, ACT, Wup, NTOK, FF2, DMOD, E); }
    GSYNC();
    conv_fix_phase(HALO, cw, cbv, GA);
    GSYNC();
    { pg8::EpiResF32 E{p.out, p.out, DMOD}; run_gemm(lds, GA, Wdn, NTOK, DMOD, FFH, E); }
}

__global__ void __launch_bounds__(512, 2) fwd_mega(Params p) {
    extern __shared__ __attribute__((aligned(16))) unsigned char lds_raw[];
    LAS unsigned char* lds = (LAS unsigned char*)lds_raw;
    unsigned char* ws = p.ws; bfu* ACT = (bfu*)(ws + WS_ACT);
    unsigned* barw = (unsigned*)(ws + WS_BAR);
    if (blockIdx.x == 0) for (int i = threadIdx.x; i < 4096; i += 512) barw[i] = 0u;
    if (threadIdx.x < 32) ((LAS unsigned*)(lds + LDS_MISC))[threadIdx.x] = 0u;
    cg::this_grid().sync();
    const XcdBarrier xbar = xcd_barrier_post(barw, (volatile LAS unsigned*)(lds + LDS_MISC));
    p0_phase(p, lds);
    GSYNC();
    { pg8::EpiBf16<0> E{(bfu*)(ws + WS_Z1), ABIN, nullptr, 0, 0, 1.f}; run_gemm(lds, ACT, (const bfu*)(ws + WS_WABIN), NTOK, ABIN, DMOD, E); }
    GSYNC();
    mixab_phase1(p, lds);
    GSYNC();
    hgrn_scan_phase(p);
    GSYNC();
    mixab_phase3(p, lds);
    GSYNC();
    { pg8::EpiResF32 E{ARG(p, 0), p.out, DMOD}; run_gemm(lds, ACT, (const bfu*)(ws + WS_WABOUT), NTOK, DMOD, DMOD, E); }
    GSYNC();
    ffn_block<0>(p, lds, xbar);
    GSYNC();
    norm_phase(p.out, ARG(p, 1) + DMOD, ACT);
    GSYNC();
    { pg8::EpiCin E{(bfu*)(ws + WS_QKVG), ARG(p, 11), ARG(p, 12), (LAS float*)(lds + 131072)}; run_gemm(lds, ACT, (const bfu*)(ws + WS_WCIN), NTOK, 8192, DMOD, E); }
    fgate_phase(p);
    GSYNC();
    qknorm_phase(p);
    GSYNC();
    attn_phase(p, (char*)lds_raw);
    GSYNC();
    { pg8::EpiResF32 E{p.out, p.out, DMOD}; run_gemm(lds, ACT, (const bfu*)(ws + WS_WCOUT), NTOK, DMOD, DMOD, E); }
    GSYNC();
    ffn_block<1>(p, lds, xbar);
}

extern "C" void kernel_launch(void* const* d_in, const int* in_sizes, int n_in, void* d_out, int out_size, void* d_ws, size_t ws_size, hipStream_t stream) {
    static int grid = 0;
    if (grid == 0) {
        if (n_in != 19 || in_sizes[0] != NTOK * DMOD || out_size != NTOK * DMOD || ws_size < WS_TOTAL) {
            fprintf(stderr, "kernel_launch: shape/workspace mismatch (n_in %d, in0 %d, out %d, ws %zu, need %zu)\n", n_in, n_in > 0 ? in_sizes[0] : -1, out_size, ws_size, (size_t)WS_TOTAL); grid = -1; return; }
        int dev = 0, cus = 0, per_cu = 0;
        (void)hipGetDevice(&dev); (void)hipDeviceGetAttribute(&cus, hipDeviceAttributeMultiprocessorCount, dev);
        if (hipFuncSetAttribute((const void*)fwd_mega, hipFuncAttributeMaxDynamicSharedMemorySize, LDS_BYTES) != hipSuccess) { fprintf(stderr, "kernel_launch: hipFuncSetAttribute failed\n"); grid = -1; return; }
        if (hipOccupancyMaxActiveBlocksPerMultiprocessor(&per_cu, (const void*)fwd_mega, 512, LDS_BYTES) != hipSuccess || per_cu < 1) { fprintf(stderr, "kernel_launch: occupancy query says %d\n", per_cu); per_cu = 1; }
        (void)hipGetLastError();
        grid = cus > 0 ? cus : 256;
    }
    if (grid < 0) return;
    Params prm{};
    for (int i = 0; i < 19; ++i) prm.in[i] = (const float*)d_in[i];
    prm.out = (float*)d_out; prm.ws = (unsigned char*)d_ws;
    void* args[] = {&prm};
    hipError_t e = hipLaunchCooperativeKernel((const void*)fwd_mega, dim3(grid), dim3(512), args, LDS_BYTES, stream);
    if (e != hipSuccess) fprintf(stderr, "kernel_launch: cooperative launch failed: %s (grid %d)\n", hipGetErrorString(e), grid);
}
```

```cpp
#include <hip/hip_runtime.h>
#include <hip/hip_bf16.h>
#include <hip/hip_cooperative_groups.h>
#include <cstdio>
#include <cstdint>
#include <cmath>
namespace cg = cooperative_groups;
namespace pg8 {
#define PG8_LAS __attribute__((address_space(3)))
typedef unsigned short bf16_t;
typedef short bf16x8 __attribute__((ext_vector_type(8)));
typedef float f32x4 __attribute__((ext_vector_type(4)));
typedef unsigned u32x4 __attribute__((ext_vector_type(4)));
constexpr int BM = 256, BK = 64, HALF = 128, HTB = HALF * BK * 2  , STAGE_BYTES = 8 * HTB, NXCD = 8, WGM = 8;

__host__ __device__ __forceinline__ int lds_byte(int r, int c) { const int st = (r >> 4) * 2 + (c >> 5), rr = r & 15, cc = c & 31, ob = rr * 64 + cc * 2; return st * 1024 + (ob ^ (((ob >> 9) & 1) << 5)); }
__host__ __device__ __forceinline__ void stage_rc(int b, int& R, int& C) { const int st = b / 1024, sb = b % 1024, swz = sb ^ (((sb >> 9) & 1) << 5); R = (st >> 1) * 16 + swz / 64; C = (st & 1) * 32 + (swz % 64) / 2; }
__host__ __device__ __forceinline__ int perm32(int rho) { const int n = rho >> 4, i = rho & 15; return 8 * (i >> 2) + 4 * n + (i & 3); }

struct Unit { int pm, pn; };
struct Gemm { const bf16_t* A; const bf16_t* Bt; int M, N, K; };

struct StaticOrder {
    int nM, nN, nwg, G, c;
    __host__ __device__ void init(int M, int N, int G_, int c_) { nM = M / BM; nN = N / BM; nwg = nM * nN; G = G_; c = c_; }
    __host__ __device__ bool next(int i, Unit& u) const {
        const long L = (long)i * G + c; if (L >= nwg) return false;
        int wgid = (int)L; { const int q = nwg / NXCD, r = nwg % NXCD, xcd = wgid % NXCD, off = wgid / NXCD; wgid = (xcd < r ? xcd * (q + 1) : r * (q + 1) + (xcd - r) * q) + off; }
        const int nig = WGM * nN, gid = wgid / nig, fm = gid * WGM, gsz = (nM - fm) < WGM ? (nM - fm) : WGM;
        u.pm = fm + ((wgid % nig) % gsz); u.pn = (wgid % nig) / gsz; return true;
    }
    __device__ __forceinline__ void a_ready(const Unit&) const {}
    __device__ __forceinline__ void done(const Unit&) const {}
};

__device__ __forceinline__ unsigned cvt_pk_bf16(float lo, float hi) { unsigned r; asm volatile("v_cvt_pk_bf16_f32 %0, %1, %2" : "=v"(r) : "v"(lo), "v"(hi)); return r; }
typedef float f32x2 __attribute__((ext_vector_type(2)));
__device__ __forceinline__ f32x2 gelu_pk(f32x2 v) {
    const f32x2 av = __builtin_elementwise_abs(v), d = av * 0.2316418882f + 1.0f;
    f32x2 t; t.x = __builtin_amdgcn_rcpf(d.x); t.y = __builtin_amdgcn_rcpf(d.y);
    f32x2 q = t * 0.5307027145f + (-0.7265760135f); q = q * t + 0.7107068705f; q = q * t + (-0.142248368f); q = q * t + 0.127414796f; q = q * t;
    const f32x2 s = (v * v) * (-0.72134752044f);
    f32x2 e; e.x = __builtin_amdgcn_exp2f(s.x); e.y = __builtin_amdgcn_exp2f(s.y);
    const f32x2 m = v * (q * e), r = v - m;
    f32x2 o; o.x = v.x < 0.f ? m.x : r.x; o.y = v.y < 0.f ? m.y : r.y; return o;
}

template <int ACT  > struct EpiBf16 {
    static constexpr bool PERM = true, AFTER_DRAIN = false; static_assert(ACT == 0 || ACT == 1, "EpiBf16: ACT is 0 (none) or 1 (gelu_pk)");
    bf16_t* O; int ldc; const float* bias; int split_cols; size_t split_stride; float scale0;
    __device__ __forceinline__ void operator()(const f32x4 (&acc)[2][2][4][2], const Unit& u, int wr, int wc, int fr, int fq) const {
        const int row0 = u.pm * BM + wr * 64 + fr; int colt = u.pn * BM; bf16_t* base = O;
        float sc = 1.f; if (split_cols) { const int t = colt / split_cols; base += (size_t)t * split_stride; colt -= t * split_cols; if (t == 0) sc = scale0; }
        const int col0 = colt + wc * 32 + 8 * fq, bcol0 = u.pn * BM + wc * 32 + 8 * fq;
        f32x4 bv[2][2];
#pragma unroll
        for (int bj = 0; bj < 2; ++bj)
#pragma unroll
            for (int n = 0; n < 2; ++n) bv[bj][n] = bias ? *(const f32x4*)(bias + bcol0 + bj * HALF + 4 * n) : (f32x4){0.f, 0.f, 0.f, 0.f};
#pragma unroll
        for (int ai = 0; ai < 2; ++ai)
#pragma unroll
            for (int m = 0; m < 4; ++m) { bf16_t* rowp = base + (size_t)(row0 + ai * HALF + m * 16) * ldc + col0;
#pragma unroll
                for (int bj = 0; bj < 2; ++bj) { f32x4 v0 = acc[ai][bj][m][0] + bv[bj][0], v1 = acc[ai][bj][m][1] + bv[bj][1];
                    if (ACT == 1) { f32x2 a = gelu_pk((f32x2){v0[0], v0[1]}), b = gelu_pk((f32x2){v0[2], v0[3]}), c = gelu_pk((f32x2){v1[0], v1[1]}), d = gelu_pk((f32x2){v1[2], v1[3]});
                        v0 = (f32x4){a.x, a.y, b.x, b.y}; v1 = (f32x4){c.x, c.y, d.x, d.y}; }
                    v0 = v0 * sc; v1 = v1 * sc; u32x4 w; w.x = cvt_pk_bf16(v0[0], v0[1]); w.y = cvt_pk_bf16(v0[2], v0[3]); w.z = cvt_pk_bf16(v1[0], v1[1]); w.w = cvt_pk_bf16(v1[2], v1[3]);
                    *(u32x4*)(rowp + bj * HALF) = w; } }
    }
};
struct EpiResF32 {
    static constexpr bool PERM = false, AFTER_DRAIN = false;
    const float* res; float* out; int ldc;
    __device__ __forceinline__ void operator()(const f32x4 (&acc)[2][2][4][2], const Unit& u, int wr, int wc, int fr, int fq) const {
        const int col0 = u.pn * BM + wc * 32 + 4 * fq;
#pragma unroll
        for (int ai = 0; ai < 2; ++ai)
#pragma unroll
            for (int mp = 0; mp < 2; ++mp) {
                f32x4 rv[2][2][2];
#pragma unroll
                for (int mm = 0; mm < 2; ++mm) { const size_t off = (size_t)(u.pm * BM + ai * HALF + wr * 64 + (2 * mp + mm) * 16 + fr) * ldc + col0;
#pragma unroll
                    for (int bj = 0; bj < 2; ++bj)
#pragma unroll
                        for (int n = 0; n < 2; ++n) rv[mm][bj][n] = *(const f32x4*)(res + off + bj * HALF + n * 16); }
                asm volatile("" ::: "memory");
#pragma unroll
                for (int mm = 0; mm < 2; ++mm) { const size_t off = (size_t)(u.pm * BM + ai * HALF + wr * 64 + (2 * mp + mm) * 16 + fr) * ldc + col0;
#pragma unroll
                    for (int bj = 0; bj < 2; ++bj)
#pragma unroll
                        for (int n = 0; n < 2; ++n) *(f32x4*)(out + off + bj * HALF + n * 16) = rv[mm][bj][n] + acc[ai][bj][2 * mp + mm][n]; }
                asm volatile("" ::: "memory");
            }
    }
};
struct EpiCin {
    static constexpr bool PERM = true, AFTER_DRAIN = false;
    bf16_t* O; const float* qg; const float* kg; PG8_LAS float* X;
    __device__ __forceinline__ void operator()(const f32x4 (&acc)[2][2][4][2], const Unit& u, int wr, int wc, int fr, int fq) const {
        const int sec = u.pn >> 3, h0 = (u.pn & 7) * 2, b = u.pm >> 4, s0 = (u.pm & 15) * BM + wr * 64 + fr;
        bf16_t* base = O + (size_t)sec * ((size_t)16384 * 2048) + ((size_t)(b * 16 + h0) * 4096) * 128 + wc * 32 + 8 * fq;
        const bool nrm = sec < 2;
        f32x4 g0 = (f32x4){1.f, 1.f, 1.f, 1.f}, g1 = g0;
        if (nrm) {
            const float* gp = (sec ? kg : qg) + wc * 32 + 8 * fq; g0 = *(const f32x4*)gp; g1 = *(const f32x4*)(gp + 4);
#pragma unroll
            for (int ai = 0; ai < 2; ++ai)
#pragma unroll
                for (int m = 0; m < 4; ++m)
#pragma unroll
                    for (int bj = 0; bj < 2; ++bj) { const f32x4 v0 = acc[ai][bj][m][0], v1 = acc[ai][bj][m][1];
                        float ss = ((v0[0] * v0[0] + v0[1] * v0[1]) + (v0[2] * v0[2] + v0[3] * v0[3])) + ((v1[0] * v1[0] + v1[1] * v1[1]) + (v1[2] * v1[2] + v1[3] * v1[3]));
                        ss += __shfl_xor(ss, 16); ss += __shfl_xor(ss, 32);
                        if (fq == 0) X[((ai * HALF + wr * 64 + m * 16 + fr) * 2 + bj) * 4 + wc] = ss; }
            asm volatile("s_waitcnt lgkmcnt(0)" ::: "memory"); __builtin_amdgcn_s_barrier(); asm volatile("" ::: "memory");
        }
#pragma unroll
        for (int ai = 0; ai < 2; ++ai)
#pragma unroll
            for (int m = 0; m < 4; ++m) { bf16_t* rowp = base + (size_t)(s0 + ai * HALF + m * 16) * 128;
#pragma unroll
                for (int bj = 0; bj < 2; ++bj) { f32x4 v0 = acc[ai][bj][m][0], v1 = acc[ai][bj][m][1];
                    if (nrm) { const f32x4 pp = *(const PG8_LAS f32x4*)(X + ((ai * HALF + wr * 64 + m * 16 + fr) * 2 + bj) * 4);
                        const float r = __builtin_amdgcn_rsqf(((pp[0] + pp[1]) + (pp[2] + pp[3])) * (1.0f / 128.0f) + 1e-6f); v0 = v0 * r * g0; v1 = v1 * r * g1; }
                    u32x4 w; w.x = cvt_pk_bf16(v0[0], v0[1]); w.y = cvt_pk_bf16(v0[2], v0[3]); w.z = cvt_pk_bf16(v1[0], v1[1]); w.w = cvt_pk_bf16(v1[2], v1[3]);
                    *(u32x4*)(rowp + (size_t)bj * 4096 * 128) = w; } }
    }
};
__device__ __forceinline__ float dpp_ror1(float v) { return __builtin_bit_cast(float, __builtin_amdgcn_update_dpp(0, __builtin_bit_cast(int, v), 0x121, 0xF, 0xF, false)); }
__device__ __forceinline__ float dpp_ror2(float v) { return __builtin_bit_cast(float, __builtin_amdgcn_update_dpp(0, __builtin_bit_cast(int, v), 0x122, 0xF, 0xF, false)); }
struct EpiConvGate {
    static constexpr bool PERM = true, AFTER_DRAIN = false;
    bf16_t* GA; float* HALO; const float* cw; const float* cb;
    __device__ __forceinline__ void operator()(const f32x4 (&acc)[2][2][4][2], const Unit& u, int wr, int wc, int fr, int fq) const {
        constexpr int F2 = 11264, FH = 5632;
        const int cl = wc * 32 + 8 * fq, ca = u.pn * 128 + cl, ct = u.pn * 256 + cl;
        const bool f1 = fr >= 1, f2 = fr >= 2;
#pragma unroll
        for (int n = 0; n < 2; ++n) {
            const f32x4 wa0 = *(const f32x4*)(cw + ca + 4 * n), wa1 = *(const f32x4*)(cw + F2 + ca + 4 * n), wa2 = *(const f32x4*)(cw + 2 * F2 + ca + 4 * n), ba = *(const f32x4*)(cb + ca + 4 * n);
            const f32x4 wb0 = *(const f32x4*)(cw + FH + ca + 4 * n), wb1 = *(const f32x4*)(cw + F2 + FH + ca + 4 * n), wb2 = *(const f32x4*)(cw + 2 * F2 + FH + ca + 4 * n), bb = *(const f32x4*)(cb + FH + ca + 4 * n);
#pragma unroll
            for (int ai = 0; ai < 2; ++ai) {
                const int grp = u.pm * 4 + ai * 2 + wr;
                f32x4 pa1 = (f32x4){0.f, 0.f, 0.f, 0.f}, pa2 = pa1, pb1 = pa1, pb2 = pa1;
#pragma unroll
                for (int m = 0; m < 4; ++m) {
                    const f32x4 za = acc[ai][0][m][n], zb = acc[ai][1][m][n];
                    f32x4 ra1, ra2, rb1, rb2;
#pragma unroll
                    for (int i = 0; i < 4; ++i) { ra1[i] = dpp_ror1(za[i]); ra2[i] = dpp_ror2(za[i]); rb1[i] = dpp_ror1(zb[i]); rb2[i] = dpp_ror2(zb[i]); }
                    f32x4 a, b;
#pragma unroll
                    for (int i = 0; i < 4; ++i) { const float a1 = f1 ? ra1[i] : pa1[i], a2 = f2 ? ra2[i] : pa2[i], b1 = f1 ? rb1[i] : pb1[i], b2 = f2 ? rb2[i] : pb2[i];
                        a[i] = ba[i] + wa0[i] * a2 + wa1[i] * a1 + wa2[i] * za[i]; b[i] = bb[i] + wb0[i] * b2 + wb1[i] * b1 + wb2[i] * zb[i]; }
                    pa1 = ra1; pa2 = ra2; pb1 = rb1; pb2 = rb2;
                    float g[4];
#pragma unroll
                    for (int i = 0; i < 4; ++i) g[i] = a[i] * __builtin_amdgcn_rcpf(1.0f + __expf(-a[i])) * b[i];
                    const size_t row = (size_t)grp * 64 + m * 16 + fr;
                    unsigned long long w = (unsigned long long)cvt_pk_bf16(g[0], g[1]) | ((unsigned long long)cvt_pk_bf16(g[2], g[3]) << 32);
                    *(unsigned long long*)(GA + row * FH + ca + 4 * n) = w;
                    if (m == 0 && fr < 2) { float* hp = HALO + ((size_t)grp * 4 + fr) * F2 + ct + 4 * n; *(f32x4*)hp = za; *(f32x4*)(hp + 128) = zb; }
                    if (m == 3 && fr >= 14) { float* hp = HALO + ((size_t)grp * 4 + (fr - 12)) * F2 + ct + 4 * n; *(f32x4*)hp = za; *(f32x4*)(hp + 128) = zb; }
                }
            }
        }
    }
};
template <class Epi, class Sched, bool ALIGN_EPI = false, bool SP2 = false>
__device__ __forceinline__ void gemm_phase(PG8_LAS unsigned char* lds, const Gemm g, const Sched& S, const Epi& E) {
    int tid_l = threadIdx.x; asm volatile("" : "+v"(tid_l)); const int tid = tid_l, wid = __builtin_amdgcn_readfirstlane(tid >> 6), lane = tid & 63, wr = wid >> 2, wc = wid & 3, fr = lane & 15, fq = lane >> 4;
    const int K = g.K, nt = K / BK;
    unsigned voffA[2], voffB[2];
#pragma unroll
    for (int i = 0; i < 2; ++i) { int R, C; stage_rc(tid * 16 + i * 8192, R, C); const int Rb = Epi::PERM ? ((R & ~31) + perm32(R & 31)) : R;
        voffA[i] = (unsigned)(R * K + C) * 2u; voffB[i] = (unsigned)(Rb * K + C) * 2u; }
    const size_t kstep = (size_t)(BK * 2);
    const size_t hstep = (size_t)HALF * K * 2;
    const size_t tstep = 2 * hstep;
    const unsigned ldsw = (unsigned)wid * 1024u;
    const int aoff = lds_byte(wr * 64 + fr, fq * 8), boff = lds_byte(wc * 32 + fr, fq * 8);
#define PG8_SA(b, h) (((b) * 2 + (h)) * HTB)
#define PG8_SB(b, h) ((4 + (b) * 2 + (h)) * HTB)
#define PG8_STAGE(bufoff, gbase, voff) do { _Pragma("unroll") for (int _i = 0; _i < 2; ++_i) \
        __builtin_amdgcn_global_load_lds((const unsigned*)((const char*)(gbase) + (voff)[_i]), (PG8_LAS unsigned*)(lds + (bufoff) + ldsw + _i * 8192), 16, 0, 0); } while (0)
#define PG8_LDA(dst, b, h) do { _Pragma("unroll") for (int m = 0; m < 4; ++m) _Pragma("unroll") for (int k = 0; k < 2; ++k) dst[m][k] = *(const PG8_LAS bf16x8*)(lds + PG8_SA(b, h) + aoff + m * 2048 + k * 1024); } while (0)
#define PG8_LDB(dst, b, h) do { _Pragma("unroll") for (int n = 0; n < 2; ++n) _Pragma("unroll") for (int k = 0; k < 2; ++k) dst[n][k] = *(const PG8_LAS bf16x8*)(lds + PG8_SB(b, h) + boff + n * 2048 + k * 1024); } while (0)
#define PG8_MMA(ai, bj, At, Bt) do { __builtin_amdgcn_s_setprio(1); _Pragma("unroll") for (int m = 0; m < 4; ++m) _Pragma("unroll") for (int n = 0; n < 2; ++n) _Pragma("unroll") for (int k = 0; k < 2; ++k) \
        acc[ai][bj][m][n] = __builtin_amdgcn_mfma_f32_16x16x32_bf16(Bt[n][k], At[m][k], acc[ai][bj][m][n], 0, 0, 0); __builtin_amdgcn_s_setprio(0); } while (0)
#define PG8_WAIT_V(n) asm volatile("s_waitcnt vmcnt(" #n ")" ::: "memory")
#define PG8_WAIT_L(n) asm volatile("s_waitcnt lgkmcnt(" #n ")" ::: "memory")
#define PG8_BAR __builtin_amdgcn_s_barrier()
#define PG8_SCHED __builtin_amdgcn_sched_barrier(0)
    Unit cur, nxt; int ui = 0;
    if (!S.next(0, cur)) return;
    f32x4 acc[2][2][4][2];
#pragma unroll
    for (int a = 0; a < 2; ++a)
#pragma unroll
        for (int b = 0; b < 2; ++b)
#pragma unroll
            for (int m = 0; m < 4; ++m)
#pragma unroll
                for (int n = 0; n < 2; ++n) acc[a][b][m][n] = (f32x4){0.f, 0.f, 0.f, 0.f};
    bf16x8 At[4][2], B0[2][2], B1[2][2];
    const char* cA = (const char*)g.A + (size_t)cur.pm * tstep; const char* cB = (const char*)g.Bt + (size_t)cur.pn * tstep;
    S.a_ready(cur);
    if constexpr (SP2) {
        PG8_STAGE(PG8_SB(0, 0), cB, voffB); PG8_STAGE(PG8_SB(0, 1), cB + hstep, voffB); PG8_STAGE(PG8_SA(0, 0), cA, voffA); PG8_STAGE(PG8_SA(0, 1), cA + hstep, voffA);
        if (wr == 1) PG8_BAR;
        PG8_WAIT_V(2); PG8_BAR;
        PG8_STAGE(PG8_SB(1, 0), cB + kstep, voffB); PG8_STAGE(PG8_SA(1, 0), cA + kstep, voffA); PG8_STAGE(PG8_SB(1, 1), cB + hstep + kstep, voffB);
        PG8_WAIT_V(6); PG8_BAR;
    } else {
        PG8_STAGE(PG8_SB(0, 0), cB, voffB); PG8_STAGE(PG8_SA(0, 0), cA, voffA); PG8_STAGE(PG8_SB(0, 1), cB + hstep, voffB); PG8_STAGE(PG8_SA(0, 1), cA + hstep, voffA);
        if (wr == 1) PG8_BAR;
        PG8_WAIT_V(4); PG8_BAR;
        PG8_STAGE(PG8_SB(1, 0), cB + kstep, voffB); PG8_STAGE(PG8_SA(1, 0), cA + kstep, voffA); PG8_STAGE(PG8_SB(1, 1), cB + hstep + kstep, voffB);
        PG8_WAIT_V(6); PG8_BAR;
    }
    for (;;) {
        const bool has_next = S.next(ui + 1, nxt);
        const char* nA = has_next ? (const char*)g.A + (size_t)nxt.pm * tstep : cA; const char* nB = has_next ? (const char*)g.Bt + (size_t)nxt.pn * tstep : cB;
        for (int t = 0; t < nt; t += 2) {
            const bool last = (t == nt - 2);
            const char* a1 = cA + (size_t)(t + 1) * kstep;
            const char* a2 = last ? nA : cA + (size_t)(t + 2) * kstep; const char* b2 = last ? nB : cB + (size_t)(t + 2) * kstep;
            const char* a3 = a2 + kstep; const char* b3 = b2 + kstep;
            if (last && has_next) S.a_ready(nxt);
            if constexpr (SP2) {
            PG8_LDB(B0, 0, 0); PG8_LDB(B1, 0, 1); PG8_SCHED; PG8_LDA(At, 0, 0); PG8_STAGE(PG8_SA(1, 1), a1 + hstep, voffA);
            PG8_WAIT_V(8); PG8_WAIT_L(0); PG8_BAR; PG8_MMA(0, 0, At, B0); PG8_MMA(0, 1, At, B1); PG8_BAR; PG8_SCHED;
            PG8_LDA(At, 0, 1); PG8_STAGE(PG8_SB(0, 0), b2, voffB); PG8_STAGE(PG8_SB(0, 1), b2 + hstep, voffB); PG8_STAGE(PG8_SA(0, 0), a2, voffA);
            PG8_WAIT_V(8); PG8_WAIT_L(0); PG8_BAR; PG8_MMA(1, 0, At, B0); PG8_MMA(1, 1, At, B1); PG8_BAR; PG8_SCHED;
            PG8_LDB(B0, 1, 0); PG8_LDB(B1, 1, 1); PG8_SCHED; PG8_LDA(At, 1, 0); PG8_STAGE(PG8_SA(0, 1), a2 + hstep, voffA);
            PG8_WAIT_V(8); PG8_WAIT_L(0); PG8_BAR; PG8_MMA(0, 0, At, B0); PG8_MMA(0, 1, At, B1); PG8_BAR; PG8_SCHED;
            PG8_LDA(At, 1, 1); PG8_STAGE(PG8_SB(1, 0), b3, voffB); PG8_STAGE(PG8_SB(1, 1), b3 + hstep, voffB); PG8_STAGE(PG8_SA(1, 0), a3, voffA);
            PG8_WAIT_V(8); PG8_WAIT_L(0); PG8_BAR; PG8_MMA(1, 0, At, B0); PG8_MMA(1, 1, At, B1); PG8_BAR; PG8_SCHED;
            } else {
            PG8_LDB(B0, 0, 0); PG8_SCHED; PG8_LDA(At, 0, 0); PG8_STAGE(PG8_SA(1, 1), a1 + hstep, voffA);
            PG8_WAIT_L(8); PG8_BAR; PG8_WAIT_L(0); PG8_MMA(0, 0, At, B0); PG8_BAR; PG8_SCHED;
            PG8_LDB(B1, 0, 1); PG8_STAGE(PG8_SB(0, 0), b2, voffB);
            PG8_BAR; PG8_WAIT_L(0); PG8_MMA(0, 1, At, B1); PG8_BAR;
            PG8_LDA(At, 0, 1); PG8_STAGE(PG8_SA(0, 0), a2, voffA);
            PG8_BAR; PG8_WAIT_L(0); PG8_MMA(1, 0, At, B0); PG8_BAR; PG8_SCHED;
            PG8_STAGE(PG8_SB(0, 1), b2 + hstep, voffB);
            PG8_WAIT_V(6); PG8_BAR; PG8_MMA(1, 1, At, B1); PG8_BAR;
            PG8_LDB(B0, 1, 0); PG8_SCHED; PG8_LDA(At, 1, 0); PG8_STAGE(PG8_SA(0, 1), a2 + hstep, voffA);
            PG8_WAIT_L(8); PG8_BAR; PG8_WAIT_L(0); PG8_MMA(0, 0, At, B0); PG8_BAR; PG8_SCHED;
            PG8_LDB(B1, 1, 1); PG8_STAGE(PG8_SB(1, 0), b3, voffB);
            PG8_BAR; PG8_WAIT_L(0); PG8_MMA(0, 1, At, B1); PG8_BAR;
            PG8_LDA(At, 1, 1); PG8_STAGE(PG8_SA(1, 0), a3, voffA);
            PG8_BAR; PG8_WAIT_L(0); PG8_MMA(1, 0, At, B0); PG8_BAR; PG8_SCHED;
            PG8_STAGE(PG8_SB(1, 1), b3 + hstep, voffB);
            PG8_WAIT_V(6); PG8_BAR; PG8_MMA(1, 1, At, B1); PG8_BAR;
            }
        }
        if constexpr (ALIGN_EPI) { if (wr == 0) PG8_BAR; }
        if constexpr (!Epi::AFTER_DRAIN) { E(acc, cur, wr, wc, fr, fq); S.done(cur); }
        if (!has_next) break;
#pragma unroll
        for (int a = 0; a < 2; ++a)
#pragma unroll
            for (int b = 0; b < 2; ++b)
#pragma unroll
                for (int m = 0; m < 4; ++m)
#pragma unroll
                    for (int n = 0; n < 2; ++n) acc[a][b][m][n] = (f32x4){0.f, 0.f, 0.f, 0.f};
        cur = nxt; cA = nA; cB = nB; ++ui;
        if constexpr (ALIGN_EPI) { if (wr == 1) PG8_BAR; }
    }
    PG8_WAIT_V(0);
    if constexpr (!ALIGN_EPI) { if (wr == 0) PG8_BAR; }
    PG8_BAR;
    if constexpr (Epi::AFTER_DRAIN) { E.fused(acc, cur, wr, wc, fr, fq, lds, wid, lane); S.done(cur); }
#undef PG8_SA
#undef PG8_SB
#undef PG8_STAGE
#undef PG8_LDA
#undef PG8_LDB
#undef PG8_MMA
#undef PG8_WAIT_V
#undef PG8_WAIT_L
#undef PG8_BAR
#undef PG8_SCHED
}
}
namespace fox {
constexpr int D = 128, PQ = 128, PO = 2048;
constexpr float THR = 8.f; constexpr bool WSKIP = false;
constexpr float SCALE = 0.08838834764831845f;
constexpr int NW = 8, QBLK = 32, KVBLK = 64, QB = NW * QBLK;
constexpr int SHM_V = KVBLK * D * 2, SHM_K = KVBLK * D * 2;
constexpr int LDS_CB = 2 * SHM_V + 2 * SHM_K + NW * 64 * 4;
constexpr int LDS_BYTES = LDS_CB + 4096 * 4;

using bf16 = __hip_bfloat16;
typedef short bf16x8 __attribute__((ext_vector_type(8)));
typedef short s16x4 __attribute__((ext_vector_type(4)));
typedef float f32x16 __attribute__((ext_vector_type(16)));
typedef float f32x4 __attribute__((ext_vector_type(4)));
typedef unsigned u32x4 __attribute__((ext_vector_type(4)));
template <class A, class Bt> struct same_t { static constexpr bool v = false; };
template <class A> struct same_t<A, A> { static constexpr bool v = true; };

#define KSWZ(row, colB) ((row) * 256 + ((colB) ^ (((row) & 7) << 4)))
#define SBAR() __builtin_amdgcn_sched_barrier(0)
__device__ __forceinline__ int v_st(int k, int c) { const int kk = (k & ~0xC) | ((k & 4) << 1) | ((k & 8) >> 1); return ((kk >> 3) * 4 + (c >> 5)) * 512 + ((kk & 7) * 32 + (c & 31)) * 2; }
__device__ __forceinline__ int v_rd_base(int lane) { return ((lane & 3) << 3) | (((lane >> 2) & 3) << 6) | (((lane >> 4) & 1) << 5) | (((lane >> 5) & 1) << 8); }
constexpr int v_rd_off(int d0, int ks, int half) { return d0 * 512 + ks * 4096 + half * 2048; }
__device__ __forceinline__ int crow(int r, int hi) { return (r & 3) + 8 * (r >> 2) + 4 * hi; }
__device__ __forceinline__ unsigned cvtpk(float lo, float hi) {
    unsigned r; asm volatile("v_cvt_pk_bf16_f32 %0, %1, %2" : "=v"(r) : "v"(lo), "v"(hi)); return r;
}
__device__ __forceinline__ bf16x8 pack8(f32x4 a, f32x4 b) {
    u32x4 w = {cvtpk(a[0], a[1]), cvtpk(a[2], a[3]), cvtpk(b[0], b[1]), cvtpk(b[2], b[3])};
    return *reinterpret_cast<bf16x8*>(&w);
}
template <class T> __device__ __forceinline__ bf16x8 load8(const T* p) {
    if constexpr (same_t<T, float>::v) { return pack8(*(const f32x4*)p, *(const f32x4*)(p + 4)); }
    else { return *reinterpret_cast<const bf16x8*>(p); }
}
__device__ __forceinline__ void mask_tile(f32x16& p0, f32x16& p1, int dq, unsigned W) {
    const float NEG = -__builtin_inff();
#pragma unroll
    for (int r = 0; r < 16; ++r) {
        const int c = (r & 3) + 8 * (r >> 2);
        if ((unsigned)(dq - c) >= W) p0[r] = NEG;
        if ((unsigned)(dq - c - 32) >= W) p1[r] = NEG;
    }
}
__device__ __forceinline__ void partialSM(f32x16& p0, f32x16& p1, float& m_reg, float& mn, float& alpha) {
    float pmax = p0[0]; for (int r = 1; r < 16; ++r) pmax = fmaxf(pmax, p0[r]); for (int r = 0; r < 16; ++r) pmax = fmaxf(pmax, p1[r]);
    { auto rr = __builtin_amdgcn_permlane32_swap(__float_as_uint(pmax), __float_as_uint(pmax), false, false);
      pmax = fmaxf(__uint_as_float(rr[0]), __uint_as_float(rr[1])); }
    constexpr float C2 = 1.4426950408889634f * SCALE;
    if (__builtin_expect(__all((pmax - m_reg) * SCALE <= THR), 1)) { mn = m_reg; alpha = 1.f; }
    else { mn = fmaxf(m_reg, pmax); alpha = __builtin_amdgcn_exp2f((m_reg - mn) * C2); m_reg = mn; }
    const float mnL = -mn * C2;
    for (int r = 0; r < 16; ++r) p0[r] = fmaf(p0[r], C2, mnL); for (int r = 0; r < 16; ++r) p1[r] = fmaf(p1[r], C2, mnL);
    for (int r = 0; r < 16; ++r) p0[r] = __builtin_amdgcn_exp2f(p0[r]);
}
__device__ __forceinline__ void finishSM(f32x16& p0, f32x16& p1, float alpha, float& l_reg, bf16x8& pa0, bf16x8& pa1, bf16x8& pa2, bf16x8& pa3) {
    for (int r = 0; r < 16; ++r) p1[r] = __builtin_amdgcn_exp2f(p1[r]);
    float ps = 0; for (int r = 0; r < 16; ++r) ps += p0[r]; for (int r = 0; r < 16; ++r) ps += p1[r];
    { auto rr = __builtin_amdgcn_permlane32_swap(__float_as_uint(ps), __float_as_uint(ps), false, false);
      ps = __uint_as_float(rr[0]) + __uint_as_float(rr[1]); }
    l_reg = l_reg * alpha + ps;
#define PK4(P, B_, OUT) do { unsigned a0 = cvtpk(P[B_+0], P[B_+1]), a1 = cvtpk(P[B_+2], P[B_+3]);                          \
        unsigned b0 = cvtpk(P[B_+4], P[B_+5]), b1 = cvtpk(P[B_+6], P[B_+7]);                                             \
        auto r0 = __builtin_amdgcn_permlane32_swap(a0, b0, false, false); auto r1 = __builtin_amdgcn_permlane32_swap(a1, b1, false, false); \
        u32x4 w = {r0[0], r1[0], r0[1], r1[1]}; OUT = *reinterpret_cast<bf16x8*>(&w); } while (0)
    PK4(p0, 0, pa0); PK4(p0, 8, pa1); PK4(p1, 0, pa2); PK4(p1, 8, pa3);
#undef PK4
}
__device__ __forceinline__ void bias_init(f32x16& p0, f32x16& p1, const float* cbt) {
#pragma unroll
    for (int g = 0; g < 4; ++g) { const f32x4 b0v = *(const f32x4*)(cbt + 8 * g), b1v = *(const f32x4*)(cbt + 32 + 8 * g);
        p0[4 * g] = b0v[0]; p0[4 * g + 1] = b0v[1]; p0[4 * g + 2] = b0v[2]; p0[4 * g + 3] = b0v[3];
        p1[4 * g] = b1v[0]; p1[4 * g + 1] = b1v[1]; p1[4 * g + 2] = b1v[2]; p1[4 * g + 3] = b1v[3]; }
}
template <int KB, bool SK>
__device__ __forceinline__ void qkt(f32x16& p0, f32x16& p1, const char* K_lds, int r32, int hi, const bf16x8* qr, bool act, const float* cbt) {
    if (SK && !act) { const float NEG = -__builtin_inff();
#pragma unroll
        for (int r = 0; r < 16; ++r) { p0[r] = NEG; p1[r] = NEG; } return; }
    (void)cbt;
    const char* kb[4];
#pragma unroll
    for (int dd = 0; dd < 4; ++dd) kb[dd] = K_lds + KB * SHM_K + KSWZ(r32, (dd * 16 + hi * 8) * 2);
#pragma unroll
    for (int d0 = 0; d0 < 8; ++d0) { const char* a = kb[d0 & 3] + (d0 >> 2) * 128;
        bf16x8 b0 = *reinterpret_cast<const bf16x8*>(a);
        bf16x8 b1 = *reinterpret_cast<const bf16x8*>(a + 32 * 256);
        p0 = __builtin_amdgcn_mfma_f32_32x32x16_bf16(b0, qr[d0], p0, 0, 0, 0);
        p1 = __builtin_amdgcn_mfma_f32_32x32x16_bf16(b1, qr[d0], p1, 0, 0, 0); }
}
template <int VB, bool SK>
__device__ __forceinline__ void pv_tile(f32x16* o, int vb0, bf16x8 pa0, bf16x8 pa1, bf16x8 pa2, bf16x8 pa3, bool act) {
    if (SK && !act) return;
#define TRRD(dst, off) asm volatile("ds_read_b64_tr_b16 %0, %1 offset:%2" : "=&v"(dst) : "v"(vb0), "i"(off) : "memory")
#define PV_D0(d0) do { s16x4 l0, l1, l2, l3, h0, h1, h2, h3; constexpr int b_ = VB * SHM_V + v_rd_off(d0, 0, 0);     \
        TRRD(l0, b_); TRRD(h0, b_ + 2048); TRRD(l1, b_ + 4096); TRRD(h1, b_ + 6144); TRRD(l2, b_ + 8192); TRRD(h2, b_ + 10240); TRRD(l3, b_ + 12288); TRRD(h3, b_ + 14336); \
        asm volatile("s_waitcnt lgkmcnt(0)" ::: "memory"); SBAR();                 \
        o[d0] = __builtin_amdgcn_mfma_f32_32x32x16_bf16(pa0, (bf16x8){l0[0], l0[1], l0[2], l0[3], h0[0], h0[1], h0[2], h0[3]}, o[d0], 0, 0, 0);   \
        o[d0] = __builtin_amdgcn_mfma_f32_32x32x16_bf16(pa1, (bf16x8){l1[0], l1[1], l1[2], l1[3], h1[0], h1[1], h1[2], h1[3]}, o[d0], 0, 0, 0);   \
        o[d0] = __builtin_amdgcn_mfma_f32_32x32x16_bf16(pa2, (bf16x8){l2[0], l2[1], l2[2], l2[3], h2[0], h2[1], h2[2], h2[3]}, o[d0], 0, 0, 0);   \
        o[d0] = __builtin_amdgcn_mfma_f32_32x32x16_bf16(pa3, (bf16x8){l3[0], l3[1], l3[2], l3[3], h3[0], h3[1], h3[2], h3[3]}, o[d0], 0, 0, 0); } while (0)
    PV_D0(0); PV_D0(1); PV_D0(2); PV_D0(3);
#undef PV_D0
#undef TRRD
}

__device__ __forceinline__ int fox_jlo(const float* cb, int P0, float margin) {
    const int lane = threadIdx.x & 63, nt0 = P0 / KVBLK;
    const float thr = cb[P0] + margin;
    bool dead = false; if (lane < nt0) dead = cb[KVBLK * lane + KVBLK - 1] > thr;
    const unsigned long long m = __ballot(dead);
    return __builtin_amdgcn_readfirstlane((int)__builtin_ctzll(~m));
}
template <class TIn, class TOut> struct BlockRef { const TIn* Q; const TIn* K; const TIn* V; TOut* O; int P0; const float* cb; const TIn* Gt; };
template <class TIn> struct Seam {
    bf16x8 qr[8];
    bf16x8 st_v0, st_v1, st_k0, st_k1; f32x4 sf0, sf1, sf2, sf3;
    f32x4 tq[16];
};
__device__ __forceinline__ int swa_jlo(int P0, int W) { const int lowk = P0 - W + 1; return lowk > 0 ? lowk / KVBLK : 0; }
#define ROW(p, k0, rr) ((p) + (size_t)((k0) + (rr)) * PQ + sc)
#define VMW() asm volatile("s_waitcnt vmcnt(0)" ::: "memory")
#define VMWN(n) asm volatile("s_waitcnt vmcnt(%0)" :: "i"(n) : "memory")
#define SLOAD_H(Kp, Vp, k0) do { S.st_v0 = load8<TIn>(ROW(Vp, k0, sr)); S.st_v1 = load8<TIn>(ROW(Vp, k0, 32 + sr));              \
                         S.st_k0 = load8<TIn>(ROW(Kp, k0, sr)); S.st_k1 = load8<TIn>(ROW(Kp, k0, 32 + sr)); } while (0)
#define SWRITE_HK(bf) do { *(bf16x8*)(K_lds + (bf) * SHM_K + kws) = S.st_k0; *(bf16x8*)(K_lds + (bf) * SHM_K + kws + 32 * 256) = S.st_k1; } while (0)
#define SWRITE_HV(bf) do { *(bf16x8*)(V_lds + (bf) * SHM_V + vst0) = S.st_v0; *(bf16x8*)(V_lds + (bf) * SHM_V + vst1) = S.st_v1; } while (0)
#define SWRITE_H(bf) do { SWRITE_HV(bf); SWRITE_HK(bf); } while (0)
#define SLOAD_F(p, k0) do { S.sf0 = *(const f32x4*)ROW(p, k0, sr); S.sf1 = *(const f32x4*)(ROW(p, k0, sr) + 4);                \
                            S.sf2 = *(const f32x4*)ROW(p, k0, 32 + sr); S.sf3 = *(const f32x4*)(ROW(p, k0, 32 + sr) + 4); } while (0)
#define SWRITE_KF(bf) do { *(bf16x8*)(K_lds + (bf) * SHM_K + kws) = pack8(S.sf0, S.sf1); *(bf16x8*)(K_lds + (bf) * SHM_K + kws + 32 * 256) = pack8(S.sf2, S.sf3); } while (0)
#define SWRITE_VF(bf) do { *(bf16x8*)(V_lds + (bf) * SHM_V + vst0) = pack8(S.sf0, S.sf1); *(bf16x8*)(V_lds + (bf) * SHM_V + vst1) = pack8(S.sf2, S.sf3); } while (0)
template <class TIn, class TOut>
__device__ __forceinline__ void causal_swa_prime(const BlockRef<TIn, TOut>& cur, int W, char* lds, Seam<TIn>& S) {
    constexpr bool F32 = same_t<TIn, float>::v;
    int tid_l = threadIdx.x; asm volatile("" : "+v"(tid_l)); const int tid = tid_l, wid = __builtin_amdgcn_readfirstlane(tid >> 6), lane = tid & 63, r32 = lane & 31, hi = lane >> 5;
    const int sr = tid >> 4, sc = (tid & 15) * 8, kws = KSWZ(sr, sc * 2); char* K_lds = lds + 2 * SHM_V;
    const int kb0 = swa_jlo(cur.P0, W) * KVBLK;
    for (int d0 = 0; d0 < 8; ++d0) S.qr[d0] = load8<TIn>(cur.Q + (size_t)(wid * QBLK + r32) * PQ + d0 * 16 + hi * 8);
    if constexpr (F32) { SLOAD_F((const float*)cur.K, kb0); VMW(); SWRITE_KF(0); SBAR(); SLOAD_F((const float*)cur.V, kb0); }
    else { SLOAD_H(cur.K, cur.V, kb0); VMW(); SWRITE_HK(0); }
    __syncthreads();
}
template <class TIn, class TOut>
__device__ __forceinline__ void causal_swa_block(const BlockRef<TIn, TOut>& cur, const BlockRef<TIn, TOut>& nxt, int skv, int W, char* lds, Seam<TIn>& S) {
    constexpr bool F32 = same_t<TIn, float>::v;
    int tid_l = threadIdx.x; asm volatile("" : "+v"(tid_l)); const int tid = tid_l, wid = __builtin_amdgcn_readfirstlane(tid >> 6), lane = tid & 63, r32 = lane & 31, hi = lane >> 5;
    const int j_lo = swa_jlo(cur.P0, W);
    int j_hi = (cur.P0 + QB - 1) / KVBLK + 1; if (j_hi > skv / KVBLK) j_hi = skv / KVBLK;
    const int NT = j_hi - j_lo;
    const int kbn = swa_jlo(nxt.P0, W) * KVBLK;
    const int qlo = cur.P0 + wid * QBLK, qm = qlo + r32 - 4 * hi;
    char* V_lds = lds; char* K_lds = lds + 2 * SHM_V;
    float* ws = (float*)(lds + 2 * SHM_V + 2 * SHM_K) + wid * 64; float* li_l = ws, * al_l = ws + 32;
    float m_reg = -1e30f, l_reg = 0; f32x16 o[4] = {};
    float* cbl = (float*)(lds + LDS_CB);
    { const float cref = cur.cb[cur.P0]; const float rs = 1.0f / SCALE;
      for (int i = tid; i < cur.P0 + QB; i += 64 * NW) cbl[i] = (cref - cur.cb[i]) * rs;
      __syncthreads(); }
    const float* cbh = cbl + 4 * hi;
    const int sr = tid >> 4, sc = (tid & 15) * 8, vst0 = v_st(sr, sc), vst1 = v_st(32 + sr, sc), kws = KSWZ(sr, sc * 2);
    const int vb0 = (int)(uintptr_t)V_lds + v_rd_base(lane);
    const TIn* Kh = cur.K; const TIn* Vh = cur.V;
#define RESC(a) do { if (__any((a) < 1.f)) { if (hi == 0) al_l[r32] = (a); asm volatile("s_waitcnt lgkmcnt(0)" ::: "memory");              \
                     for (int d_ = 0; d_ < 4; ++d_) for (int r = 0; r < 16; ++r) o[d_][r] *= al_l[crow(r, hi)]; } } while (0)
#define KBASE(t) ((j_lo + (t)) * KVBLK)
#define ACT(t) (KBASE(t) <= qlo + QBLK - 1 && KBASE(t) + KVBLK - 1 >= qlo - W + 1)
#define MASKT(P0_, P1_, t) do { const int kb_ = KBASE(t); if ((!SK || ACT(t)) && (kb_ + KVBLK - 1 > qlo || kb_ <= qlo + QBLK - 1 - W)) mask_tile(P0_, P1_, qm - kb_, (unsigned)W); } while (0)
    constexpr int NQL = F32 ? 16 : 8;
    constexpr bool SK = WSKIP && !F32;
#define SEAM_K0() do { VMWN(NQL); if constexpr (F32) { SWRITE_KF(0); SBAR(); SLOAD_F((const float*)nxt.V, kbn); } else { SWRITE_HK(0); } SBAR(); } while (0)
    f32x16 pA0, pA1, pB0, pB1; float mnA, mnB, alA, alB; bf16x8 pa0, pa1, pa2, pa3;
    if constexpr (F32) { VMW(); SWRITE_VF(0); SBAR(); } else { SWRITE_HV(0); SBAR(); }
    if (NT > 1) { if constexpr (F32) SLOAD_F((const float*)Kh, KBASE(1)); else SLOAD_H(Kh, Vh, KBASE(1)); }
    bias_init(pA0, pA1, cbh + KBASE(0)); if (NT > 1) bias_init(pB0, pB1, cbh + KBASE(1));
    SBAR(); qkt<0, SK>(pA0, pA1, K_lds, r32, hi, S.qr, ACT(0), cbh + KBASE(0));
    if constexpr (F32) { if (NT > 1) { VMW(); SWRITE_KF(1); SBAR(); SLOAD_F((const float*)Vh, KBASE(1)); } }
    MASKT(pA0, pA1, 0); partialSM(pA0, pA1, m_reg, mnA, alA);
    if (NT > 1) { VMW(); if constexpr (F32) { SWRITE_VF(1); SBAR(); if (NT > 2) SLOAD_F((const float*)Kh, KBASE(2)); } else SWRITE_H(1); }
    __syncthreads();
#define HALF_STEP(PX0, PX1, mnX, alX, PY0, PY1, alY, t, KB, VB, SB) do {                                                      \
        SBAR(); qkt<KB, SK>(PX0, PX1, K_lds, r32, hi, S.qr, ACT(t), cbh + KBASE(t));                             \
        finishSM(PY0, PY1, alY, l_reg, pa0, pa1, pa2, pa3); SBAR();                                                           \
        if ((t) + 1 < NT) bias_init(PY0, PY1, cbh + KBASE((t) + 1));                                                          \
        if ((t) + 1 < NT) { if constexpr (F32) { VMW(); SWRITE_KF(SB); SBAR(); SLOAD_F((const float*)Vh, KBASE((t) + 1)); }  \
                            else { SLOAD_H(Kh, Vh, KBASE((t) + 1)); } SBAR(); }                                               \
        pv_tile<VB, SK>(o, vb0, pa0, pa1, pa2, pa3, ACT((t) - 1)); MASKT(PX0, PX1, (t)); partialSM(PX0, PX1, m_reg, mnX, alX);                                        \
        __syncthreads();                                                                                                      \
        if ((t) + 1 < NT) { VMW(); if constexpr (F32) { SWRITE_VF(SB); SBAR(); if ((t) + 2 < NT) SLOAD_F((const float*)Kh, KBASE((t) + 2)); } \
                            else { SWRITE_H(SB); } }                                                                          \
        RESC(alX); __syncthreads(); } while (0)
    for (int t = 1; t + 1 < NT; t += 2) {
        HALF_STEP(pB0, pB1, mnB, alB, pA0, pA1, alA, t, 1, 0, 0);
        HALF_STEP(pA0, pA1, mnA, alA, pB0, pB1, alB, t + 1, 0, 1, 1);
    }
    const bool even = (NT & 1) == 0;
    if (even) { SBAR(); qkt<1, SK>(pB0, pB1, K_lds, r32, hi, S.qr, ACT(NT - 1), cbh + KBASE(NT - 1)); SBAR(); }
#define QROW(e) (nxt.Q + (size_t)(wid * QBLK + r32) * PQ + ((e) >> 1) * 16 + hi * 8 + ((e) & 1) * 4)
    if constexpr (F32) { SLOAD_F((const float*)nxt.K, kbn); SBAR();
#pragma unroll
        for (int e = 0; e < 8; ++e) S.tq[e] = *(const f32x4*)QROW(e); }
    else { SLOAD_H(nxt.K, nxt.V, kbn); SBAR();
#pragma unroll
        for (int d0 = 0; d0 < 8; ++d0) S.qr[d0] = load8<TIn>(nxt.Q + (size_t)(wid * QBLK + r32) * PQ + d0 * 16 + hi * 8); }
    SBAR();
    finishSM(pA0, pA1, alA, l_reg, pa0, pa1, pa2, pa3); SBAR();
    if constexpr (F32) {
#pragma unroll
        for (int e = 8; e < 16; ++e) S.tq[e] = *(const f32x4*)QROW(e); SBAR(); }
#undef QROW
    pv_tile<0, SK>(o, vb0, pa0, pa1, pa2, pa3, ACT(even ? NT - 2 : NT - 1));
    if (even) { MASKT(pB0, pB1, NT - 1); partialSM(pB0, pB1, m_reg, mnB, alB); __syncthreads(); RESC(alB);
        finishSM(pB0, pB1, alB, l_reg, pa0, pa1, pa2, pa3); SBAR(); pv_tile<1, SK>(o, vb0, pa0, pa1, pa2, pa3, ACT(NT - 1)); }
    SBAR(); SEAM_K0();
    if (hi == 0) li_l[r32] = l_reg; asm volatile("s_waitcnt lgkmcnt(0)" ::: "memory");
    float rli[16];
#pragma unroll
    for (int r = 0; r < 16; ++r) rli[r] = __builtin_amdgcn_rcpf(li_l[crow(r, hi)]);
    TOut* Ow = cur.O + (size_t)(wid * QBLK) * PO; const TIn* Gw = cur.Gt + (size_t)(wid * QBLK) * PQ;
    const unsigned short* Gu = reinterpret_cast<const unsigned short*>(Gw);
#pragma unroll
    for (int rh = 0; rh < 2; ++rh) {
        unsigned gr[8][4];
#pragma unroll
        for (int r8 = 0; r8 < 8; ++r8)
#pragma unroll
            for (int d0 = 0; d0 < 4; ++d0) gr[r8][d0] = Gu[(size_t)crow(8 * rh + r8, hi) * PQ + d0 * 32 + r32];
        asm volatile("" ::: "memory");
#pragma unroll
        for (int r8 = 0; r8 < 8; ++r8) { const int r = 8 * rh + r8, orow = crow(r, hi);
#pragma unroll
            for (int d0 = 0; d0 < 4; ++d0) { const float gv = __uint_as_float(gr[r8][d0] << 16); const float v = o[d0][r] * rli[r] * __builtin_amdgcn_rcpf(1.0f + __expf(-gv));
                if constexpr (same_t<TOut, float>::v) { Ow[(size_t)orow * PO + d0 * 32 + r32] = v; }
                else { const float vn = __shfl_xor(v, 1);
                       if ((r32 & 1) == 0) *(unsigned*)(Ow + (size_t)orow * PO + d0 * 32 + r32) = cvtpk(v, vn); } } }
    }
    if constexpr (F32) {
#pragma unroll
        for (int d0 = 0; d0 < 8; ++d0) S.qr[d0] = pack8(S.tq[2 * d0], S.tq[2 * d0 + 1]); }
    __syncthreads();
#undef RESC
#undef KBASE
#undef ACT
#undef MASKT
#undef SEAM_K0
#undef HALF_STEP
}
#undef ROW
#undef VMW
#undef VMWN
#undef SLOAD_H
#undef SWRITE_HK
#undef SWRITE_HV
#undef SWRITE_H
#undef SLOAD_F
#undef SWRITE_KF
#undef SWRITE_VF

}
constexpr int NTOK = 16384, DMOD = 2048, SEQL = 4096, NBAT = 4;
constexpr int ABIN = 6144, FFH = 5632, FF2 = 11264, CINW = 8208, CINP = 8448;
constexpr float RMS_EPS = 1e-6f;
constexpr size_t WS_WABIN = 0;
constexpr size_t WS_WABOUT = WS_WABIN + (size_t)ABIN * DMOD * 2;
constexpr size_t WS_WCIN = WS_WABOUT + (size_t)DMOD * DMOD * 2;
constexpr size_t WS_WCOUT = WS_WCIN + (size_t)CINP * DMOD * 2;
constexpr size_t WS_WUP0 = WS_WCOUT + (size_t)DMOD * DMOD * 2;
constexpr size_t WS_WUP1 = WS_WUP0 + (size_t)FF2 * DMOD * 2;
constexpr size_t WS_WDN0 = WS_WUP1 + (size_t)FF2 * DMOD * 2;
constexpr size_t WS_WDN1 = WS_WDN0 + (size_t)DMOD * FFH * 2;
constexpr size_t WS_ACT = WS_WDN1 + (size_t)DMOD * FFH * 2;
constexpr size_t WS_BIG = WS_ACT + (size_t)NTOK * DMOD * 2;
constexpr size_t WS_Z1 = WS_BIG;
constexpr size_t WS_HL = WS_Z1 + (size_t)NTOK * ABIN * 2;
constexpr size_t WS_DEC = WS_HL + (size_t)32 * 64 * 128 * 128 * 2;
constexpr size_t WS_END_AB = WS_DEC + (size_t)32 * 64 * 128 * 4;
constexpr size_t WS_GA = WS_BIG;
constexpr size_t WS_HALO = WS_GA + (size_t)NTOK * FFH * 2;
constexpr size_t WS_END_FFN = WS_HALO + (size_t)256 * 4 * FF2 * 4;
constexpr size_t WS_QKVG = WS_BIG;
constexpr size_t WS_F = WS_QKVG + (size_t)NTOK * 8192 * 2;
constexpr size_t WS_C = WS_F + (size_t)2 * NTOK * 16 * 4;
constexpr size_t WS_END_C = WS_C + (size_t)64 * 4096 * 4;
constexpr size_t WS_NEED = WS_END_FFN > WS_END_AB ? (WS_END_FFN > WS_END_C ? WS_END_FFN : WS_END_C) : (WS_END_AB > WS_END_C ? WS_END_AB : WS_END_C);
constexpr size_t WS_BAR = (WS_NEED + 255) / 256 * 256;
constexpr size_t WS_TOTAL = WS_BAR + 16384;
constexpr int LDS_BYTES = 147456, LDS_MISC = LDS_BYTES - 128;
constexpr int LDS_BYTES_UNUSED = 0;

#define LAS __attribute__((address_space(3)))
typedef unsigned short bfu;
typedef unsigned v4u __attribute__((ext_vector_type(4)));
typedef float f32x4 __attribute__((ext_vector_type(4)));
typedef short bf16x8 __attribute__((ext_vector_type(8)));
#define LDS_WAIT() asm volatile("s_waitcnt lgkmcnt(0)" ::: "memory")
typedef float f32x2_t __attribute__((ext_vector_type(2))); typedef __bf16 bf16x2_t __attribute__((ext_vector_type(2)));
__device__ __forceinline__ unsigned pk2(float lo, float hi) { f32x2_t v = {lo, hi}; bf16x2_t b = __builtin_convertvector(v, bf16x2_t); return __builtin_bit_cast(unsigned, b); }
__device__ __forceinline__ unsigned f2bf(float f) { return pk2(f, 0.f) & 0xffffu; }
__device__ __forceinline__ float bf2f(unsigned h) { return __builtin_bit_cast(float, h << 16); }
__device__ __forceinline__ float bflo(unsigned w) { return __builtin_bit_cast(float, w << 16); }
__device__ __forceinline__ float bfhi(unsigned w) { return __builtin_bit_cast(float, w & 0xffff0000u); }
__device__ __forceinline__ float sigmoidf_(float x) { return __builtin_amdgcn_rcpf(1.0f + __expf(-x)); }
__device__ __forceinline__ float gelu_erf(float x) { return 0.5f * x * (1.0f + erff(x * 0.70710678118654752f)); }
__device__ __forceinline__ void gelu2(float& a, float& b) { const pg8::f32x2 r = pg8::gelu_pk((pg8::f32x2){a, b}); a = r.x; b = r.y; }
__device__ __forceinline__ float wave_sum(float v) {
#pragma unroll
    for (int o = 1; o < 64; o <<= 1) v += __shfl_xor(v, o);
    return v;
}
__device__ __forceinline__ bf16x8 pack8f(f32x4 a, f32x4 b) { v4u w = {pk2(a[0], a[1]), pk2(a[2], a[3]), pk2(b[0], b[1]), pk2(b[2], b[3])}; return __builtin_bit_cast(bf16x8, w); }
#define MFMA16(a, b, c) __builtin_amdgcn_mfma_f32_16x16x32_bf16((a), (b), (c), 0, 0, 0)

__device__ __forceinline__ void tr_item64(const float* W, int ldw, int K, bfu* WT, int nblk, int item, LAS float* scr, int lane, bool ab_remap = false) {
    const int kb = item / nblk, nb = item - kb * nblk, k0 = 64 * kb, n0 = 64 * nb;
    int d0 = n0; if (ab_remap) { const int bj = n0 >= FFH ? 1 : 0, rem = n0 - bj * FFH; d0 = (rem >> 7) * 256 + bj * 128 + (rem & 127); }
    const int q = lane & 15, kr = lane >> 4;
    f32x4 v[16];
#pragma unroll
    for (int i = 0; i < 16; ++i) v[i] = *(const f32x4*)(W + (size_t)(k0 + 4 * i + kr) * ldw + n0 + 4 * q);
#pragma unroll
    for (int i = 0; i < 16; ++i) { LAS float* s = scr + (4 * i + kr) * 65 + 4 * q; s[0] = v[i][0]; s[1] = v[i][1]; s[2] = v[i][2]; s[3] = v[i][3]; }
    LDS_WAIT(); asm volatile("" ::: "memory");
    const int c = lane & 7;
#pragma unroll
    for (int j = 0; j < 8; ++j) { const int n = (lane >> 3) + 8 * j; const LAS float* s = scr + (8 * c) * 65 + n;
        v4u o; o.x = pk2(s[0], s[65]); o.y = pk2(s[130], s[195]); o.z = pk2(s[260], s[325]); o.w = pk2(s[390], s[455]);
        *(v4u*)(WT + (size_t)(d0 + n) * K + k0 + 8 * c) = o; }
    LDS_WAIT(); asm volatile("" ::: "memory");
}
template <bool NT = false> __device__ __forceinline__ void rms_rows(const float* X, const float* gain, bfu* O, int gw, int NGW, int lane) {
    f32x4 gv[8];
#pragma unroll
    for (int j = 0; j < 8; ++j) gv[j] = ((const f32x4*)gain)[64 * j + lane];
    for (int m = gw; m < NTOK; m += NGW) {
        const f32x4* xr = (const f32x4*)(X + (size_t)m * DMOD) + lane;
        f32x4 v[8]; float s = 0.f;
#pragma unroll
        for (int j = 0; j < 8; ++j) { v[j] = NT ? __builtin_nontemporal_load(xr + 64 * j) : xr[64 * j]; s += (v[j][0] * v[j][0] + v[j][1] * v[j][1]) + (v[j][2] * v[j][2] + v[j][3] * v[j][3]); }
        const float r = rsqrtf(wave_sum(s) * (1.0f / DMOD) + RMS_EPS);
        unsigned long long* o8 = (unsigned long long*)(O + (size_t)m * DMOD) + lane;
#pragma unroll
        for (int j = 0; j < 8; ++j) { const f32x4 y = v[j] * r * gv[j]; o8[64 * j] = (unsigned long long)pk2(y[0], y[1]) | ((unsigned long long)pk2(y[2], y[3]) << 32); }
    }
}

__device__ __forceinline__ void gmlp_tile(int tile, const bfu* Z1, const float* spw, const float* spb, const float* vgain, bfu* Y, LAS unsigned char* lds, int tid, int wave, int lane) {
    const int h = tile & 7, bc = tile >> 3; const size_t tok0 = (size_t)bc * 128;
    LAS bfu* vnT = (LAS bfu*)lds;
    { const int s = tid >> 2, part = tid & 3;
      const bfu* src = Z1 + (tok0 + s) * ABIN + 1024 + h * 128 + 32 * part;
      v4u raw[4];
#pragma unroll
      for (int i = 0; i < 4; ++i) raw[i] = ((const v4u*)src)[i];
      float g[32]; float ss = 0.f;
#pragma unroll
      for (int i = 0; i < 4; ++i)
#pragma unroll
          for (int j = 0; j < 4; ++j) { float a = bflo(raw[i][j]), b = bfhi(raw[i][j]); gelu2(a, b); g[8 * i + 2 * j] = a; g[8 * i + 2 * j + 1] = b; ss += a * a + b * b; }
      ss += __shfl_xor(ss, 1); ss += __shfl_xor(ss, 2);
      const float r = rsqrtf(ss * (1.0f / 128.0f) + RMS_EPS);
      const float* gp = vgain + h * 128 + 32 * part;
#pragma unroll
      for (int e = 0; e < 32; ++e) vnT[(32 * part + e) * 136 + s] = (bfu)f2bf(g[e] * r * gp[e]);
    }
    __syncthreads();
    const int fr = lane & 15, fq = lane >> 4, t0 = 16 * wave, trow = t0 + fr;
    f32x4 acc[8];
#pragma unroll
    for (int nb = 0; nb < 8; ++nb) acc[nb] = (f32x4){0.f, 0.f, 0.f, 0.f};
    const float* wrow = spw + (size_t)(h * 128 + trow) * 128;
    const int nks = (t0 + 15) / 32 + 1;
    for (int ks = 0; ks < nks; ++ks) {
        const int s0 = 32 * ks + 8 * fq;
        f32x4 w0 = *(const f32x4*)(wrow + s0), w1 = *(const f32x4*)(wrow + s0 + 4);
#pragma unroll
        for (int j = 0; j < 4; ++j) { if (s0 + j > trow) w0[j] = 0.f; if (s0 + 4 + j > trow) w1[j] = 0.f; }
        const bf16x8 a = pack8f(w0, w1);
#pragma unroll
        for (int nb = 0; nb < 8; ++nb) { const bf16x8 b = *(const LAS bf16x8*)(vnT + (16 * nb + fr) * 136 + 32 * ks + 8 * fq); acc[nb] = MFMA16(a, b, acc[nb]); }
    }
#pragma unroll
    for (int i = 0; i < 4; ++i) { const int t = t0 + 4 * fq + i; const float bias = spb[h * 128 + t];
        const bfu* up = Z1 + (tok0 + t) * ABIN + h * 128 + fr; bfu* yp = Y + (tok0 + t) * DMOD + h * 128 + fr;
#pragma unroll
        for (int nb = 0; nb < 8; nb += 2) { float u0 = bf2f(up[16 * nb]), u1 = bf2f(up[16 * nb + 16]); gelu2(u0, u1);
            yp[16 * nb] = (bfu)f2bf(u0 * (acc[nb][i] + bias)); yp[16 * nb + 16] = (bfu)f2bf(u1 * (acc[nb + 1][i] + bias)); } }
    __syncthreads();
}

__device__ __forceinline__ float hgrn_lb(const float* gamma, int col) {
    const float g0 = gamma[col], g1 = gamma[1024 + col], g2 = gamma[2048 + col]; const float mx = fmaxf(g0, fmaxf(g1, g2));
    const float e0 = __expf(g0 - mx), e1 = __expf(g1 - mx), e2 = __expf(g2 - mx); return e0 / (e0 + e1 + e2);
}
__device__ __forceinline__ void hgrn_local_tile(int tile, const bfu* Z1, const float* gamma, bfu* HL, float* DEC, LAS unsigned char* lds, int tid, int wave, int lane) {
    const int bh = tile >> 6, c = tile & 63, b = bh >> 3, h = bh & 7; const size_t tok0 = (size_t)b * SEQL + c * 64;
    LAS float* segsum = (LAS float*)lds; LAS bfu* keT = (LAS bfu*)(lds + 2048); LAS bfu* vT = (LAS bfu*)(lds + 2048 + 18432);
    const int seg = tid >> 7, k = tid & 127;
    const float lb = hgrn_lb(gamma, h * 128 + k);
    float fl[16], G[16]; float run = 0.f;
#pragma unroll
    for (int i = 0; i < 16; ++i) { fl[i] = bf2f(Z1[(tok0 + 16 * seg + i) * ABIN + 3072 + h * 128 + k]); run += __logf(lb + (1.0f - lb) * sigmoidf_(fl[i])); G[i] = run; }
    segsum[seg * 128 + k] = run;
    unsigned vw[8];
#pragma unroll
    for (int i = 0; i < 8; ++i) vw[i] = (unsigned)Z1[(tok0 + 16 * seg + 2 * i) * ABIN + 4096 + h * 128 + k] | ((unsigned)Z1[(tok0 + 16 * seg + 2 * i + 1) * ABIN + 4096 + h * 128 + k] << 16);
    *(LAS v4u*)(vT + k * 72 + 16 * seg) = (v4u){vw[0], vw[1], vw[2], vw[3]}; *(LAS v4u*)(vT + k * 72 + 16 * seg + 8) = (v4u){vw[4], vw[5], vw[6], vw[7]};
    __syncthreads();
    float pre = 0.f, tot = 0.f;
#pragma unroll
    for (int s = 0; s < 4; ++s) { const float v = segsum[s * 128 + k]; if (s < seg) pre += v; tot += v; }
    unsigned kw[8];
#pragma unroll
    for (int i = 0; i < 8; ++i) { const float k0 = (1.0f - lb) * sigmoidf_(-fl[2 * i]) * __expf(tot - (pre + G[2 * i])), k1 = (1.0f - lb) * sigmoidf_(-fl[2 * i + 1]) * __expf(tot - (pre + G[2 * i + 1])); kw[i] = pk2(k0, k1); }
    *(LAS v4u*)(keT + k * 72 + 16 * seg) = (v4u){kw[0], kw[1], kw[2], kw[3]}; *(LAS v4u*)(keT + k * 72 + 16 * seg + 8) = (v4u){kw[4], kw[5], kw[6], kw[7]};
    if (seg == 3) DEC[(size_t)(bh * 64 + c) * 128 + k] = __expf(tot);
    __syncthreads();
    const int fr = lane & 15, fq = lane >> 4;
    f32x4 acc[8];
#pragma unroll
    for (int nb = 0; nb < 8; ++nb) acc[nb] = (f32x4){0.f, 0.f, 0.f, 0.f};
#pragma unroll
    for (int ks = 0; ks < 2; ++ks) { const bf16x8 a = *(const LAS bf16x8*)(vT + (16 * wave + fr) * 72 + 32 * ks + 8 * fq);
#pragma unroll
        for (int nb = 0; nb < 8; ++nb) { const bf16x8 bb = *(const LAS bf16x8*)(keT + (16 * nb + fr) * 72 + 32 * ks + 8 * fq); acc[nb] = MFMA16(a, bb, acc[nb]); } }
    LAS bfu* Lt = (LAS bfu*)(lds + 40960);
#pragma unroll
    for (int i = 0; i < 4; ++i)
#pragma unroll
        for (int nb = 0; nb < 8; ++nb) Lt[(16 * wave + 4 * fq + i) * 136 + 16 * nb + fr] = (bfu)f2bf(acc[nb][i]);
    __syncthreads();
    bfu* Lp = HL + (size_t)(bh * 64 + c) * 16384;
#pragma unroll
    for (int j = 0; j < 4; ++j) { const int idx = tid + 512 * j, row = idx >> 4, ch = idx & 15; *(v4u*)(Lp + row * 128 + ch * 8) = *(const LAS v4u*)(Lt + row * 136 + ch * 8); }
    __syncthreads();
}
__device__ __forceinline__ void hgrn_out_tile(int tile, const bfu* Z1, const float* gamma, const float* ogain, const bfu* HL, bfu* Y, LAS unsigned char* lds, int tid, int wave, int lane) {
    const int bh = tile >> 6, c = tile & 63, b = bh >> 3, h = bh & 7; const size_t tok0 = (size_t)b * SEQL + c * 64;
    LAS float* segsum = (LAS float*)lds; LAS float* ssq = (LAS float*)(lds + 2048);
    LAS bfu* qd = (LAS bfu*)(lds + 4096); LAS bfu* kd = qd + 64 * 136; LAS bfu* vT = kd + 64 * 136; LAS bfu* Pm = vT + 128 * 72;
    const int seg = tid >> 7, k = tid & 127;
    const int fr = lane & 15, fq = lane >> 4, tb = wave >> 1, wh = wave & 1;
    const float lb = hgrn_lb(gamma, h * 128 + k);
    unsigned flraw[16], qraw[16], vraw[16], graw[4][4];
#pragma unroll
    for (int i = 0; i < 16; ++i) { const bfu* rp = Z1 + (tok0 + 16 * seg + i) * ABIN + h * 128 + k; flraw[i] = rp[3072]; vraw[i] = rp[4096]; qraw[i] = rp[2048]; }
#pragma unroll
    for (int i = 0; i < 4; ++i)
#pragma unroll
        for (int j = 0; j < 4; ++j) graw[i][j] = Z1[(tok0 + 16 * tb + 4 * fq + i) * ABIN + 5120 + h * 128 + 16 * (4 * wh + j) + fr];
    float fl[16], G[16]; float run = 0.f;
#pragma unroll
    for (int i = 0; i < 16; ++i) { fl[i] = bf2f(flraw[i]); run += __logf(lb + (1.0f - lb) * sigmoidf_(fl[i])); G[i] = run; }
    segsum[seg * 128 + k] = run;
    unsigned vw[8];
#pragma unroll
    for (int i = 0; i < 8; ++i) vw[i] = vraw[2 * i] | (vraw[2 * i + 1] << 16);
    *(LAS v4u*)(vT + k * 72 + 16 * seg) = (v4u){vw[0], vw[1], vw[2], vw[3]}; *(LAS v4u*)(vT + k * 72 + 16 * seg + 8) = (v4u){vw[4], vw[5], vw[6], vw[7]};
    __syncthreads();
    float pre = 0.f;
#pragma unroll
    for (int s = 0; s < 3; ++s) { const float v = segsum[s * 128 + k]; if (s < seg) pre += v; }
#pragma unroll
    for (int i = 0; i < 16; ++i) { const int t = 16 * seg + i; const float Gt = pre + G[i]; const float qv = bf2f(qraw[i]);
        qd[t * 136 + k] = (bfu)f2bf(qv * __expf(Gt)); kd[t * 136 + k] = (bfu)f2bf((1.0f - lb) * sigmoidf_(-fl[i]) * __expf(-Gt)); }
    const bfu* Sg = HL + (size_t)(bh * 64 + c) * 16384;
    bf16x8 sfr[4][4];
#pragma unroll
    for (int ks = 0; ks < 4; ++ks)
#pragma unroll
        for (int j = 0; j < 4; ++j) sfr[ks][j] = *(const bf16x8*)(Sg + (16 * (4 * wh + j) + fr) * 128 + 32 * ks + 8 * fq);
    __syncthreads();
#pragma unroll
    for (int jj = 0; jj < 2; ++jj) { const int sb = 2 * wh + jj; f32x4 sc = (f32x4){0.f, 0.f, 0.f, 0.f};
        if (sb <= tb) {
#pragma unroll
            for (int ks = 0; ks < 4; ++ks) { const bf16x8 a = *(const LAS bf16x8*)(qd + (16 * tb + fr) * 136 + 32 * ks + 8 * fq), bb = *(const LAS bf16x8*)(kd + (16 * sb + fr) * 136 + 32 * ks + 8 * fq); sc = MFMA16(a, bb, sc); } }
#pragma unroll
        for (int i = 0; i < 4; ++i) { const int t = 16 * tb + 4 * fq + i, s = 16 * sb + fr; Pm[t * 72 + s] = (bfu)f2bf(s <= t ? sc[i] : 0.f); } }
    __syncthreads();
    f32x4 acc[4];
#pragma unroll
    for (int j = 0; j < 4; ++j) acc[j] = (f32x4){0.f, 0.f, 0.f, 0.f};
#pragma unroll
    for (int ks = 0; ks < 2; ++ks) { const bf16x8 a = *(const LAS bf16x8*)(Pm + (16 * tb + fr) * 72 + 32 * ks + 8 * fq);
#pragma unroll
        for (int j = 0; j < 4; ++j) { const bf16x8 bb = *(const LAS bf16x8*)(vT + (16 * (4 * wh + j) + fr) * 72 + 32 * ks + 8 * fq); acc[j] = MFMA16(a, bb, acc[j]); } }
#pragma unroll
    for (int ks = 0; ks < 4; ++ks) { const bf16x8 a = *(const LAS bf16x8*)(qd + (16 * tb + fr) * 136 + 32 * ks + 8 * fq);
#pragma unroll
        for (int j = 0; j < 4; ++j) acc[j] = MFMA16(a, sfr[ks][j], acc[j]); }
#pragma unroll
    for (int i = 0; i < 4; ++i) { float pp = (acc[0][i] * acc[0][i] + acc[1][i] * acc[1][i]) + (acc[2][i] * acc[2][i] + acc[3][i] * acc[3][i]);
        pp += __shfl_xor(pp, 1); pp += __shfl_xor(pp, 2); pp += __shfl_xor(pp, 4); pp += __shfl_xor(pp, 8);
        if (fr == 0) ssq[wave * 16 + 4 * fq + i] = pp; }
    __syncthreads();
#pragma unroll
    for (int i = 0; i < 4; ++i) { const int t = 16 * tb + 4 * fq + i; const float r = rsqrtf((ssq[wave * 16 + 4 * fq + i] + ssq[(wave ^ 1) * 16 + 4 * fq + i]) * (1.0f / 128.0f) + RMS_EPS);
#pragma unroll
        for (int j = 0; j < 4; ++j) { const int v = 16 * (4 * wh + j) + fr; const float gt = bf2f(graw[i][j]);
            Y[(tok0 + t) * DMOD + 1024 + h * 128 + v] = (bfu)f2bf(acc[j][i] * r * ogain[v] * gt * sigmoidf_(gt)); } }
    __syncthreads();
}


#ifndef EN_ATTN
#define EN_ATTN 1
#endif
#ifndef EN_MIXAB
#define EN_MIXAB 1
#endif
#ifndef EN_GEMM
#define EN_GEMM 1
#endif
#define XB_TMO      128
#define XB_XCNT(j)  (256  + 64 * (j))
#define XB_XSUB(j)  (1280 + 64 * (j))
#define XB_XGEN(j)  (2304 + 64 * (j))
#define XB_TOP      3328
#define XB_TOPGEN   3392
#define XCD_BAR_WORDS 3456
#define XB_SPIN_CAP (1u << 18)

__device__ __forceinline__ unsigned xb_ld(unsigned* p)              { return __hip_atomic_load(p, __ATOMIC_RELAXED, __HIP_MEMORY_SCOPE_AGENT); }
__device__ __forceinline__ unsigned xb_add(unsigned* p, unsigned v) { return __hip_atomic_fetch_add(p, v, __ATOMIC_RELAXED, __HIP_MEMORY_SCOPE_AGENT); }
__device__ __forceinline__ unsigned xb_xcc_id() { return (unsigned)__builtin_amdgcn_s_getreg((3 << 11) | 20) & 0xFu; }
#define XB_SPIN(cond, bar) do { unsigned _sp = 0; while (cond) { __builtin_amdgcn_s_sleep(1); \
    if ((++_sp & 255u) == 0u) { if (xb_ld(&(bar)[XB_TMO])) break; if (_sp > XB_SPIN_CAP) { atomicAdd(&(bar)[XB_TMO], 1u); break; } } } } while (0)

struct XcdBarrier {
    unsigned* bar; unsigned x;
    volatile LAS unsigned* st;
};

__device__ __forceinline__ XcdBarrier xcd_barrier_post(unsigned* bar, volatile LAS unsigned* st) {
    XcdBarrier b; b.bar = bar; b.x = xb_xcc_id(); b.st = st;
    if (threadIdx.x == 0) (void)xb_add(&bar[XB_XCNT(b.x)], 1u);
    return b;
}
__device__ __forceinline__ void xcd_barrier_complete(unsigned* bar, unsigned x, unsigned& nloc, unsigned& nx) {
    const unsigned G = gridDim.x * gridDim.y * gridDim.z;
    unsigned sum, cnt, mine, sp = 0u;
    for (;;) {
        sum = 0u; cnt = 0u; mine = 0u;
#pragma unroll
        for (unsigned j = 0; j < 16; ++j) { const unsigned c = xb_ld(&bar[XB_XCNT(j)]); sum += c; cnt += (c > 0u) ? 1u : 0u; mine = (j == x) ? c : mine; }
        if (sum == G) break;
        __builtin_amdgcn_s_sleep(1);
        if ((++sp & 255u) == 0u) { if (xb_ld(&bar[XB_TMO])) break; if (sp > XB_SPIN_CAP) { atomicAdd(&bar[XB_TMO], 1u); break; } }
    }
    nloc = mine > 0u ? mine : 1u; nx = cnt > 0u ? cnt : 1u;
}

__device__ __forceinline__ void xcd_barrier(const XcdBarrier& b) {
    asm volatile("s_waitcnt vmcnt(0)" ::: "memory");
    __syncthreads();
    if (threadIdx.x == 0) {
        unsigned* bar = b.bar;
        __builtin_amdgcn_s_waitcnt(0);
        unsigned nloc = b.st[0], nx = b.st[1];
        if (nloc == 0u) { xcd_barrier_complete(bar, b.x, nloc, nx); b.st[0] = nloc; b.st[1] = nx; }
        const unsigned old = xb_add(&bar[XB_XSUB(b.x)], 1u);
        const unsigned gen = old / nloc;
        if (old + 1u == (gen + 1u) * nloc) {
            __builtin_amdgcn_fence(__ATOMIC_RELEASE, "agent");
            asm volatile("s_waitcnt vmcnt(0)" ::: "memory");
            const unsigned og = xb_add(&bar[XB_TOP], 1u);
            const unsigned tg = og / nx;
            if (og + 1u == (tg + 1u) * nx) xb_add(&bar[XB_TOPGEN], 1u);
            else XB_SPIN(xb_ld(&bar[XB_TOPGEN]) == tg, bar);
            __builtin_amdgcn_fence(__ATOMIC_ACQUIRE, "agent");
            xb_add(&bar[XB_XGEN(b.x)], 1u);
            asm volatile("s_waitcnt vmcnt(0)" ::: "memory");
        } else {
            XB_SPIN(xb_ld(&bar[XB_XGEN(b.x)]) == gen, bar);
            __builtin_amdgcn_fence(__ATOMIC_ACQUIRE, "agent");
            asm volatile("s_waitcnt vmcnt(0)" ::: "memory");
        }
    }
    __syncthreads();
}

struct Params { const float* in[19]; float* out; unsigned char* ws; };
#define ARG(p_, i_) ([&]() -> const float* { int k_ = (i_); asm volatile("" : "+s"(k_)); return (p_).in[k_]; }())
#define PHASE_IDS() int tid = threadIdx.x; asm volatile("" : "+v"(tid)); const int lane = tid & 63, wave = __builtin_amdgcn_readfirstlane(tid >> 6); \
    const int G = gridDim.x, gw = blockIdx.x * 8 + wave, NGW = G * 8; const long gtid = (long)blockIdx.x * 512 + tid, NGT = (long)G * 512; (void)lane; (void)gw; (void)NGW; (void)gtid; (void)NGT

template <class Epi> __device__ __forceinline__ void run_gemm(LAS unsigned char* lds, const bfu* A, const bfu* Bt, int M, int N, int K, const Epi& E) {
#if EN_GEMM
    pg8::Gemm g{A, Bt, M, N, K}; pg8::StaticOrder S; S.init(M, N, (int)gridDim.x, (int)blockIdx.x);
    pg8::gemm_phase<Epi, pg8::StaticOrder, true, true>(lds, g, S, E);
#endif
}

struct TrDesc { const float* src; bfu* dst; int ldw, K; };
__device__ __forceinline__ TrDesc tr_decode(const Params& p, int item) {
    constexpr int I0 = 96 * 32, I1 = 32 * 32, I2 = 128 * 32, I3 = 32 * 32, I4 = 176 * 32, I5 = 32 * 88;
    unsigned char* ws = p.ws; const float* W; bfu* WT; int ldw, K, nblk; bool remap = false; int r = item;
    if (r < I0) { W = ARG(p, 2); WT = (bfu*)(ws + WS_WABIN); ldw = ABIN; K = DMOD; nblk = 96; }
    else if ((r -= I0) < I1) { W = ARG(p, 8); WT = (bfu*)(ws + WS_WABOUT); ldw = DMOD; K = DMOD; nblk = 32; }
    else if ((r -= I1) < I2) { W = ARG(p, 9); WT = (bfu*)(ws + WS_WCIN); ldw = CINW; K = DMOD; nblk = 128; }
    else if ((r -= I2) < I3) { W = ARG(p, 13); WT = (bfu*)(ws + WS_WCOUT); ldw = DMOD; K = DMOD; nblk = 32; }
    else if ((r -= I3) < I4) { W = ARG(p, 15); WT = (bfu*)(ws + WS_WUP0); ldw = FF2; K = DMOD; nblk = 176; remap = true; }
    else if ((r -= I4) < I4) { W = ARG(p, 15) + (size_t)DMOD * FF2; WT = (bfu*)(ws + WS_WUP1); ldw = FF2; K = DMOD; nblk = 176; remap = true; }
    else if ((r -= I4) < I5) { W = ARG(p, 18); WT = (bfu*)(ws + WS_WDN0); ldw = DMOD; K = FFH; nblk = 32; }
    else { r -= I5; W = ARG(p, 18) + (size_t)FFH * DMOD; WT = (bfu*)(ws + WS_WDN1); ldw = DMOD; K = FFH; nblk = 32; }
    const int kb = r / nblk, nb = r - kb * nblk, k0 = 64 * kb, n0 = 64 * nb;
    int d0 = n0; if (remap) { const int bj = n0 >= FFH ? 1 : 0, rem = n0 - bj * FFH; d0 = (rem >> 7) * 256 + bj * 128 + (rem & 127); }
    TrDesc d; d.src = W + (size_t)k0 * ldw + n0; d.dst = WT + (size_t)d0 * K + k0; d.ldw = ldw; d.K = K; return d;
}
__device__ __forceinline__ void tr_load(const TrDesc& d, f32x4 (&v)[16], int lane) {
    const float* s = d.src + (size_t)(lane >> 4) * d.ldw + 4 * (lane & 15);
#pragma unroll
    for (int i = 0; i < 16; ++i) v[i] = __builtin_nontemporal_load((const f32x4*)(s + (size_t)(4 * i) * d.ldw));
}
__device__ __forceinline__ void tr_finish(const TrDesc& d, const f32x4 (&v)[16], LAS float* scr, int lane) {
    const int q = lane & 15, kr = lane >> 4;
#pragma unroll
    for (int i = 0; i < 16; ++i) { LAS float* s = scr + (4 * i + kr) * 65 + 4 * q; s[0] = v[i][0]; s[1] = v[i][1]; s[2] = v[i][2]; s[3] = v[i][3]; }
    LDS_WAIT(); asm volatile("" ::: "memory");
    const int c = lane & 7;
#pragma unroll
    for (int j = 0; j < 8; ++j) { const int n = (lane >> 3) + 8 * j; const LAS float* s = scr + (8 * c) * 65 + n;
        v4u o; o.x = pk2(s[0], s[65]); o.y = pk2(s[130], s[195]); o.z = pk2(s[260], s[325]); o.w = pk2(s[390], s[455]);
        *(v4u*)(d.dst + (size_t)n * d.K + 8 * c) = o; }
    LDS_WAIT(); asm volatile("" ::: "memory");
}
__device__ __forceinline__ void p0_phase(const Params& p, LAS unsigned char* lds) {
    PHASE_IDS(); unsigned char* ws = p.ws;
    bfu* Wcin = (bfu*)(ws + WS_WCIN);
    LAS float* scr = (LAS float*)(lds + wave * 16640);
    constexpr int NIT = 96 * 32 + 32 * 32 + 128 * 32 + 32 * 32 + 2 * 176 * 32 + 2 * 32 * 88;
    f32x4 va[16], vb[16]; TrDesc da, db; int it = gw;
    if (it < NIT) { da = tr_decode(p, it); tr_load(da, va, lane); }
    for (; it < NIT; it += 2 * NGW) {
        const int it1 = it + NGW, it2 = it + 2 * NGW;
        if (it1 < NIT) { db = tr_decode(p, it1); tr_load(db, vb, lane); }
        tr_finish(da, va, scr, lane);
        if (it2 < NIT) { da = tr_decode(p, it2); tr_load(da, va, lane); }
        if (it1 < NIT) tr_finish(db, vb, scr, lane);
    }
    for (long i = gtid; i < 16 * DMOD; i += NGT) { const int j = (int)(i / DMOD), kk = (int)(i % DMOD); Wcin[(size_t)(8192 + j) * DMOD + kk] = (bfu)f2bf(ARG(p, 9)[(size_t)kk * CINW + 8192 + j]); }
    rms_rows<true>(ARG(p, 0), ARG(p, 1), (bfu*)(ws + WS_ACT), gw, NGW, lane);
}
__device__ __forceinline__ void norm_phase(const float* X, const float* gain, bfu* O) { PHASE_IDS(); rms_rows<true>(X, gain, O, gw, NGW, lane); }

__device__ __forceinline__ void mixab_phase1(const Params& p, LAS unsigned char* lds) {
#if EN_MIXAB
    PHASE_IDS(); unsigned char* ws = p.ws; const bfu* Z1 = (const bfu*)(ws + WS_Z1);
    for (int t = blockIdx.x; t < 1024 + 2048; t += G) {
        if (t < 1024) gmlp_tile(t, Z1, ARG(p, 3), ARG(p, 4), ARG(p, 5), (bfu*)(ws + WS_ACT), lds, tid, wave, lane);
        else hgrn_local_tile(t - 1024, Z1, ARG(p, 6), (bfu*)(ws + WS_HL), (float*)(ws + WS_DEC), lds, tid, wave, lane);
    }
#endif
}
__device__ __forceinline__ void hgrn_scan_phase(const Params& p) {
    PHASE_IDS(); bfu* HL = (bfu*)(p.ws + WS_HL); const float* DEC = (const float*)(p.ws + WS_DEC);
    typedef unsigned u32x2 __attribute__((ext_vector_type(2)));
    for (long e = gtid; e < 32L * 128 * 32; e += NGT) {
        const int bh = (int)(e >> 12), vq = (int)(e & 4095);
        bfu* base = HL + (size_t)bh * 64 * 16384 + (size_t)vq * 4; const float* db = DEC + (size_t)bh * 64 * 128 + (vq & 31) * 4;
        f32x4 s = (f32x4){0.f, 0.f, 0.f, 0.f};
        for (int c0 = 0; c0 < 64; c0 += 16) {
            u32x2 Lc[16]; f32x4 dc[16];
#pragma unroll
            for (int u = 0; u < 16; ++u) { Lc[u] = *(const u32x2*)(base + (size_t)(c0 + u) * 16384); dc[u] = *(const f32x4*)(db + (c0 + u) * 128); }
#pragma unroll
            for (int u = 0; u < 16; ++u) { *(u32x2*)(base + (size_t)(c0 + u) * 16384) = (u32x2){pk2(s[0], s[1]), pk2(s[2], s[3])};
                s = dc[u] * s + (f32x4){bflo(Lc[u][0]), bfhi(Lc[u][0]), bflo(Lc[u][1]), bfhi(Lc[u][1])}; }
        }
    }
}
__device__ __forceinline__ void mixab_phase3(const Params& p, LAS unsigned char* lds) {
#if EN_MIXAB
    PHASE_IDS(); unsigned char* ws = p.ws;
    for (int t = blockIdx.x; t < 2048; t += G) hgrn_out_tile(t, (const bfu*)(ws + WS_Z1), ARG(p, 6), ARG(p, 7), (const bfu*)(ws + WS_HL), (bfu*)(ws + WS_ACT), lds, tid, wave, lane);
#endif
}
__device__ __forceinline__ void fgate_phase(const Params& p) {
    PHASE_IDS(); const bfu* A = (const bfu*)(p.ws + WS_ACT); const bfu* Bw = (const bfu*)(p.ws + WS_WCIN) + (size_t)8192 * DMOD; float* Fb = (float*)(p.ws + WS_F);
    const int fr = lane & 15, fq = lane >> 4;
    for (int it = gw; it < 2 * (NTOK / 16); it += NGW) {
        const int rb = it >> 1, kh = it & 1;
        const bfu* ap = A + (size_t)(16 * rb + fr) * DMOD + 8 * fq + 1024 * kh; const bfu* bp = Bw + (size_t)fr * DMOD + 8 * fq + 1024 * kh;
        f32x4 acc0 = (f32x4){0.f, 0.f, 0.f, 0.f}, acc1 = acc0;
#pragma unroll 8
        for (int ks = 0; ks < 32; ks += 2) {
            const bf16x8 a0 = *(const bf16x8*)(ap + 32 * ks), b0 = *(const bf16x8*)(bp + 32 * ks), a1 = *(const bf16x8*)(ap + 32 * ks + 32), b1 = *(const bf16x8*)(bp + 32 * ks + 32);
            acc0 = MFMA16(a0, b0, acc0); acc1 = MFMA16(a1, b1, acc1); }
#pragma unroll
        for (int i = 0; i < 4; ++i) Fb[(size_t)kh * NTOK * 16 + (size_t)(16 * rb + 4 * fq + i) * 16 + fr] = acc0[i] + acc1[i];
    }
}
__device__ __forceinline__ void qknorm_phase(const Params& p) {
    PHASE_IDS(); const float* Fb = (const float*)(p.ws + WS_F); float* Cb = (float*)(p.ws + WS_C);
    if (gw < 64) {
        const int bh = gw, b = bh >> 4, h = bh & 15; const float bf_ = ARG(p, 10)[h];
        const float* fp = Fb + ((size_t)b * SEQL + 64 * lane) * 16 + h;
        float tot = 0.f;
        for (int i = 0; i < 64; ++i) { const float z = fp[i * 16] + fp[(size_t)NTOK * 16 + i * 16] + bf_; tot += fminf(z, 0.f) - log1pf(__expf(-fabsf(z))); }
        float inc = tot;
#pragma unroll
        for (int o = 1; o < 64; o <<= 1) { const float u = __shfl_up(inc, o); if (lane >= o) inc += u; }
        float run = inc - tot;
        float* cp = Cb + (size_t)bh * SEQL + 64 * lane;
        for (int i = 0; i < 64; ++i) { const float z = fp[i * 16] + fp[(size_t)NTOK * 16 + i * 16] + bf_; run += fminf(z, 0.f) - log1pf(__expf(-fabsf(z))); cp[i] = run; }
    }
}
__device__ __forceinline__ void attn_phase(const Params& p, char* ldsg) {
#if EN_ATTN
    using bfh = __hip_bfloat16; typedef fox::BlockRef<bfh, bfh> BR;
    const bfh* Qb = (const bfh*)(p.ws + WS_QKVG); bfh* Yb = (bfh*)(p.ws + WS_ACT); const float* Cb = (const float*)(p.ws + WS_C);
    const int total = 512, stride = gridDim.x;
    float margin;
    { const float* qg = ARG(p, 11); const float* kg = ARG(p, 12); float a = 0.f, b = 0.f;
#pragma unroll 8
      for (int i = 0; i < 128; ++i) { a = fmaxf(a, fabsf(qg[i])); b = fmaxf(b, fabsf(kg[i])); }
      margin = 110.0f + 2.0f * 1.01f * 128.0f * a * b * fox::SCALE;
      margin = __builtin_bit_cast(float, __builtin_amdgcn_readfirstlane(__builtin_bit_cast(int, margin))); }
#define FOX_ID(L_, pass_) const int bh_ = ((L_) & 7) + 8 * ((L_) >> 6), x_ = ((L_) >> 3) & 7, qb_ = (pass_) ? 15 - x_ : x_, b_ = bh_ >> 4, h_ = bh_ & 15
#define FOX_REF(r, L_, pass_, sk_) do { FOX_ID(L_, pass_); \
        const size_t SEC_ = (size_t)NTOK * 2048, hb_ = (size_t)bh_ * SEQL * 128, rq_ = hb_ + (size_t)qb_ * 256 * 128; \
        (r).Q = Qb + rq_; (r).K = Qb + SEC_ + hb_ + (size_t)(sk_) * 128; (r).V = Qb + 2 * SEC_ + hb_ + (size_t)(sk_) * 128; (r).Gt = Qb + 3 * SEC_ + rq_; \
        (r).O = Yb + ((size_t)b_ * SEQL + (size_t)qb_ * 256) * 2048 + h_ * 128; (r).P0 = qb_ * 256 - (sk_); (r).cb = Cb + (size_t)bh_ * SEQL + (sk_); } while (0)
    int sk00 = 0, sk01 = 0, sk10 = 0, sk11 = 0;
#define FOX_SKIP(dst, L_, pass_) do { FOX_ID(L_, pass_); (void)b_; (void)h_; dst = fox::fox_jlo(Cb + (size_t)bh_ * SEQL, qb_ * 256, margin) * 64; } while (0)
    { const int L0 = blockIdx.x, L1 = blockIdx.x + stride;
      if (L0 < total) { FOX_SKIP(sk00, L0, 0); FOX_SKIP(sk01, L0, 1); }
      if (L1 < total) { FOX_SKIP(sk10, L1, 0); FOX_SKIP(sk11, L1, 1); } }
#define FOX_SK(L_, pass_) ((L_) == (int)blockIdx.x ? ((pass_) ? sk01 : sk00) : (L_) == (int)blockIdx.x + stride ? ((pass_) ? sk11 : sk10) : 0)
    int L = blockIdx.x;
    if (L < total) {
        int pass = 0; BR cur; FOX_REF(cur, L, 0, FOX_SK(L, 0));
        fox::Seam<bfh> S;
        fox::causal_swa_prime<bfh, bfh>(cur, SEQL, ldsg, S);
        for (;;) {
            const bool more_pass = pass == 0, more_item = L + stride < total, last = !more_pass && !more_item;
            int passn = pass + 1, Ln = L;
            if (!more_pass) { passn = 0; Ln = more_item ? L + stride : L; }
            BR nxt = cur; if (!last) FOX_REF(nxt, Ln, passn, FOX_SK(Ln, passn));
            fox::causal_swa_block<bfh, bfh>(cur, nxt, SEQL, SEQL, ldsg, S);
            if (last) break;
            cur = nxt; pass = passn; L = Ln;
        }
#undef FOX_SK
#undef FOX_SKIP
#undef FOX_ID
#undef FOX_REF
    }
#endif
}
__device__ __forceinline__ void conv_fix_phase(const float* HALO, const float* cw, const float* cbv, bfu* GA) {
    PHASE_IDS();
    for (long e = gtid; e < 256L * 2 * 1408; e += NGT) {
        const int cq = (int)(e % 1408), gr = (int)(e / 1408), r = gr & 1, g = gr >> 1;
        const int c = cq * 4, cp = (c >> 7) * 256 + (c & 127);
        const bool first = (g & 63) == 0;
        const float* H = HALO + (size_t)g * 4 * FF2 + cp; const float* Hp = first ? H : H - 4 * FF2;
        const f32x4 zero = (f32x4){0.f, 0.f, 0.f, 0.f};
        const f32x4 za = *(const f32x4*)(H + r * FF2), zb = *(const f32x4*)(H + r * FF2 + 128);
        f32x4 za1, zb1, za2, zb2;
        if (r == 0) { za1 = *(const f32x4*)(Hp + 3 * FF2); zb1 = *(const f32x4*)(Hp + 3 * FF2 + 128); za2 = *(const f32x4*)(Hp + 2 * FF2); zb2 = *(const f32x4*)(Hp + 2 * FF2 + 128); if (first) { za1 = zero; zb1 = zero; za2 = zero; zb2 = zero; } }
        else { za1 = *(const f32x4*)(H); zb1 = *(const f32x4*)(H + 128); za2 = *(const f32x4*)(Hp + 3 * FF2); zb2 = *(const f32x4*)(Hp + 3 * FF2 + 128); if (first) { za2 = zero; zb2 = zero; } }
        const f32x4 a = *(const f32x4*)(cbv + c) + *(const f32x4*)(cw + c) * za2 + *(const f32x4*)(cw + FF2 + c) * za1 + *(const f32x4*)(cw + 2 * FF2 + c) * za;
        const f32x4 b = *(const f32x4*)(cbv + FFH + c) + *(const f32x4*)(cw + FFH + c) * zb2 + *(const f32x4*)(cw + FF2 + FFH + c) * zb1 + *(const f32x4*)(cw + 2 * FF2 + FFH + c) * zb;
        float gv[4];
#pragma unroll
        for (int i = 0; i < 4; ++i) gv[i] = a[i] * sigmoidf_(a[i]) * b[i];
        *(unsigned long long*)(GA + ((size_t)g * 64 + r) * FFH + c) = (unsigned long long)pk2(gv[0], gv[1]) | ((unsigned long long)pk2(gv[2], gv[3]) << 32);
    }
}
#define GSYNC() xcd_barrier(xbar)
template <int LAYER> __device__ __forceinline__ void ffn_block(const Params& p, LAS unsigned char* lds, const XcdBarrier& xbar) {
    unsigned char* ws = p.ws; bfu* ACT = (bfu*)(ws + WS_ACT); bfu* GA = (bfu*)(ws + WS_GA); float* HALO = (float*)(ws + WS_HALO);
    const bfu* Wup = (const bfu*)(ws + (LAYER ? WS_WUP1 : WS_WUP0)); const bfu* Wdn = (const bfu*)(ws + (LAYER ? WS_WDN1 : WS_WDN0));
    const float* cw = ARG(p, 16) + (size_t)LAYER * 3 * FF2; const float* cbv = ARG(p, 17) + (size_t)LAYER * FF2;
    norm_phase(p.out, ARG(p, 14) + (size_t)LAYER * DMOD, ACT);
    GSYNC();
    { pg8::EpiConvGate E{GA, HALO, cw, cbv}; run_gemm(lds, ACT, Wup, NTOK, FF2, DMOD, E); }
    GSYNC();
    conv_fix_phase(HALO, cw, cbv, GA);
    GSYNC();
    { pg8::EpiResF32 E{p.out, p.out, DMOD}; run_gemm(lds, GA, Wdn, NTOK, DMOD, FFH, E); }
}

__global__ void __launch_bounds__(512, 2) fwd_mega(Params p) {
    extern __shared__ __attribute__((aligned(16))) unsigned char lds_raw[];
    LAS unsigned char* lds = (LAS unsigned char*)lds_raw;
    unsigned char* ws = p.ws; bfu* ACT = (bfu*)(ws + WS_ACT);
    unsigned* barw = (unsigned*)(ws + WS_BAR);
    if (blockIdx.x == 0) for (int i = threadIdx.x; i < 4096; i += 512) barw[i] = 0u;
    if (threadIdx.x < 32) ((LAS unsigned*)(lds + LDS_MISC))[threadIdx.x] = 0u;
    cg::this_grid().sync();
    const XcdBarrier xbar = xcd_barrier_post(barw, (volatile LAS unsigned*)(lds + LDS_MISC));
    p0_phase(p, lds);
    GSYNC();
    { pg8::EpiBf16<0> E{(bfu*)(ws + WS_Z1), ABIN, nullptr, 0, 0, 1.f}; run_gemm(lds, ACT, (const bfu*)(ws + WS_WABIN), NTOK, ABIN, DMOD, E); }
    GSYNC();
    mixab_phase1(p, lds);
    GSYNC();
    hgrn_scan_phase(p);
    GSYNC();
    mixab_phase3(p, lds);
    GSYNC();
    { pg8::EpiResF32 E{ARG(p, 0), p.out, DMOD}; run_gemm(lds, ACT, (const bfu*)(ws + WS_WABOUT), NTOK, DMOD, DMOD, E); }
    GSYNC();
    ffn_block<0>(p, lds, xbar);
    GSYNC();
    norm_phase(p.out, ARG(p, 1) + DMOD, ACT);
    GSYNC();
    { pg8::EpiCin E{(bfu*)(ws + WS_QKVG), ARG(p, 11), ARG(p, 12), (LAS float*)(lds + 131072)}; run_gemm(lds, ACT, (const bfu*)(ws + WS_WCIN), NTOK, 8192, DMOD, E); }
    fgate_phase(p);
    GSYNC();
    qknorm_phase(p);
    GSYNC();
    attn_phase(p, (char*)lds_raw);
    GSYNC();
    { pg8::EpiResF32 E{p.out, p.out, DMOD}; run_gemm(lds, ACT, (const bfu*)(ws + WS_WCOUT), NTOK, DMOD, DMOD, E); }
    GSYNC();
    ffn_block<1>(p, lds, xbar);
}

extern "C" void kernel_launch(void* const* d_in, const int* in_sizes, int n_in, void* d_out, int out_size, void* d_ws, size_t ws_size, hipStream_t stream) {
    static int grid = 0;
    if (grid == 0) {
        if (n_in != 19 || in_sizes[0] != NTOK * DMOD || out_size != NTOK * DMOD || ws_size < WS_TOTAL) {
            fprintf(stderr, "kernel_launch: shape/workspace mismatch (n_in %d, in0 %d, out %d, ws %zu, need %zu)\n", n_in, n_in > 0 ? in_sizes[0] : -1, out_size, ws_size, (size_t)WS_TOTAL); grid = -1; return; }
        int dev = 0, cus = 0, per_cu = 0;
        (void)hipGetDevice(&dev); (void)hipDeviceGetAttribute(&cus, hipDeviceAttributeMultiprocessorCount, dev);
        if (hipFuncSetAttribute((const void*)fwd_mega, hipFuncAttributeMaxDynamicSharedMemorySize, LDS_BYTES) != hipSuccess) { fprintf(stderr, "kernel_launch: hipFuncSetAttribute failed\n"); grid = -1; return; }
        if (hipOccupancyMaxActiveBlocksPerMultiprocessor(&per_cu, (const void*)fwd_mega, 512, LDS_BYTES) != hipSuccess || per_cu < 1) { fprintf(stderr, "kernel_launch: occupancy query says %d\n", per_cu); per_cu = 1; }
        (void)hipGetLastError();
        grid = cus > 0 ? cus : 256;
    }
    if (grid < 0) return;
    Params prm{};
    for (int i = 0; i < 19; ++i) prm.in[i] = (const float*)d_in[i];
    prm.out = (float*)d_out; prm.ws = (unsigned char*)d_ws;
    void* args[] = {&prm};
    hipError_t e = hipLaunchCooperativeKernel((const void*)fwd_mega, dim3(grid), dim3(512), args, LDS_BYTES, stream);
    if (e != hipSuccess) fprintf(stderr, "kernel_launch: cooperative launch failed: %s (grid %d)\n", hipGetErrorString(e), grid);
}
```

```cpp
#include <hip/hip_runtime.h>
#include <hip/hip_bf16.h>
#include <hip/hip_cooperative_groups.h>
#include <cstdio>
#include <cstdint>
#include <cmath>
namespace cg = cooperative_groups;
namespace pg8 {
#define PG8_LAS __attribute__((address_space(3)))
typedef unsigned short bf16_t;
typedef short bf16x8 __attribute__((ext_vector_type(8)));
typedef float f32x4 __attribute__((ext_vector_type(4)));
typedef unsigned u32x4 __attribute__((ext_vector_type(4)));
constexpr int BM = 256, BK = 64, HALF = 128, HTB = HALF * BK * 2  , STAGE_BYTES = 8 * HTB, NXCD = 8, WGM = 8;

__host__ __device__ __forceinline__ int lds_byte(int r, int c) { const int st = (r >> 4) * 2 + (c >> 5), rr = r & 15, cc = c & 31, ob = rr * 64 + cc * 2; return st * 1024 + (ob ^ (((ob >> 9) & 1) << 5)); }
__host__ __device__ __forceinline__ void stage_rc(int b, int& R, int& C) { const int st = b / 1024, sb = b % 1024, swz = sb ^ (((sb >> 9) & 1) << 5); R = (st >> 1) * 16 + swz / 64; C = (st & 1) * 32 + (swz % 64) / 2; }
__host__ __device__ __forceinline__ int perm32(int rho) { const int n = rho >> 4, i = rho & 15; return 8 * (i >> 2) + 4 * n + (i & 3); }

struct Unit { int pm, pn; };
struct Gemm { const bf16_t* A; const bf16_t* Bt; int M, N, K; };

struct StaticOrder {
    int nM, nN, nwg, G, c;
    __host__ __device__ void init(int M, int N, int G_, int c_) { nM = M / BM; nN = N / BM; nwg = nM * nN; G = G_; c = c_; }
    __host__ __device__ bool next(int i, Unit& u) const {
        const long L = (long)i * G + c; if (L >= nwg) return false;
        int wgid = (int)L; { const int q = nwg / NXCD, r = nwg % NXCD, xcd = wgid % NXCD, off = wgid / NXCD; wgid = (xcd < r ? xcd * (q + 1) : r * (q + 1) + (xcd - r) * q) + off; }
        const int nig = WGM * nN, gid = wgid / nig, fm = gid * WGM, gsz = (nM - fm) < WGM ? (nM - fm) : WGM;
        u.pm = fm + ((wgid % nig) % gsz); u.pn = (wgid % nig) / gsz; return true;
    }
    __device__ __forceinline__ void a_ready(const Unit&) const {}
    __device__ __forceinline__ void done(const Unit&) const {}
};

__device__ __forceinline__ unsigned cvt_pk_bf16(float lo, float hi) { unsigned r; asm volatile("v_cvt_pk_bf16_f32 %0, %1, %2" : "=v"(r) : "v"(lo), "v"(hi)); return r; }
typedef float f32x2 __attribute__((ext_vector_type(2)));
__device__ __forceinline__ f32x2 gelu_pk(f32x2 v) {
    const f32x2 av = __builtin_elementwise_abs(v), d = av * 0.2316418882f + 1.0f;
    f32x2 t; t.x = __builtin_amdgcn_rcpf(d.x); t.y = __builtin_amdgcn_rcpf(d.y);
    f32x2 q = t * 0.5307027145f + (-0.7265760135f); q = q * t + 0.7107068705f; q = q * t + (-0.142248368f); q = q * t + 0.127414796f; q = q * t;
    const f32x2 s = (v * v) * (-0.72134752044f);
    f32x2 e; e.x = __builtin_amdgcn_exp2f(s.x); e.y = __builtin_amdgcn_exp2f(s.y);
    const f32x2 m = v * (q * e), r = v - m;
    f32x2 o; o.x = v.x < 0.f ? m.x : r.x; o.y = v.y < 0.f ? m.y : r.y; return o;
}

template <int ACT  > struct EpiBf16 {
    static constexpr bool PERM = true, AFTER_DRAIN = false; static_assert(ACT == 0 || ACT == 1, "EpiBf16: ACT is 0 (none) or 1 (gelu_pk)");
    bf16_t* O; int ldc; const float* bias; int split_cols; size_t split_stride; float scale0;
    __device__ __forceinline__ void operator()(const f32x4 (&acc)[2][2][4][2], const Unit& u, int wr, int wc, int fr, int fq) const {
        const int row0 = u.pm * BM + wr * 64 + fr; int colt = u.pn * BM; bf16_t* base = O;
        float sc = 1.f; if (split_cols) { const int t = colt / split_cols; base += (size_t)t * split_stride; colt -= t * split_cols; if (t == 0) sc = scale0; }
        const int col0 = colt + wc * 32 + 8 * fq, bcol0 = u.pn * BM + wc * 32 + 8 * fq;
        f32x4 bv[2][2];
#pragma unroll
        for (int bj = 0; bj < 2; ++bj)
#pragma unroll
            for (int n = 0; n < 2; ++n) bv[bj][n] = bias ? *(const f32x4*)(bias + bcol0 + bj * HALF + 4 * n) : (f32x4){0.f, 0.f, 0.f, 0.f};
#pragma unroll
        for (int ai = 0; ai < 2; ++ai)
#pragma unroll
            for (int m = 0; m < 4; ++m) { bf16_t* rowp = base + (size_t)(row0 + ai * HALF + m * 16) * ldc + col0;
#pragma unroll
                for (int bj = 0; bj < 2; ++bj) { f32x4 v0 = acc[ai][bj][m][0] + bv[bj][0], v1 = acc[ai][bj][m][1] + bv[bj][1];
                    if (ACT == 1) { f32x2 a = gelu_pk((f32x2){v0[0], v0[1]}), b = gelu_pk((f32x2){v0[2], v0[3]}), c = gelu_pk((f32x2){v1[0], v1[1]}), d = gelu_pk((f32x2){v1[2], v1[3]});
                        v0 = (f32x4){a.x, a.y, b.x, b.y}; v1 = (f32x4){c.x, c.y, d.x, d.y}; }
                    v0 = v0 * sc; v1 = v1 * sc; u32x4 w; w.x = cvt_pk_bf16(v0[0], v0[1]); w.y = cvt_pk_bf16(v0[2], v0[3]); w.z = cvt_pk_bf16(v1[0], v1[1]); w.w = cvt_pk_bf16(v1[2], v1[3]);
                    *(u32x4*)(rowp + bj * HALF) = w; } }
    }
};
struct EpiResF32 {
    static constexpr bool PERM = false, AFTER_DRAIN = false;
    const float* res; float* out; int ldc;
    __device__ __forceinline__ void operator()(const f32x4 (&acc)[2][2][4][2], const Unit& u, int wr, int wc, int fr, int fq) const {
        const int col0 = u.pn * BM + wc * 32 + 4 * fq;
#pragma unroll
        for (int ai = 0; ai < 2; ++ai)
#pragma unroll
            for (int mp = 0; mp < 2; ++mp) {
                f32x4 rv[2][2][2];
#pragma unroll
                for (int mm = 0; mm < 2; ++mm) { const size_t off = (size_t)(u.pm * BM + ai * HALF + wr * 64 + (2 * mp + mm) * 16 + fr) * ldc + col0;
#pragma unroll
                    for (int bj = 0; bj < 2; ++bj)
#pragma unroll
                        for (int n = 0; n < 2; ++n) rv[mm][bj][n] = *(const f32x4*)(res + off + bj * HALF + n * 16); }
                asm volatile("" ::: "memory");
#pragma unroll
                for (int mm = 0; mm < 2; ++mm) { const size_t off = (size_t)(u.pm * BM + ai * HALF + wr * 64 + (2 * mp + mm) * 16 + fr) * ldc + col0;
#pragma unroll
                    for (int bj = 0; bj < 2; ++bj)
#pragma unroll
                        for (int n = 0; n < 2; ++n) *(f32x4*)(out + off + bj * HALF + n * 16) = rv[mm][bj][n] + acc[ai][bj][2 * mp + mm][n]; }
                asm volatile("" ::: "memory");
            }
    }
};
struct EpiCin {
    static constexpr bool PERM = true, AFTER_DRAIN = false;
    bf16_t* O; const float* qg; const float* kg; PG8_LAS float* X;
    __device__ __forceinline__ void operator()(const f32x4 (&acc)[2][2][4][2], const Unit& u, int wr, int wc, int fr, int fq) const {
        const int sec = u.pn >> 3, h0 = (u.pn & 7) * 2, b = u.pm >> 4, s0 = (u.pm & 15) * BM + wr * 64 + fr;
        bf16_t* base = O + (size_t)sec * ((size_t)16384 * 2048) + ((size_t)(b * 16 + h0) * 4096) * 128 + wc * 32 + 8 * fq;
        const bool nrm = sec < 2;
        f32x4 g0 = (f32x4){1.f, 1.f, 1.f, 1.f}, g1 = g0;
        if (nrm) {
            const float* gp = (sec ? kg : qg) + wc * 32 + 8 * fq; g0 = *(const f32x4*)gp; g1 = *(const f32x4*)(gp + 4);
#pragma unroll
            for (int ai = 0; ai < 2; ++ai)
#pragma unroll
                for (int m = 0; m < 4; ++m)
#pragma unroll
                    for (int bj = 0; bj < 2; ++bj) { const f32x4 v0 = acc[ai][bj][m][0], v1 = acc[ai][bj][m][1];
                        float ss = ((v0[0] * v0[0] + v0[1] * v0[1]) + (v0[2] * v0[2] + v0[3] * v0[3])) + ((v1[0] * v1[0] + v1[1] * v1[1]) + (v1[2] * v1[2] + v1[3] * v1[3]));
                        ss += __shfl_xor(ss, 16); ss += __shfl_xor(ss, 32);
                        if (fq == 0) X[((ai * HALF + wr * 64 + m * 16 + fr) * 2 + bj) * 4 + wc] = ss; }
            asm volatile("s_waitcnt lgkmcnt(0)" ::: "memory"); __builtin_amdgcn_s_barrier(); asm volatile("" ::: "memory");
        }
#pragma unroll
        for (int ai = 0; ai < 2; ++ai)
#pragma unroll
            for (int m = 0; m < 4; ++m) { bf16_t* rowp = base + (size_t)(s0 + ai * HALF + m * 16) * 128;
#pragma unroll
                for (int bj = 0; bj < 2; ++bj) { f32x4 v0 = acc[ai][bj][m][0], v1 = acc[ai][bj][m][1];
                    if (nrm) { const f32x4 pp = *(const PG8_LAS f32x4*)(X + ((ai * HALF + wr * 64 + m * 16 + fr) * 2 + bj) * 4);
                        const float r = __builtin_amdgcn_rsqf(((pp[0] + pp[1]) + (pp[2] + pp[3])) * (1.0f / 128.0f) + 1e-6f); v0 = v0 * r * g0; v1 = v1 * r * g1; }
                    u32x4 w; w.x = cvt_pk_bf16(v0[0], v0[1]); w.y = cvt_pk_bf16(v0[2], v0[3]); w.z = cvt_pk_bf16(v1[0], v1[1]); w.w = cvt_pk_bf16(v1[2], v1[3]);
                    *(u32x4*)(rowp + (size_t)bj * 4096 * 128) = w; } }
    }
};
__device__ __forceinline__ float dpp_ror1(float v) { return __builtin_bit_cast(float, __builtin_amdgcn_update_dpp(0, __builtin_bit_cast(int, v), 0x121, 0xF, 0xF, false)); }
__device__ __forceinline__ float dpp_ror2(float v) { return __builtin_bit_cast(float, __builtin_amdgcn_update_dpp(0, __builtin_bit_cast(int, v), 0x122, 0xF, 0xF, false)); }
struct EpiConvGate {
    static constexpr bool PERM = true, AFTER_DRAIN = false;
    bf16_t* GA; float* HALO; const float* cw; const float* cb;
    __device__ __forceinline__ void operator()(f32x4 (&acc)[2][2][4][2], const Unit& u, int wr, int wc, int fr, int fq) const {
        constexpr int F2 = 11264, FH = 5632;
        const float* __restrict__ cwr = cw; const float* __restrict__ cbr = cb; bf16_t* __restrict__ GAr = GA; float* __restrict__ HALOr = HALO;
        const int cl = wc * 32 + 8 * fq, ca = u.pn * 128 + cl, ct = u.pn * 256 + cl;
        if (fr < 2 || fr >= 14) { const bool lo = fr < 2; const int slot = lo ? fr : fr - 12;
#pragma unroll
            for (int ai = 0; ai < 2; ++ai) { float* hb = HALOr + ((size_t)(u.pm * 4 + ai * 2 + wr) * 4 + slot) * F2 + ct;
#pragma unroll
                for (int bj = 0; bj < 2; ++bj)
#pragma unroll
                    for (int n = 0; n < 2; ++n) { const f32x4 z0 = acc[ai][bj][0][n], z3 = acc[ai][bj][3][n]; f32x4 z;
#pragma unroll
                        for (int i = 0; i < 4; ++i) z[i] = lo ? z0[i] : z3[i];
                        *(f32x4*)(hb + bj * 128 + 4 * n) = z; } } }
        asm volatile("" ::: "memory");
        const bool f1 = fr >= 1, f2 = fr >= 2;
#pragma unroll
        for (int n = 0; n < 2; ++n) {
#pragma unroll
            for (int ai = 0; ai < 2; ++ai) {
                const int grp = u.pm * 4 + ai * 2 + wr;
                f32x4 A[4];
                {
                    const f32x4 w0 = *(const f32x4*)(cwr + ca + 4 * n), w1 = *(const f32x4*)(cwr + F2 + ca + 4 * n), w2 = *(const f32x4*)(cwr + 2 * F2 + ca + 4 * n), bs = *(const f32x4*)(cbr + ca + 4 * n);
                    f32x4 p1 = (f32x4){0.f, 0.f, 0.f, 0.f}, p2 = p1;
#pragma unroll
                    for (int m = 0; m < 4; ++m) { const f32x4 z = acc[ai][0][m][n]; f32x4 r1, r2;
#pragma unroll
                        for (int i = 0; i < 4; ++i) { r1[i] = dpp_ror1(z[i]); r2[i] = dpp_ror2(z[i]); }
#pragma unroll
                        for (int i = 0; i < 4; ++i) A[m][i] = bs[i] + w0[i] * (f2 ? r2[i] : p2[i]) + w1[i] * (f1 ? r1[i] : p1[i]) + w2[i] * z[i];
                        p1 = r1; p2 = r2; }
                }
                {
                    const f32x4 w0 = *(const f32x4*)(cwr + FH + ca + 4 * n), w1 = *(const f32x4*)(cwr + F2 + FH + ca + 4 * n), w2 = *(const f32x4*)(cwr + 2 * F2 + FH + ca + 4 * n), bs = *(const f32x4*)(cbr + FH + ca + 4 * n);
                    f32x4 p1 = (f32x4){0.f, 0.f, 0.f, 0.f}, p2 = p1;
#pragma unroll
                    for (int m = 0; m < 4; ++m) { const f32x4 z = acc[ai][1][m][n]; f32x4 r1, r2;
#pragma unroll
                        for (int i = 0; i < 4; ++i) { r1[i] = dpp_ror1(z[i]); r2[i] = dpp_ror2(z[i]); }
                        float g[4];
#pragma unroll
                        for (int i = 0; i < 4; ++i) { const float b = bs[i] + w0[i] * (f2 ? r2[i] : p2[i]) + w1[i] * (f1 ? r1[i] : p1[i]) + w2[i] * z[i]; const float a = A[m][i];
                            g[i] = a * __builtin_amdgcn_rcpf(1.0f + __expf(-a)) * b; }
                        p1 = r1; p2 = r2;
                        *(unsigned long long*)(GAr + ((size_t)grp * 64 + m * 16 + fr) * FH + ca + 4 * n) = (unsigned long long)cvt_pk_bf16(g[0], g[1]) | ((unsigned long long)cvt_pk_bf16(g[2], g[3]) << 32); }
                }
            }
        }
    }
};
template <class Epi, class Sched, bool ALIGN_EPI = false, bool SP2 = false>
__device__ __forceinline__ void gemm_phase(PG8_LAS unsigned char* lds, const Gemm g, const Sched& S, const Epi& E) {
    int tid_l = threadIdx.x; asm volatile("" : "+v"(tid_l)); const int tid = tid_l, wid = __builtin_amdgcn_readfirstlane(tid >> 6), lane = tid & 63, wr = wid >> 2, wc = wid & 3, fr = lane & 15, fq = lane >> 4;
    const int K = g.K, nt = K / BK;
    unsigned voffA[2], voffB[2];
#pragma unroll
    for (int i = 0; i < 2; ++i) { int R, C; stage_rc(tid * 16 + i * 8192, R, C); const int Rb = Epi::PERM ? ((R & ~31) + perm32(R & 31)) : R;
        voffA[i] = (unsigned)(R * K + C) * 2u; voffB[i] = (unsigned)(Rb * K + C) * 2u; }
    const size_t kstep = (size_t)(BK * 2);
    const size_t hstep = (size_t)HALF * K * 2;
    const size_t tstep = 2 * hstep;
    const unsigned ldsw = (unsigned)wid * 1024u;
    const int aoff = lds_byte(wr * 64 + fr, fq * 8), boff = lds_byte(wc * 32 + fr, fq * 8);
#define PG8_SA(b, h) (((b) * 2 + (h)) * HTB)
#define PG8_SB(b, h) ((4 + (b) * 2 + (h)) * HTB)
#define PG8_STAGE(bufoff, gbase, voff) do { _Pragma("unroll") for (int _i = 0; _i < 2; ++_i) \
        __builtin_amdgcn_global_load_lds((const unsigned*)((const char*)(gbase) + (voff)[_i]), (PG8_LAS unsigned*)(lds + (bufoff) + ldsw + _i * 8192), 16, 0, 0); } while (0)
#define PG8_LDA(dst, b, h) do { _Pragma("unroll") for (int m = 0; m < 4; ++m) _Pragma("unroll") for (int k = 0; k < 2; ++k) dst[m][k] = *(const PG8_LAS bf16x8*)(lds + PG8_SA(b, h) + aoff + m * 2048 + k * 1024); } while (0)
#define PG8_LDB(dst, b, h) do { _Pragma("unroll") for (int n = 0; n < 2; ++n) _Pragma("unroll") for (int k = 0; k < 2; ++k) dst[n][k] = *(const PG8_LAS bf16x8*)(lds + PG8_SB(b, h) + boff + n * 2048 + k * 1024); } while (0)
#define PG8_MMA(ai, bj, At, Bt) do { __builtin_amdgcn_s_setprio(1); _Pragma("unroll") for (int m = 0; m < 4; ++m) _Pragma("unroll") for (int n = 0; n < 2; ++n) _Pragma("unroll") for (int k = 0; k < 2; ++k) \
        acc[ai][bj][m][n] = __builtin_amdgcn_mfma_f32_16x16x32_bf16(Bt[n][k], At[m][k], acc[ai][bj][m][n], 0, 0, 0); __builtin_amdgcn_s_setprio(0); } while (0)
#define PG8_WAIT_V(n) asm volatile("s_waitcnt vmcnt(" #n ")" ::: "memory")
#define PG8_WAIT_L(n) asm volatile("s_waitcnt lgkmcnt(" #n ")" ::: "memory")
#define PG8_BAR __builtin_amdgcn_s_barrier()
#define PG8_SCHED __builtin_amdgcn_sched_barrier(0)
    Unit cur, nxt; int ui = 0;
    if (!S.next(0, cur)) return;
    f32x4 acc[2][2][4][2];
#pragma unroll
    for (int a = 0; a < 2; ++a)
#pragma unroll
        for (int b = 0; b < 2; ++b)
#pragma unroll
            for (int m = 0; m < 4; ++m)
#pragma unroll
                for (int n = 0; n < 2; ++n) acc[a][b][m][n] = (f32x4){0.f, 0.f, 0.f, 0.f};
    bf16x8 At[4][2], B0[2][2], B1[2][2];
    const char* cA = (const char*)g.A + (size_t)cur.pm * tstep; const char* cB = (const char*)g.Bt + (size_t)cur.pn * tstep;
    S.a_ready(cur);
    if constexpr (SP2) {
        PG8_STAGE(PG8_SB(0, 0), cB, voffB); PG8_STAGE(PG8_SB(0, 1), cB + hstep, voffB); PG8_STAGE(PG8_SA(0, 0), cA, voffA); PG8_STAGE(PG8_SA(0, 1), cA + hstep, voffA);
        if (wr == 1) PG8_BAR;
        PG8_WAIT_V(2); PG8_BAR;
        PG8_STAGE(PG8_SB(1, 0), cB + kstep, voffB); PG8_STAGE(PG8_SA(1, 0), cA + kstep, voffA); PG8_STAGE(PG8_SB(1, 1), cB + hstep + kstep, voffB);
        PG8_WAIT_V(6); PG8_BAR;
    } else {
        PG8_STAGE(PG8_SB(0, 0), cB, voffB); PG8_STAGE(PG8_SA(0, 0), cA, voffA); PG8_STAGE(PG8_SB(0, 1), cB + hstep, voffB); PG8_STAGE(PG8_SA(0, 1), cA + hstep, voffA);
        if (wr == 1) PG8_BAR;
        PG8_WAIT_V(4); PG8_BAR;
        PG8_STAGE(PG8_SB(1, 0), cB + kstep, voffB); PG8_STAGE(PG8_SA(1, 0), cA + kstep, voffA); PG8_STAGE(PG8_SB(1, 1), cB + hstep + kstep, voffB);
        PG8_WAIT_V(6); PG8_BAR;
    }
    for (;;) {
        const bool has_next = S.next(ui + 1, nxt);
        const char* nA = has_next ? (const char*)g.A + (size_t)nxt.pm * tstep : cA; const char* nB = has_next ? (const char*)g.Bt + (size_t)nxt.pn * tstep : cB;
        for (int t = 0; t < nt; t += 2) {
            const bool last = (t == nt - 2);
            const char* a1 = cA + (size_t)(t + 1) * kstep;
            const char* a2 = last ? nA : cA + (size_t)(t + 2) * kstep; const char* b2 = last ? nB : cB + (size_t)(t + 2) * kstep;
            const char* a3 = a2 + kstep; const char* b3 = b2 + kstep;
            if (last && has_next) S.a_ready(nxt);
            if constexpr (SP2) {
            PG8_LDB(B0, 0, 0); PG8_LDB(B1, 0, 1); PG8_SCHED; PG8_LDA(At, 0, 0); PG8_STAGE(PG8_SA(1, 1), a1 + hstep, voffA);
            PG8_WAIT_V(8); PG8_WAIT_L(0); PG8_BAR; PG8_MMA(0, 0, At, B0); PG8_MMA(0, 1, At, B1); PG8_BAR; PG8_SCHED;
            PG8_LDA(At, 0, 1); PG8_STAGE(PG8_SB(0, 0), b2, voffB); PG8_STAGE(PG8_SB(0, 1), b2 + hstep, voffB); PG8_STAGE(PG8_SA(0, 0), a2, voffA);
            PG8_WAIT_V(8); PG8_WAIT_L(0); PG8_BAR; PG8_MMA(1, 0, At, B0); PG8_MMA(1, 1, At, B1); PG8_BAR; PG8_SCHED;
            PG8_LDB(B0, 1, 0); PG8_LDB(B1, 1, 1); PG8_SCHED; PG8_LDA(At, 1, 0); PG8_STAGE(PG8_SA(0, 1), a2 + hstep, voffA);
            PG8_WAIT_V(8); PG8_WAIT_L(0); PG8_BAR; PG8_MMA(0, 0, At, B0); PG8_MMA(0, 1, At, B1); PG8_BAR; PG8_SCHED;
            PG8_LDA(At, 1, 1); PG8_STAGE(PG8_SB(1, 0), b3, voffB); PG8_STAGE(PG8_SB(1, 1), b3 + hstep, voffB); PG8_STAGE(PG8_SA(1, 0), a3, voffA);
            PG8_WAIT_V(8); PG8_WAIT_L(0); PG8_BAR; PG8_MMA(1, 0, At, B0); PG8_MMA(1, 1, At, B1); PG8_BAR; PG8_SCHED;
            } else {
            PG8_LDB(B0, 0, 0); PG8_SCHED; PG8_LDA(At, 0, 0); PG8_STAGE(PG8_SA(1, 1), a1 + hstep, voffA);
            PG8_WAIT_L(8); PG8_BAR; PG8_WAIT_L(0); PG8_MMA(0, 0, At, B0); PG8_BAR; PG8_SCHED;
            PG8_LDB(B1, 0, 1); PG8_STAGE(PG8_SB(0, 0), b2, voffB);
            PG8_BAR; PG8_WAIT_L(0); PG8_MMA(0, 1, At, B1); PG8_BAR;
            PG8_LDA(At, 0, 1); PG8_STAGE(PG8_SA(0, 0), a2, voffA);
            PG8_BAR; PG8_WAIT_L(0); PG8_MMA(1, 0, At, B0); PG8_BAR; PG8_SCHED;
            PG8_STAGE(PG8_SB(0, 1), b2 + hstep, voffB);
            PG8_WAIT_V(6); PG8_BAR; PG8_MMA(1, 1, At, B1); PG8_BAR;
            PG8_LDB(B0, 1, 0); PG8_SCHED; PG8_LDA(At, 1, 0); PG8_STAGE(PG8_SA(0, 1), a2 + hstep, voffA);
            PG8_WAIT_L(8); PG8_BAR; PG8_WAIT_L(0); PG8_MMA(0, 0, At, B0); PG8_BAR; PG8_SCHED;
            PG8_LDB(B1, 1, 1); PG8_STAGE(PG8_SB(1, 0), b3, voffB);
            PG8_BAR; PG8_WAIT_L(0); PG8_MMA(0, 1, At, B1); PG8_BAR;
            PG8_LDA(At, 1, 1); PG8_STAGE(PG8_SA(1, 0), a3, voffA);
            PG8_BAR; PG8_WAIT_L(0); PG8_MMA(1, 0, At, B0); PG8_BAR; PG8_SCHED;
            PG8_STAGE(PG8_SB(1, 1), b3 + hstep, voffB);
            PG8_WAIT_V(6); PG8_BAR; PG8_MMA(1, 1, At, B1); PG8_BAR;
            }
        }
        if constexpr (ALIGN_EPI) { if (wr == 0) PG8_BAR; }
        if constexpr (!Epi::AFTER_DRAIN) { E(acc, cur, wr, wc, fr, fq); S.done(cur); }
        if (!has_next) break;
#pragma unroll
        for (int a = 0; a < 2; ++a)
#pragma unroll
            for (int b = 0; b < 2; ++b)
#pragma unroll
                for (int m = 0; m < 4; ++m)
#pragma unroll
                    for (int n = 0; n < 2; ++n) acc[a][b][m][n] = (f32x4){0.f, 0.f, 0.f, 0.f};
        cur = nxt; cA = nA; cB = nB; ++ui;
        if constexpr (ALIGN_EPI) { if (wr == 1) PG8_BAR; }
    }
    PG8_WAIT_V(0);
    if constexpr (!ALIGN_EPI) { if (wr == 0) PG8_BAR; }
    PG8_BAR;
    if constexpr (Epi::AFTER_DRAIN) { E.fused(acc, cur, wr, wc, fr, fq, lds, wid, lane); S.done(cur); }
#undef PG8_SA
#undef PG8_SB
#undef PG8_STAGE
#undef PG8_LDA
#undef PG8_LDB
#undef PG8_MMA
#undef PG8_WAIT_V
#undef PG8_WAIT_L
#undef PG8_BAR
#undef PG8_SCHED
}
}
namespace fox {
constexpr int D = 128, PQ = 128, PO = 2048;
constexpr float THR = 8.f; constexpr bool WSKIP = false;
constexpr float SCALE = 0.08838834764831845f;
constexpr int NW = 8, QBLK = 32, KVBLK = 64, QB = NW * QBLK;
constexpr int SHM_V = KVBLK * D * 2, SHM_K = KVBLK * D * 2;
constexpr int LDS_CB = 2 * SHM_V + 2 * SHM_K + NW * 64 * 4;
constexpr int LDS_BYTES = LDS_CB + 4096 * 4;

using bf16 = __hip_bfloat16;
typedef short bf16x8 __attribute__((ext_vector_type(8)));
typedef short s16x4 __attribute__((ext_vector_type(4)));
typedef float f32x16 __attribute__((ext_vector_type(16)));
typedef float f32x4 __attribute__((ext_vector_type(4)));
typedef unsigned u32x4 __attribute__((ext_vector_type(4)));
template <class A, class Bt> struct same_t { static constexpr bool v = false; };
template <class A> struct same_t<A, A> { static constexpr bool v = true; };

#define KSWZ(row, colB) ((row) * 256 + ((colB) ^ (((row) & 7) << 4)))
#define SBAR() __builtin_amdgcn_sched_barrier(0)
__device__ __forceinline__ int v_st(int k, int c) { const int kk = (k & ~0xC) | ((k & 4) << 1) | ((k & 8) >> 1); return ((kk >> 3) * 4 + (c >> 5)) * 512 + ((kk & 7) * 32 + (c & 31)) * 2; }
__device__ __forceinline__ int v_rd_base(int lane) { return ((lane & 3) << 3) | (((lane >> 2) & 3) << 6) | (((lane >> 4) & 1) << 5) | (((lane >> 5) & 1) << 8); }
constexpr int v_rd_off(int d0, int ks, int half) { return d0 * 512 + ks * 4096 + half * 2048; }
__device__ __forceinline__ int crow(int r, int hi) { return (r & 3) + 8 * (r >> 2) + 4 * hi; }
__device__ __forceinline__ unsigned cvtpk(float lo, float hi) {
    unsigned r; asm volatile("v_cvt_pk_bf16_f32 %0, %1, %2" : "=v"(r) : "v"(lo), "v"(hi)); return r;
}
__device__ __forceinline__ bf16x8 pack8(f32x4 a, f32x4 b) {
    u32x4 w = {cvtpk(a[0], a[1]), cvtpk(a[2], a[3]), cvtpk(b[0], b[1]), cvtpk(b[2], b[3])};
    return *reinterpret_cast<bf16x8*>(&w);
}
template <class T> __device__ __forceinline__ bf16x8 load8(const T* p) {
    if constexpr (same_t<T, float>::v) { return pack8(*(const f32x4*)p, *(const f32x4*)(p + 4)); }
    else { return *reinterpret_cast<const bf16x8*>(p); }
}
__device__ __forceinline__ void mask_tile(f32x16& p0, f32x16& p1, int dq, unsigned W) {
    const float NEG = -__builtin_inff();
#pragma unroll
    for (int r = 0; r < 16; ++r) {
        const int c = (r & 3) + 8 * (r >> 2);
        if ((unsigned)(dq - c) >= W) p0[r] = NEG;
        if ((unsigned)(dq - c - 32) >= W) p1[r] = NEG;
    }
}
__device__ __forceinline__ void partialSM(f32x16& p0, f32x16& p1, float& m_reg, float& mn, float& alpha) {
    float pmax = p0[0]; for (int r = 1; r < 16; ++r) pmax = fmaxf(pmax, p0[r]); for (int r = 0; r < 16; ++r) pmax = fmaxf(pmax, p1[r]);
    { auto rr = __builtin_amdgcn_permlane32_swap(__float_as_uint(pmax), __float_as_uint(pmax), false, false);
      pmax = fmaxf(__uint_as_float(rr[0]), __uint_as_float(rr[1])); }
    constexpr float C2 = 1.4426950408889634f * SCALE;
    if (__builtin_expect(__all((pmax - m_reg) * SCALE <= THR), 1)) { mn = m_reg; alpha = 1.f; }
    else { mn = fmaxf(m_reg, pmax); alpha = __builtin_amdgcn_exp2f((m_reg - mn) * C2); m_reg = mn; }
    const float mnL = -mn * C2;
    for (int r = 0; r < 16; ++r) p0[r] = fmaf(p0[r], C2, mnL); for (int r = 0; r < 16; ++r) p1[r] = fmaf(p1[r], C2, mnL);
    for (int r = 0; r < 16; ++r) p0[r] = __builtin_amdgcn_exp2f(p0[r]);
}
__device__ __forceinline__ void finishSM(f32x16& p0, f32x16& p1, float alpha, float& l_reg, bf16x8& pa0, bf16x8& pa1, bf16x8& pa2, bf16x8& pa3) {
    for (int r = 0; r < 16; ++r) p1[r] = __builtin_amdgcn_exp2f(p1[r]);
    float ps = 0; for (int r = 0; r < 16; ++r) ps += p0[r]; for (int r = 0; r < 16; ++r) ps += p1[r];
    { auto rr = __builtin_amdgcn_permlane32_swap(__float_as_uint(ps), __float_as_uint(ps), false, false);
      ps = __uint_as_float(rr[0]) + __uint_as_float(rr[1]); }
    l_reg = l_reg * alpha + ps;
#define PK4(P, B_, OUT) do { unsigned a0 = cvtpk(P[B_+0], P[B_+1]), a1 = cvtpk(P[B_+2], P[B_+3]);                          \
        unsigned b0 = cvtpk(P[B_+4], P[B_+5]), b1 = cvtpk(P[B_+6], P[B_+7]);                                             \
        auto r0 = __builtin_amdgcn_permlane32_swap(a0, b0, false, false); auto r1 = __builtin_amdgcn_permlane32_swap(a1, b1, false, false); \
        u32x4 w = {r0[0], r1[0], r0[1], r1[1]}; OUT = *reinterpret_cast<bf16x8*>(&w); } while (0)
    PK4(p0, 0, pa0); PK4(p0, 8, pa1); PK4(p1, 0, pa2); PK4(p1, 8, pa3);
#undef PK4
}
__device__ __forceinline__ void bias_init(f32x16& p0, f32x16& p1, const float* cbt) {
#pragma unroll
    for (int g = 0; g < 4; ++g) { const f32x4 b0v = *(const f32x4*)(cbt + 8 * g), b1v = *(const f32x4*)(cbt + 32 + 8 * g);
        p0[4 * g] = b0v[0]; p0[4 * g + 1] = b0v[1]; p0[4 * g + 2] = b0v[2]; p0[4 * g + 3] = b0v[3];
        p1[4 * g] = b1v[0]; p1[4 * g + 1] = b1v[1]; p1[4 * g + 2] = b1v[2]; p1[4 * g + 3] = b1v[3]; }
}
template <int KB, bool SK>
__device__ __forceinline__ void qkt(f32x16& p0, f32x16& p1, const char* K_lds, int r32, int hi, const bf16x8* qr, bool act, const float* cbt) {
    if (SK && !act) { const float NEG = -__builtin_inff();
#pragma unroll
        for (int r = 0; r < 16; ++r) { p0[r] = NEG; p1[r] = NEG; } return; }
    (void)cbt;
    const char* kb[4];
#pragma unroll
    for (int dd = 0; dd < 4; ++dd) kb[dd] = K_lds + KB * SHM_K + KSWZ(r32, (dd * 16 + hi * 8) * 2);
#pragma unroll
    for (int d0 = 0; d0 < 8; ++d0) { const char* a = kb[d0 & 3] + (d0 >> 2) * 128;
        bf16x8 b0 = *reinterpret_cast<const bf16x8*>(a);
        bf16x8 b1 = *reinterpret_cast<const bf16x8*>(a + 32 * 256);
        p0 = __builtin_amdgcn_mfma_f32_32x32x16_bf16(b0, qr[d0], p0, 0, 0, 0);
        p1 = __builtin_amdgcn_mfma_f32_32x32x16_bf16(b1, qr[d0], p1, 0, 0, 0); }
}
template <int VB, bool SK>
__device__ __forceinline__ void pv_tile(f32x16* o, int vb0, bf16x8 pa0, bf16x8 pa1, bf16x8 pa2, bf16x8 pa3, bool act) {
    if (SK && !act) return;
#define TRRD(dst, off) asm volatile("ds_read_b64_tr_b16 %0, %1 offset:%2" : "=&v"(dst) : "v"(vb0), "i"(off) : "memory")
#define PV_D0(d0) do { s16x4 l0, l1, l2, l3, h0, h1, h2, h3; constexpr int b_ = VB * SHM_V + v_rd_off(d0, 0, 0);     \
        TRRD(l0, b_); TRRD(h0, b_ + 2048); TRRD(l1, b_ + 4096); TRRD(h1, b_ + 6144); TRRD(l2, b_ + 8192); TRRD(h2, b_ + 10240); TRRD(l3, b_ + 12288); TRRD(h3, b_ + 14336); \
        asm volatile("s_waitcnt lgkmcnt(0)" ::: "memory"); SBAR();                 \
        o[d0] = __builtin_amdgcn_mfma_f32_32x32x16_bf16(pa0, (bf16x8){l0[0], l0[1], l0[2], l0[3], h0[0], h0[1], h0[2], h0[3]}, o[d0], 0, 0, 0);   \
        o[d0] = __builtin_amdgcn_mfma_f32_32x32x16_bf16(pa1, (bf16x8){l1[0], l1[1], l1[2], l1[3], h1[0], h1[1], h1[2], h1[3]}, o[d0], 0, 0, 0);   \
        o[d0] = __builtin_amdgcn_mfma_f32_32x32x16_bf16(pa2, (bf16x8){l2[0], l2[1], l2[2], l2[3], h2[0], h2[1], h2[2], h2[3]}, o[d0], 0, 0, 0);   \
        o[d0] = __builtin_amdgcn_mfma_f32_32x32x16_bf16(pa3, (bf16x8){l3[0], l3[1], l3[2], l3[3], h3[0], h3[1], h3[2], h3[3]}, o[d0], 0, 0, 0); } while (0)
    PV_D0(0); PV_D0(1); PV_D0(2); PV_D0(3);
#undef PV_D0
#undef TRRD
}

__device__ __forceinline__ int fox_jlo(const float* cb, int P0, float margin) {
    const int lane = threadIdx.x & 63, nt0 = P0 / KVBLK;
    const float thr = cb[P0] + margin;
    bool dead = false; if (lane < nt0) dead = cb[KVBLK * lane + KVBLK - 1] > thr;
    const unsigned long long m = __ballot(dead);
    return __builtin_amdgcn_readfirstlane((int)__builtin_ctzll(~m));
}
template <class TIn, class TOut> struct BlockRef { const TIn* Q; const TIn* K; const TIn* V; TOut* O; int P0; const float* cb; const TIn* Gt; };
template <class TIn> struct Seam {
    bf16x8 qr[8];
    bf16x8 st_v0, st_v1, st_k0, st_k1; f32x4 sf0, sf1, sf2, sf3;
    f32x4 tq[16];
};
__device__ __forceinline__ int swa_jlo(int P0, int W) { const int lowk = P0 - W + 1; return lowk > 0 ? lowk / KVBLK : 0; }
#define ROW(p, k0, rr) ((p) + (size_t)((k0) + (rr)) * PQ + sc)
#define VMW() asm volatile("s_waitcnt vmcnt(0)" ::: "memory")
#define VMWN(n) asm volatile("s_waitcnt vmcnt(%0)" :: "i"(n) : "memory")
#define SLOAD_H(Kp, Vp, k0) do { S.st_v0 = load8<TIn>(ROW(Vp, k0, sr)); S.st_v1 = load8<TIn>(ROW(Vp, k0, 32 + sr));              \
                         S.st_k0 = load8<TIn>(ROW(Kp, k0, sr)); S.st_k1 = load8<TIn>(ROW(Kp, k0, 32 + sr)); } while (0)
#define SWRITE_HK(bf) do { *(bf16x8*)(K_lds + (bf) * SHM_K + kws) = S.st_k0; *(bf16x8*)(K_lds + (bf) * SHM_K + kws + 32 * 256) = S.st_k1; } while (0)
#define SWRITE_HV(bf) do { *(bf16x8*)(V_lds + (bf) * SHM_V + vst0) = S.st_v0; *(bf16x8*)(V_lds + (bf) * SHM_V + vst1) = S.st_v1; } while (0)
#define SWRITE_H(bf) do { SWRITE_HV(bf); SWRITE_HK(bf); } while (0)
#define SLOAD_F(p, k0) do { S.sf0 = *(const f32x4*)ROW(p, k0, sr); S.sf1 = *(const f32x4*)(ROW(p, k0, sr) + 4);                \
                            S.sf2 = *(const f32x4*)ROW(p, k0, 32 + sr); S.sf3 = *(const f32x4*)(ROW(p, k0, 32 + sr) + 4); } while (0)
#define SWRITE_KF(bf) do { *(bf16x8*)(K_lds + (bf) * SHM_K + kws) = pack8(S.sf0, S.sf1); *(bf16x8*)(K_lds + (bf) * SHM_K + kws + 32 * 256) = pack8(S.sf2, S.sf3); } while (0)
#define SWRITE_VF(bf) do { *(bf16x8*)(V_lds + (bf) * SHM_V + vst0) = pack8(S.sf0, S.sf1); *(bf16x8*)(V_lds + (bf) * SHM_V + vst1) = pack8(S.sf2, S.sf3); } while (0)
template <class TIn, class TOut>
__device__ __forceinline__ void causal_swa_prime(const BlockRef<TIn, TOut>& cur, int W, char* lds, Seam<TIn>& S) {
    constexpr bool F32 = same_t<TIn, float>::v;
    int tid_l = threadIdx.x; asm volatile("" : "+v"(tid_l)); const int tid = tid_l, wid = __builtin_amdgcn_readfirstlane(tid >> 6), lane = tid & 63, r32 = lane & 31, hi = lane >> 5;
    const int sr = tid >> 4, sc = (tid & 15) * 8, kws = KSWZ(sr, sc * 2); char* K_lds = lds + 2 * SHM_V;
    const int kb0 = swa_jlo(cur.P0, W) * KVBLK;
    for (int d0 = 0; d0 < 8; ++d0) S.qr[d0] = load8<TIn>(cur.Q + (size_t)(wid * QBLK + r32) * PQ + d0 * 16 + hi * 8);
    if constexpr (F32) { SLOAD_F((const float*)cur.K, kb0); VMW(); SWRITE_KF(0); SBAR(); SLOAD_F((const float*)cur.V, kb0); }
    else { SLOAD_H(cur.K, cur.V, kb0); VMW(); SWRITE_HK(0); }
    __syncthreads();
}
template <class TIn, class TOut>
__device__ __forceinline__ void causal_swa_block(const BlockRef<TIn, TOut>& cur, const BlockRef<TIn, TOut>& nxt, int skv, int W, char* lds, Seam<TIn>& S) {
    constexpr bool F32 = same_t<TIn, float>::v;
    int tid_l = threadIdx.x; asm volatile("" : "+v"(tid_l)); const int tid = tid_l, wid = __builtin_amdgcn_readfirstlane(tid >> 6), lane = tid & 63, r32 = lane & 31, hi = lane >> 5;
    const int j_lo = swa_jlo(cur.P0, W);
    int j_hi = (cur.P0 + QB - 1) / KVBLK + 1; if (j_hi > skv / KVBLK) j_hi = skv / KVBLK;
    const int NT = j_hi - j_lo;
    const int kbn = swa_jlo(nxt.P0, W) * KVBLK;
    const int qlo = cur.P0 + wid * QBLK, qm = qlo + r32 - 4 * hi;
    char* V_lds = lds; char* K_lds = lds + 2 * SHM_V;
    float* ws = (float*)(lds + 2 * SHM_V + 2 * SHM_K) + wid * 64; float* li_l = ws, * al_l = ws + 32;
    float m_reg = -1e30f, l_reg = 0; f32x16 o[4] = {};
    float* cbl = (float*)(lds + LDS_CB);
    { const float cref = cur.cb[cur.P0]; const float rs = 1.0f / SCALE;
      for (int i = tid; i < cur.P0 + QB; i += 64 * NW) cbl[i] = (cref - cur.cb[i]) * rs;
      __syncthreads(); }
    const float* cbh = cbl + 4 * hi;
    const int sr = tid >> 4, sc = (tid & 15) * 8, vst0 = v_st(sr, sc), vst1 = v_st(32 + sr, sc), kws = KSWZ(sr, sc * 2);
    const int vb0 = (int)(uintptr_t)V_lds + v_rd_base(lane);
    const TIn* Kh = cur.K; const TIn* Vh = cur.V;
#define RESC(a) do { if (__any((a) < 1.f)) { if (hi == 0) al_l[r32] = (a); asm volatile("s_waitcnt lgkmcnt(0)" ::: "memory");              \
                     for (int d_ = 0; d_ < 4; ++d_) for (int r = 0; r < 16; ++r) o[d_][r] *= al_l[crow(r, hi)]; } } while (0)
#define KBASE(t) ((j_lo + (t)) * KVBLK)
#define ACT(t) (KBASE(t) <= qlo + QBLK - 1 && KBASE(t) + KVBLK - 1 >= qlo - W + 1)
#define MASKT(P0_, P1_, t) do { const int kb_ = KBASE(t); if ((!SK || ACT(t)) && (kb_ + KVBLK - 1 > qlo || kb_ <= qlo + QBLK - 1 - W)) mask_tile(P0_, P1_, qm - kb_, (unsigned)W); } while (0)
    constexpr int NQL = F32 ? 16 : 8;
    constexpr bool SK = WSKIP && !F32;
#define SEAM_K0() do { VMWN(NQL); if constexpr (F32) { SWRITE_KF(0); SBAR(); SLOAD_F((const float*)nxt.V, kbn); } else { SWRITE_HK(0); } SBAR(); } while (0)
    f32x16 pA0, pA1, pB0, pB1; float mnA, mnB, alA, alB; bf16x8 pa0, pa1, pa2, pa3;
    if constexpr (F32) { VMW(); SWRITE_VF(0); SBAR(); } else { SWRITE_HV(0); SBAR(); }
    if (NT > 1) { if constexpr (F32) SLOAD_F((const float*)Kh, KBASE(1)); else SLOAD_H(Kh, Vh, KBASE(1)); }
    bias_init(pA0, pA1, cbh + KBASE(0)); if (NT > 1) bias_init(pB0, pB1, cbh + KBASE(1));
    SBAR(); qkt<0, SK>(pA0, pA1, K_lds, r32, hi, S.qr, ACT(0), cbh + KBASE(0));
    if constexpr (F32) { if (NT > 1) { VMW(); SWRITE_KF(1); SBAR(); SLOAD_F((const float*)Vh, KBASE(1)); } }
    MASKT(pA0, pA1, 0); partialSM(pA0, pA1, m_reg, mnA, alA);
    if (NT > 1) { VMW(); if constexpr (F32) { SWRITE_VF(1); SBAR(); if (NT > 2) SLOAD_F((const float*)Kh, KBASE(2)); } else SWRITE_H(1); }
    __syncthreads();
#define HALF_STEP(PX0, PX1, mnX, alX, PY0, PY1, alY, t, KB, VB, SB) do {                                                      \
        SBAR(); qkt<KB, SK>(PX0, PX1, K_lds, r32, hi, S.qr, ACT(t), cbh + KBASE(t));                             \
        finishSM(PY0, PY1, alY, l_reg, pa0, pa1, pa2, pa3); SBAR();                                                           \
        if ((t) + 1 < NT) bias_init(PY0, PY1, cbh + KBASE((t) + 1));                                                          \
        if ((t) + 1 < NT) { if constexpr (F32) { VMW(); SWRITE_KF(SB); SBAR(); SLOAD_F((const float*)Vh, KBASE((t) + 1)); }  \
                            else { SLOAD_H(Kh, Vh, KBASE((t) + 1)); } SBAR(); }                                               \
        pv_tile<VB, SK>(o, vb0, pa0, pa1, pa2, pa3, ACT((t) - 1)); MASKT(PX0, PX1, (t)); partialSM(PX0, PX1, m_reg, mnX, alX);                                        \
        __syncthreads();                                                                                                      \
        if ((t) + 1 < NT) { VMW(); if constexpr (F32) { SWRITE_VF(SB); SBAR(); if ((t) + 2 < NT) SLOAD_F((const float*)Kh, KBASE((t) + 2)); } \
                            else { SWRITE_H(SB); } }                                                                          \
        RESC(alX); __syncthreads(); } while (0)
    for (int t = 1; t + 1 < NT; t += 2) {
        HALF_STEP(pB0, pB1, mnB, alB, pA0, pA1, alA, t, 1, 0, 0);
        HALF_STEP(pA0, pA1, mnA, alA, pB0, pB1, alB, t + 1, 0, 1, 1);
    }
    const bool even = (NT & 1) == 0;
    if (even) { SBAR(); qkt<1, SK>(pB0, pB1, K_lds, r32, hi, S.qr, ACT(NT - 1), cbh + KBASE(NT - 1)); SBAR(); }
#define QROW(e) (nxt.Q + (size_t)(wid * QBLK + r32) * PQ + ((e) >> 1) * 16 + hi * 8 + ((e) & 1) * 4)
    if constexpr (F32) { SLOAD_F((const float*)nxt.K, kbn); SBAR();
#pragma unroll
        for (int e = 0; e < 8; ++e) S.tq[e] = *(const f32x4*)QROW(e); }
    else { SLOAD_H(nxt.K, nxt.V, kbn); SBAR();
#pragma unroll
        for (int d0 = 0; d0 < 8; ++d0) S.qr[d0] = load8<TIn>(nxt.Q + (size_t)(wid * QBLK + r32) * PQ + d0 * 16 + hi * 8); }
    SBAR();
    finishSM(pA0, pA1, alA, l_reg, pa0, pa1, pa2, pa3); SBAR();
    if constexpr (F32) {
#pragma unroll
        for (int e = 8; e < 16; ++e) S.tq[e] = *(const f32x4*)QROW(e); SBAR(); }
#undef QROW
    pv_tile<0, SK>(o, vb0, pa0, pa1, pa2, pa3, ACT(even ? NT - 2 : NT - 1));
    if (even) { MASKT(pB0, pB1, NT - 1); partialSM(pB0, pB1, m_reg, mnB, alB); __syncthreads(); RESC(alB);
        finishSM(pB0, pB1, alB, l_reg, pa0, pa1, pa2, pa3); SBAR(); pv_tile<1, SK>(o, vb0, pa0, pa1, pa2, pa3, ACT(NT - 1)); }
    SBAR(); SEAM_K0();
    if (hi == 0) li_l[r32] = l_reg; asm volatile("s_waitcnt lgkmcnt(0)" ::: "memory");
    float rli[16];
#pragma unroll
    for (int r = 0; r < 16; ++r) rli[r] = __builtin_amdgcn_rcpf(li_l[crow(r, hi)]);
    TOut* Ow = cur.O + (size_t)(wid * QBLK) * PO; const TIn* Gw = cur.Gt + (size_t)(wid * QBLK) * PQ;
    const unsigned short* Gu = reinterpret_cast<const unsigned short*>(Gw);
#pragma unroll
    for (int rh = 0; rh < 2; ++rh) {
        unsigned gr[8][4];
#pragma unroll
        for (int r8 = 0; r8 < 8; ++r8)
#pragma unroll
            for (int d0 = 0; d0 < 4; ++d0) gr[r8][d0] = Gu[(size_t)crow(8 * rh + r8, hi) * PQ + d0 * 32 + r32];
        asm volatile("" ::: "memory");
#pragma unroll
        for (int r8 = 0; r8 < 8; ++r8) { const int r = 8 * rh + r8, orow = crow(r, hi);
#pragma unroll
            for (int d0 = 0; d0 < 4; ++d0) { const float gv = __uint_as_float(gr[r8][d0] << 16); const float v = o[d0][r] * rli[r] * __builtin_amdgcn_rcpf(1.0f + __expf(-gv));
                if constexpr (same_t<TOut, float>::v) { Ow[(size_t)orow * PO + d0 * 32 + r32] = v; }
                else { const float vn = __shfl_xor(v, 1);
                       if ((r32 & 1) == 0) *(unsigned*)(Ow + (size_t)orow * PO + d0 * 32 + r32) = cvtpk(v, vn); } } }
    }
    if constexpr (F32) {
#pragma unroll
        for (int d0 = 0; d0 < 8; ++d0) S.qr[d0] = pack8(S.tq[2 * d0], S.tq[2 * d0 + 1]); }
    __syncthreads();
#undef RESC
#undef KBASE
#undef ACT
#undef MASKT
#undef SEAM_K0
#undef HALF_STEP
}
#undef ROW
#undef VMW
#undef VMWN
#undef SLOAD_H
#undef SWRITE_HK
#undef SWRITE_HV
#undef SWRITE_H
#undef SLOAD_F
#undef SWRITE_KF
#undef SWRITE_VF

}
constexpr int NTOK = 16384, DMOD = 2048, SEQL = 4096, NBAT = 4;
constexpr int ABIN = 6144, FFH = 5632, FF2 = 11264, CINW = 8208, CINP = 8448;
constexpr float RMS_EPS = 1e-6f;
constexpr size_t WS_WABIN = 0;
constexpr size_t WS_WABOUT = WS_WABIN + (size_t)ABIN * DMOD * 2;
constexpr size_t WS_WCIN = WS_WABOUT + (size_t)DMOD * DMOD * 2;
constexpr size_t WS_WCOUT = WS_WCIN + (size_t)CINP * DMOD * 2;
constexpr size_t WS_WUP0 = WS_WCOUT + (size_t)DMOD * DMOD * 2;
constexpr size_t WS_WUP1 = WS_WUP0 + (size_t)FF2 * DMOD * 2;
constexpr size_t WS_WDN0 = WS_WUP1 + (size_t)FF2 * DMOD * 2;
constexpr size_t WS_WDN1 = WS_WDN0 + (size_t)DMOD * FFH * 2;
constexpr size_t WS_ACT = WS_WDN1 + (size_t)DMOD * FFH * 2;
constexpr size_t WS_BIG = WS_ACT + (size_t)NTOK * DMOD * 2;
constexpr size_t WS_Z1 = WS_BIG;
constexpr size_t WS_HL = WS_Z1 + (size_t)NTOK * ABIN * 2;
constexpr size_t WS_DEC = WS_HL + (size_t)32 * 64 * 128 * 128 * 2;
constexpr size_t WS_END_AB = WS_DEC + (size_t)32 * 64 * 128 * 4;
constexpr size_t WS_GA = WS_BIG;
constexpr size_t WS_HALO = WS_GA + (size_t)NTOK * FFH * 2;
constexpr size_t WS_END_FFN = WS_HALO + (size_t)256 * 4 * FF2 * 4;
constexpr size_t WS_QKVG = WS_BIG;
constexpr size_t WS_F = WS_QKVG + (size_t)NTOK * 8192 * 2;
constexpr size_t WS_C = WS_F + (size_t)2 * NTOK * 16 * 4;
constexpr size_t WS_END_C = WS_C + (size_t)64 * 4096 * 4;
constexpr size_t WS_NEED = WS_END_FFN > WS_END_AB ? (WS_END_FFN > WS_END_C ? WS_END_FFN : WS_END_C) : (WS_END_AB > WS_END_C ? WS_END_AB : WS_END_C);
constexpr size_t WS_BAR = (WS_NEED + 255) / 256 * 256;
constexpr size_t WS_TOTAL = WS_BAR + 16384;
constexpr int LDS_BYTES = 147456, LDS_MISC = LDS_BYTES - 128;
constexpr int LDS_BYTES_UNUSED = 0;

#define LAS __attribute__((address_space(3)))
typedef unsigned short bfu;
typedef unsigned v4u __attribute__((ext_vector_type(4)));
typedef float f32x4 __attribute__((ext_vector_type(4)));
typedef short bf16x8 __attribute__((ext_vector_type(8)));
#define LDS_WAIT() asm volatile("s_waitcnt lgkmcnt(0)" ::: "memory")
typedef float f32x2_t __attribute__((ext_vector_type(2))); typedef __bf16 bf16x2_t __attribute__((ext_vector_type(2)));
__device__ __forceinline__ unsigned pk2(float lo, float hi) { f32x2_t v = {lo, hi}; bf16x2_t b = __builtin_convertvector(v, bf16x2_t); return __builtin_bit_cast(unsigned, b); }
__device__ __forceinline__ unsigned f2bf(float f) { return pk2(f, 0.f) & 0xffffu; }
__device__ __forceinline__ float bf2f(unsigned h) { return __builtin_bit_cast(float, h << 16); }
__device__ __forceinline__ float bflo(unsigned w) { return __builtin_bit_cast(float, w << 16); }
__device__ __forceinline__ float bfhi(unsigned w) { return __builtin_bit_cast(float, w & 0xffff0000u); }
__device__ __forceinline__ float sigmoidf_(float x) { return __builtin_amdgcn_rcpf(1.0f + __expf(-x)); }
__device__ __forceinline__ float gelu_erf(float x) { return 0.5f * x * (1.0f + erff(x * 0.70710678118654752f)); }
__device__ __forceinline__ void gelu2(float& a, float& b) { const pg8::f32x2 r = pg8::gelu_pk((pg8::f32x2){a, b}); a = r.x; b = r.y; }
__device__ __forceinline__ float wave_sum(float v) {
#pragma unroll
    for (int o = 1; o < 64; o <<= 1) v += __shfl_xor(v, o);
    return v;
}
__device__ __forceinline__ bf16x8 pack8f(f32x4 a, f32x4 b) { v4u w = {pk2(a[0], a[1]), pk2(a[2], a[3]), pk2(b[0], b[1]), pk2(b[2], b[3])}; return __builtin_bit_cast(bf16x8, w); }
#define MFMA16(a, b, c) __builtin_amdgcn_mfma_f32_16x16x32_bf16((a), (b), (c), 0, 0, 0)

__device__ __forceinline__ void tr_item64(const float* W, int ldw, int K, bfu* WT, int nblk, int item, LAS float* scr, int lane, bool ab_remap = false) {
    const int kb = item / nblk, nb = item - kb * nblk, k0 = 64 * kb, n0 = 64 * nb;
    int d0 = n0; if (ab_remap) { const int bj = n0 >= FFH ? 1 : 0, rem = n0 - bj * FFH; d0 = (rem >> 7) * 256 + bj * 128 + (rem & 127); }
    const int q = lane & 15, kr = lane >> 4;
    f32x4 v[16];
#pragma unroll
    for (int i = 0; i < 16; ++i) v[i] = *(const f32x4*)(W + (size_t)(k0 + 4 * i + kr) * ldw + n0 + 4 * q);
#pragma unroll
    for (int i = 0; i < 16; ++i) { LAS float* s = scr + (4 * i + kr) * 65 + 4 * q; s[0] = v[i][0]; s[1] = v[i][1]; s[2] = v[i][2]; s[3] = v[i][3]; }
    LDS_WAIT(); asm volatile("" ::: "memory");
    const int c = lane & 7;
#pragma unroll
    for (int j = 0; j < 8; ++j) { const int n = (lane >> 3) + 8 * j; const LAS float* s = scr + (8 * c) * 65 + n;
        v4u o; o.x = pk2(s[0], s[65]); o.y = pk2(s[130], s[195]); o.z = pk2(s[260], s[325]); o.w = pk2(s[390], s[455]);
        *(v4u*)(WT + (size_t)(d0 + n) * K + k0 + 8 * c) = o; }
    LDS_WAIT(); asm volatile("" ::: "memory");
}
template <bool NT = false> __device__ __forceinline__ void rms_rows(const float* X, const float* gain, bfu* O, int gw, int NGW, int lane) {
    f32x4 gv[8];
#pragma unroll
    for (int j = 0; j < 8; ++j) gv[j] = ((const f32x4*)gain)[64 * j + lane];
    for (int m = gw; m < NTOK; m += NGW) {
        const f32x4* xr = (const f32x4*)(X + (size_t)m * DMOD) + lane;
        f32x4 v[8]; float s = 0.f;
#pragma unroll
        for (int j = 0; j < 8; ++j) { v[j] = NT ? __builtin_nontemporal_load(xr + 64 * j) : xr[64 * j]; s += (v[j][0] * v[j][0] + v[j][1] * v[j][1]) + (v[j][2] * v[j][2] + v[j][3] * v[j][3]); }
        const float r = rsqrtf(wave_sum(s) * (1.0f / DMOD) + RMS_EPS);
        unsigned long long* o8 = (unsigned long long*)(O + (size_t)m * DMOD) + lane;
#pragma unroll
        for (int j = 0; j < 8; ++j) { const f32x4 y = v[j] * r * gv[j]; o8[64 * j] = (unsigned long long)pk2(y[0], y[1]) | ((unsigned long long)pk2(y[2], y[3]) << 32); }
    }
}

__device__ __forceinline__ void gmlp_tile(int tile, const bfu* Z1, const float* spw, const float* spb, const float* vgain, bfu* Y, LAS unsigned char* lds, int tid, int wave, int lane) {
    const int h = tile & 7, bc = tile >> 3; const size_t tok0 = (size_t)bc * 128;
    LAS bfu* vnT = (LAS bfu*)lds;
    { const int s = tid >> 2, part = tid & 3;
      const bfu* src = Z1 + (tok0 + s) * ABIN + 1024 + h * 128 + 32 * part;
      v4u raw[4];
#pragma unroll
      for (int i = 0; i < 4; ++i) raw[i] = ((const v4u*)src)[i];
      float g[32]; float ss = 0.f;
#pragma unroll
      for (int i = 0; i < 4; ++i)
#pragma unroll
          for (int j = 0; j < 4; ++j) { float a = bflo(raw[i][j]), b = bfhi(raw[i][j]); gelu2(a, b); g[8 * i + 2 * j] = a; g[8 * i + 2 * j + 1] = b; ss += a * a + b * b; }
      ss += __shfl_xor(ss, 1); ss += __shfl_xor(ss, 2);
      const float r = rsqrtf(ss * (1.0f / 128.0f) + RMS_EPS);
      const float* gp = vgain + h * 128 + 32 * part;
#pragma unroll
      for (int e = 0; e < 32; ++e) vnT[(32 * part + e) * 136 + s] = (bfu)f2bf(g[e] * r * gp[e]);
    }
    __syncthreads();
    const int fr = lane & 15, fq = lane >> 4, t0 = 16 * wave, trow = t0 + fr;
    f32x4 acc[8];
#pragma unroll
    for (int nb = 0; nb < 8; ++nb) acc[nb] = (f32x4){0.f, 0.f, 0.f, 0.f};
    const float* wrow = spw + (size_t)(h * 128 + trow) * 128;
    const int nks = (t0 + 15) / 32 + 1;
    for (int ks = 0; ks < nks; ++ks) {
        const int s0 = 32 * ks + 8 * fq;
        f32x4 w0 = *(const f32x4*)(wrow + s0), w1 = *(const f32x4*)(wrow + s0 + 4);
#pragma unroll
        for (int j = 0; j < 4; ++j) { if (s0 + j > trow) w0[j] = 0.f; if (s0 + 4 + j > trow) w1[j] = 0.f; }
        const bf16x8 a = pack8f(w0, w1);
#pragma unroll
        for (int nb = 0; nb < 8; ++nb) { const bf16x8 b = *(const LAS bf16x8*)(vnT + (16 * nb + fr) * 136 + 32 * ks + 8 * fq); acc[nb] = MFMA16(a, b, acc[nb]); }
    }
#pragma unroll
    for (int i = 0; i < 4; ++i) { const int t = t0 + 4 * fq + i; const float bias = spb[h * 128 + t];
        const bfu* up = Z1 + (tok0 + t) * ABIN + h * 128 + fr; bfu* yp = Y + (tok0 + t) * DMOD + h * 128 + fr;
#pragma unroll
        for (int nb = 0; nb < 8; nb += 2) { float u0 = bf2f(up[16 * nb]), u1 = bf2f(up[16 * nb + 16]); gelu2(u0, u1);
            yp[16 * nb] = (bfu)f2bf(u0 * (acc[nb][i] + bias)); yp[16 * nb + 16] = (bfu)f2bf(u1 * (acc[nb + 1][i] + bias)); } }
    __syncthreads();
}

__device__ __forceinline__ float hgrn_lb(const float* gamma, int col) {
    const float g0 = gamma[col], g1 = gamma[1024 + col], g2 = gamma[2048 + col]; const float mx = fmaxf(g0, fmaxf(g1, g2));
    const float e0 = __expf(g0 - mx), e1 = __expf(g1 - mx), e2 = __expf(g2 - mx); return e0 / (e0 + e1 + e2);
}
__device__ __forceinline__ void hgrn_local_tile(int tile, const bfu* Z1, const float* gamma, bfu* HL, float* DEC, LAS unsigned char* lds, int tid, int wave, int lane) {
    const int bh = tile >> 6, c = tile & 63, b = bh >> 3, h = bh & 7; const size_t tok0 = (size_t)b * SEQL + c * 64;
    LAS float* segsum = (LAS float*)lds; LAS bfu* keT = (LAS bfu*)(lds + 2048); LAS bfu* vT = (LAS bfu*)(lds + 2048 + 18432);
    const int seg = tid >> 7, k = tid & 127;
    const float lb = hgrn_lb(gamma, h * 128 + k);
    float fl[16], G[16]; float run = 0.f;
#pragma unroll
    for (int i = 0; i < 16; ++i) { fl[i] = bf2f(Z1[(tok0 + 16 * seg + i) * ABIN + 3072 + h * 128 + k]); run += __logf(lb + (1.0f - lb) * sigmoidf_(fl[i])); G[i] = run; }
    segsum[seg * 128 + k] = run;
    unsigned vw[8];
#pragma unroll
    for (int i = 0; i < 8; ++i) vw[i] = (unsigned)Z1[(tok0 + 16 * seg + 2 * i) * ABIN + 4096 + h * 128 + k] | ((unsigned)Z1[(tok0 + 16 * seg + 2 * i + 1) * ABIN + 4096 + h * 128 + k] << 16);
    *(LAS v4u*)(vT + k * 72 + 16 * seg) = (v4u){vw[0], vw[1], vw[2], vw[3]}; *(LAS v4u*)(vT + k * 72 + 16 * seg + 8) = (v4u){vw[4], vw[5], vw[6], vw[7]};
    __syncthreads();
    float pre = 0.f, tot = 0.f;
#pragma unroll
    for (int s = 0; s < 4; ++s) { const float v = segsum[s * 128 + k]; if (s < seg) pre += v; tot += v; }
    unsigned kw[8];
#pragma unroll
    for (int i = 0; i < 8; ++i) { const float k0 = (1.0f - lb) * sigmoidf_(-fl[2 * i]) * __expf(tot - (pre + G[2 * i])), k1 = (1.0f - lb) * sigmoidf_(-fl[2 * i + 1]) * __expf(tot - (pre + G[2 * i + 1])); kw[i] = pk2(k0, k1); }
    *(LAS v4u*)(keT + k * 72 + 16 * seg) = (v4u){kw[0], kw[1], kw[2], kw[3]}; *(LAS v4u*)(keT + k * 72 + 16 * seg + 8) = (v4u){kw[4], kw[5], kw[6], kw[7]};
    if (seg == 3) DEC[(size_t)(bh * 64 + c) * 128 + k] = __expf(tot);
    __syncthreads();
    const int fr = lane & 15, fq = lane >> 4;
    f32x4 acc[8];
#pragma unroll
    for (int nb = 0; nb < 8; ++nb) acc[nb] = (f32x4){0.f, 0.f, 0.f, 0.f};
#pragma unroll
    for (int ks = 0; ks < 2; ++ks) { const bf16x8 a = *(const LAS bf16x8*)(vT + (16 * wave + fr) * 72 + 32 * ks + 8 * fq);
#pragma unroll
        for (int nb = 0; nb < 8; ++nb) { const bf16x8 bb = *(const LAS bf16x8*)(keT + (16 * nb + fr) * 72 + 32 * ks + 8 * fq); acc[nb] = MFMA16(a, bb, acc[nb]); } }
    LAS bfu* Lt = (LAS bfu*)(lds + 40960);
#pragma unroll
    for (int i = 0; i < 4; ++i)
#pragma unroll
        for (int nb = 0; nb < 8; ++nb) Lt[(16 * wave + 4 * fq + i) * 136 + 16 * nb + fr] = (bfu)f2bf(acc[nb][i]);
    __syncthreads();
    bfu* Lp = HL + (size_t)(bh * 64 + c) * 16384;
#pragma unroll
    for (int j = 0; j < 4; ++j) { const int idx = tid + 512 * j, row = idx >> 4, ch = idx & 15; *(v4u*)(Lp + row * 128 + ch * 8) = *(const LAS v4u*)(Lt + row * 136 + ch * 8); }
    __syncthreads();
}
__device__ __forceinline__ void hgrn_out_tile(int tile, const bfu* Z1, const float* gamma, const float* ogain, const bfu* HL, bfu* Y, LAS unsigned char* lds, int tid, int wave, int lane) {
    const int bh = tile >> 6, c = tile & 63, b = bh >> 3, h = bh & 7; const size_t tok0 = (size_t)b * SEQL + c * 64;
    LAS float* segsum = (LAS float*)lds; LAS float* ssq = (LAS float*)(lds + 2048);
    LAS bfu* qd = (LAS bfu*)(lds + 4096); LAS bfu* kd = qd + 64 * 136; LAS bfu* vT = kd + 64 * 136; LAS bfu* Pm = vT + 128 * 72;
    const int seg = tid >> 7, k = tid & 127;
    const int fr = lane & 15, fq = lane >> 4, tb = wave >> 1, wh = wave & 1;
    const float lb = hgrn_lb(gamma, h * 128 + k);
    unsigned flraw[16], qraw[16], vraw[16], graw[4][4];
#pragma unroll
    for (int i = 0; i < 16; ++i) { const bfu* rp = Z1 + (tok0 + 16 * seg + i) * ABIN + h * 128 + k; flraw[i] = rp[3072]; vraw[i] = rp[4096]; qraw[i] = rp[2048]; }
#pragma unroll
    for (int i = 0; i < 4; ++i)
#pragma unroll
        for (int j = 0; j < 4; ++j) graw[i][j] = Z1[(tok0 + 16 * tb + 4 * fq + i) * ABIN + 5120 + h * 128 + 16 * (4 * wh + j) + fr];
    float fl[16], G[16]; float run = 0.f;
#pragma unroll
    for (int i = 0; i < 16; ++i) { fl[i] = bf2f(flraw[i]); run += __logf(lb + (1.0f - lb) * sigmoidf_(fl[i])); G[i] = run; }
    segsum[seg * 128 + k] = run;
    unsigned vw[8];
#pragma unroll
    for (int i = 0; i < 8; ++i) vw[i] = vraw[2 * i] | (vraw[2 * i + 1] << 16);
    *(LAS v4u*)(vT + k * 72 + 16 * seg) = (v4u){vw[0], vw[1], vw[2], vw[3]}; *(LAS v4u*)(vT + k * 72 + 16 * seg + 8) = (v4u){vw[4], vw[5], vw[6], vw[7]};
    __syncthreads();
    float pre = 0.f;
#pragma unroll
    for (int s = 0; s < 3; ++s) { const float v = segsum[s * 128 + k]; if (s < seg) pre += v; }
#pragma unroll
    for (int i = 0; i < 16; ++i) { const int t = 16 * seg + i; const float Gt = pre + G[i]; const float qv = bf2f(qraw[i]);
        qd[t * 136 + k] = (bfu)f2bf(qv * __expf(Gt)); kd[t * 136 + k] = (bfu)f2bf((1.0f - lb) * sigmoidf_(-fl[i]) * __expf(-Gt)); }
    const bfu* Sg = HL + (size_t)(bh * 64 + c) * 16384;
    bf16x8 sfr[4][4];
#pragma unroll
    for (int ks = 0; ks < 4; ++ks)
#pragma unroll
        for (int j = 0; j < 4; ++j) sfr[ks][j] = *(const bf16x8*)(Sg + (16 * (4 * wh + j) + fr) * 128 + 32 * ks + 8 * fq);
    __syncthreads();
#pragma unroll
    for (int jj = 0; jj < 2; ++jj) { const int sb = 2 * wh + jj; f32x4 sc = (f32x4){0.f, 0.f, 0.f, 0.f};
        if (sb <= tb) {
#pragma unroll
            for (int ks = 0; ks < 4; ++ks) { const bf16x8 a = *(const LAS bf16x8*)(qd + (16 * tb + fr) * 136 + 32 * ks + 8 * fq), bb = *(const LAS bf16x8*)(kd + (16 * sb + fr) * 136 + 32 * ks + 8 * fq); sc = MFMA16(a, bb, sc); } }
#pragma unroll
        for (int i = 0; i < 4; ++i) { const int t = 16 * tb + 4 * fq + i, s = 16 * sb + fr; Pm[t * 72 + s] = (bfu)f2bf(s <= t ? sc[i] : 0.f); } }
    __syncthreads();
    f32x4 acc[4];
#pragma unroll
    for (int j = 0; j < 4; ++j) acc[j] = (f32x4){0.f, 0.f, 0.f, 0.f};
#pragma unroll
    for (int ks = 0; ks < 2; ++ks) { const bf16x8 a = *(const LAS bf16x8*)(Pm + (16 * tb + fr) * 72 + 32 * ks + 8 * fq);
#pragma unroll
        for (int j = 0; j < 4; ++j) { const bf16x8 bb = *(const LAS bf16x8*)(vT + (16 * (4 * wh + j) + fr) * 72 + 32 * ks + 8 * fq); acc[j] = MFMA16(a, bb, acc[j]); } }
#pragma unroll
    for (int ks = 0; ks < 4; ++ks) { const bf16x8 a = *(const LAS bf16x8*)(qd + (16 * tb + fr) * 136 + 32 * ks + 8 * fq);
#pragma unroll
        for (int j = 0; j < 4; ++j) acc[j] = MFMA16(a, sfr[ks][j], acc[j]); }
#pragma unroll
    for (int i = 0; i < 4; ++i) { float pp = (acc[0][i] * acc[0][i] + acc[1][i] * acc[1][i]) + (acc[2][i] * acc[2][i] + acc[3][i] * acc[3][i]);
        pp += __shfl_xor(pp, 1); pp += __shfl_xor(pp, 2); pp += __shfl_xor(pp, 4); pp += __shfl_xor(pp, 8);
        if (fr == 0) ssq[wave * 16 + 4 * fq + i] = pp; }
    __syncthreads();
#pragma unroll
    for (int i = 0; i < 4; ++i) { const int t = 16 * tb + 4 * fq + i; const float r = rsqrtf((ssq[wave * 16 + 4 * fq + i] + ssq[(wave ^ 1) * 16 + 4 * fq + i]) * (1.0f / 128.0f) + RMS_EPS);
#pragma unroll
        for (int j = 0; j < 4; ++j) { const int v = 16 * (4 * wh + j) + fr; const float gt = bf2f(graw[i][j]);
            Y[(tok0 + t) * DMOD + 1024 + h * 128 + v] = (bfu)f2bf(acc[j][i] * r * ogain[v] * gt * sigmoidf_(gt)); } }
    __syncthreads();
}


#ifndef EN_ATTN
#define EN_ATTN 1
#endif
#ifndef EN_MIXAB
#define EN_MIXAB 1
#endif
#ifndef EN_GEMM
#define EN_GEMM 1
#endif
#define XB_TMO      128
#define XB_XCNT(j)  (256  + 64 * (j))
#define XB_XSUB(j)  (1280 + 64 * (j))
#define XB_XGEN(j)  (2304 + 64 * (j))
#define XB_TOP      3328
#define XB_TOPGEN   3392
#define XCD_BAR_WORDS 3456
#define XB_SPIN_CAP (1u << 18)

__device__ __forceinline__ unsigned xb_ld(unsigned* p)              { return __hip_atomic_load(p, __ATOMIC_RELAXED, __HIP_MEMORY_SCOPE_AGENT); }
__device__ __forceinline__ unsigned xb_add(unsigned* p, unsigned v) { return __hip_atomic_fetch_add(p, v, __ATOMIC_RELAXED, __HIP_MEMORY_SCOPE_AGENT); }
__device__ __forceinline__ unsigned xb_xcc_id() { return (unsigned)__builtin_amdgcn_s_getreg((3 << 11) | 20) & 0xFu; }
#define XB_SPIN(cond, bar) do { unsigned _sp = 0; while (cond) { __builtin_amdgcn_s_sleep(1); \
    if ((++_sp & 255u) == 0u) { if (xb_ld(&(bar)[XB_TMO])) break; if (_sp > XB_SPIN_CAP) { atomicAdd(&(bar)[XB_TMO], 1u); break; } } } } while (0)

struct XcdBarrier {
    unsigned* bar; unsigned x;
    volatile LAS unsigned* st;
};

__device__ __forceinline__ XcdBarrier xcd_barrier_post(unsigned* bar, volatile LAS unsigned* st) {
    XcdBarrier b; b.bar = bar; b.x = xb_xcc_id(); b.st = st;
    if (threadIdx.x == 0) (void)xb_add(&bar[XB_XCNT(b.x)], 1u);
    return b;
}
__device__ __forceinline__ void xcd_barrier_complete(unsigned* bar, unsigned x, unsigned& nloc, unsigned& nx) {
    const unsigned G = gridDim.x * gridDim.y * gridDim.z;
    unsigned sum, cnt, mine, sp = 0u;
    for (;;) {
        sum = 0u; cnt = 0u; mine = 0u;
#pragma unroll
        for (unsigned j = 0; j < 16; ++j) { const unsigned c = xb_ld(&bar[XB_XCNT(j)]); sum += c; cnt += (c > 0u) ? 1u : 0u; mine = (j == x) ? c : mine; }
        if (sum == G) break;
        __builtin_amdgcn_s_sleep(1);
        if ((++sp & 255u) == 0u) { if (xb_ld(&bar[XB_TMO])) break; if (sp > XB_SPIN_CAP) { atomicAdd(&bar[XB_TMO], 1u); break; } }
    }
    nloc = mine > 0u ? mine : 1u; nx = cnt > 0u ? cnt : 1u;
}

__device__ __forceinline__ void xcd_barrier(const XcdBarrier& b) {
    asm volatile("s_waitcnt vmcnt(0)" ::: "memory");
    __syncthreads();
    if (threadIdx.x == 0) {
        unsigned* bar = b.bar;
        __builtin_amdgcn_s_waitcnt(0);
        unsigned nloc = b.st[0], nx = b.st[1];
        if (nloc == 0u) { xcd_barrier_complete(bar, b.x, nloc, nx); b.st[0] = nloc; b.st[1] = nx; }
        const unsigned old = xb_add(&bar[XB_XSUB(b.x)], 1u);
        const unsigned gen = old / nloc;
        if (old + 1u == (gen + 1u) * nloc) {
            __builtin_amdgcn_fence(__ATOMIC_RELEASE, "agent");
            asm volatile("s_waitcnt vmcnt(0)" ::: "memory");
            const unsigned og = xb_add(&bar[XB_TOP], 1u);
            const unsigned tg = og / nx;
            if (og + 1u == (tg + 1u) * nx) xb_add(&bar[XB_TOPGEN], 1u);
            else XB_SPIN(xb_ld(&bar[XB_TOPGEN]) == tg, bar);
            __builtin_amdgcn_fence(__ATOMIC_ACQUIRE, "agent");
            xb_add(&bar[XB_XGEN(b.x)], 1u);
            asm volatile("s_waitcnt vmcnt(0)" ::: "memory");
        } else {
            XB_SPIN(xb_ld(&bar[XB_XGEN(b.x)]) == gen, bar);
            __builtin_amdgcn_fence(__ATOMIC_ACQUIRE, "agent");
            asm volatile("s_waitcnt vmcnt(0)" ::: "memory");
        }
    }
    __syncthreads();
}

struct Params { const float* in[19]; float* out; unsigned char* ws; };
#define ARG(p_, i_) ([&]() -> const float* { int k_ = (i_); asm volatile("" : "+s"(k_)); return (p_).in[k_]; }())
#define PHASE_IDS() int tid = threadIdx.x; asm volatile("" : "+v"(tid)); const int lane = tid & 63, wave = __builtin_amdgcn_readfirstlane(tid >> 6); \
    const int G = gridDim.x, gw = blockIdx.x * 8 + wave, NGW = G * 8; const long gtid = (long)blockIdx.x * 512 + tid, NGT = (long)G * 512; (void)lane; (void)gw; (void)NGW; (void)gtid; (void)NGT

template <class Epi> __device__ __forceinline__ void run_gemm(LAS unsigned char* lds, const bfu* A, const bfu* Bt, int M, int N, int K, const Epi& E) {
#if EN_GEMM
    pg8::Gemm g{A, Bt, M, N, K}; pg8::StaticOrder S; S.init(M, N, (int)gridDim.x, (int)blockIdx.x);
    pg8::gemm_phase<Epi, pg8::StaticOrder, true, true>(lds, g, S, E);
#endif
}

struct TrDesc { const float* src; bfu* dst; int ldw, K; };
__device__ __forceinline__ TrDesc tr_decode(const Params& p, int item) {
    constexpr int I0 = 96 * 32, I1 = 32 * 32, I2 = 128 * 32, I3 = 32 * 32, I4 = 176 * 32, I5 = 32 * 88;
    unsigned char* ws = p.ws; const float* W; bfu* WT; int ldw, K, nblk; bool remap = false; int r = item;
    if (r < I0) { W = ARG(p, 2); WT = (bfu*)(ws + WS_WABIN); ldw = ABIN; K = DMOD; nblk = 96; }
    else if ((r -= I0) < I1) { W = ARG(p, 8); WT = (bfu*)(ws + WS_WABOUT); ldw = DMOD; K = DMOD; nblk = 32; }
    else if ((r -= I1) < I2) { W = ARG(p, 9); WT = (bfu*)(ws + WS_WCIN); ldw = CINW; K = DMOD; nblk = 128; }
    else if ((r -= I2) < I3) { W = ARG(p, 13); WT = (bfu*)(ws + WS_WCOUT); ldw = DMOD; K = DMOD; nblk = 32; }
    else if ((r -= I3) < I4) { W = ARG(p, 15); WT = (bfu*)(ws + WS_WUP0); ldw = FF2; K = DMOD; nblk = 176; remap = true; }
    else if ((r -= I4) < I4) { W = ARG(p, 15) + (size_t)DMOD * FF2; WT = (bfu*)(ws + WS_WUP1); ldw = FF2; K = DMOD; nblk = 176; remap = true; }
    else if ((r -= I4) < I5) { W = ARG(p, 18); WT = (bfu*)(ws + WS_WDN0); ldw = DMOD; K = FFH; nblk = 32; }
    else { r -= I5; W = ARG(p, 18) + (size_t)FFH * DMOD; WT = (bfu*)(ws + WS_WDN1); ldw = DMOD; K = FFH; nblk = 32; }
    const int kb = r / nblk, nb = r - kb * nblk, k0 = 64 * kb, n0 = 64 * nb;
    int d0 = n0; if (remap) { const int bj = n0 >= FFH ? 1 : 0, rem = n0 - bj * FFH; d0 = (rem >> 7) * 256 + bj * 128 + (rem & 127); }
    TrDesc d; d.src = W + (size_t)k0 * ldw + n0; d.dst = WT + (size_t)d0 * K + k0; d.ldw = ldw; d.K = K; return d;
}
__device__ __forceinline__ void tr_load(const TrDesc& d, f32x4 (&v)[16], int lane) {
    const float* s = d.src + (size_t)(lane >> 4) * d.ldw + 4 * (lane & 15);
#pragma unroll
    for (int i = 0; i < 16; ++i) v[i] = __builtin_nontemporal_load((const f32x4*)(s + (size_t)(4 * i) * d.ldw));
}
__device__ __forceinline__ void tr_finish(const TrDesc& d, const f32x4 (&v)[16], LAS float* scr, int lane) {
    const int q = lane & 15, kr = lane >> 4;
#pragma unroll
    for (int i = 0; i < 16; ++i) { LAS float* s = scr + (4 * i + kr) * 65 + 4 * q; s[0] = v[i][0]; s[1] = v[i][1]; s[2] = v[i][2]; s[3] = v[i][3]; }
    LDS_WAIT(); asm volatile("" ::: "memory");
    const int c = lane & 7;
#pragma unroll
    for (int j = 0; j < 8; ++j) { const int n = (lane >> 3) + 8 * j; const LAS float* s = scr + (8 * c) * 65 + n;
        v4u o; o.x = pk2(s[0], s[65]); o.y = pk2(s[130], s[195]); o.z = pk2(s[260], s[325]); o.w = pk2(s[390], s[455]);
        *(v4u*)(d.dst + (size_t)n * d.K + 8 * c) = o; }
    LDS_WAIT(); asm volatile("" ::: "memory");
}
__device__ __forceinline__ void p0_phase(const Params& p, LAS unsigned char* lds) {
    PHASE_IDS(); unsigned char* ws = p.ws;
    bfu* Wcin = (bfu*)(ws + WS_WCIN);
    LAS float* scr = (LAS float*)(lds + wave * 16640);
    constexpr int NIT = 96 * 32 + 32 * 32 + 128 * 32 + 32 * 32 + 2 * 176 * 32 + 2 * 32 * 88;
    f32x4 va[16], vb[16]; TrDesc da, db; int it = gw;
    if (it < NIT) { da = tr_decode(p, it); tr_load(da, va, lane); }
    for (; it < NIT; it += 2 * NGW) {
        const int it1 = it + NGW, it2 = it + 2 * NGW;
        if (it1 < NIT) { db = tr_decode(p, it1); tr_load(db, vb, lane); }
        tr_finish(da, va, scr, lane);
        if (it2 < NIT) { da = tr_decode(p, it2); tr_load(da, va, lane); }
        if (it1 < NIT) tr_finish(db, vb, scr, lane);
    }
    for (long i = gtid; i < 16 * DMOD; i += NGT) { const int j = (int)(i / DMOD), kk = (int)(i % DMOD); Wcin[(size_t)(8192 + j) * DMOD + kk] = (bfu)f2bf(ARG(p, 9)[(size_t)kk * CINW + 8192 + j]); }
    rms_rows<true>(ARG(p, 0), ARG(p, 1), (bfu*)(ws + WS_ACT), gw, NGW, lane);
}
__device__ __forceinline__ void norm_phase(const float* X, const float* gain, bfu* O) { PHASE_IDS(); rms_rows<true>(X, gain, O, gw, NGW, lane); }

__device__ __forceinline__ void mixab_phase1(const Params& p, LAS unsigned char* lds) {
#if EN_MIXAB
    PHASE_IDS(); unsigned char* ws = p.ws; const bfu* Z1 = (const bfu*)(ws + WS_Z1);
    for (int t = blockIdx.x; t < 1024 + 2048; t += G) {
        if (t < 1024) gmlp_tile(t, Z1, ARG(p, 3), ARG(p, 4), ARG(p, 5), (bfu*)(ws + WS_ACT), lds, tid, wave, lane);
        else hgrn_local_tile(t - 1024, Z1, ARG(p, 6), (bfu*)(ws + WS_HL), (float*)(ws + WS_DEC), lds, tid, wave, lane);
    }
#endif
}
__device__ __forceinline__ void hgrn_scan_phase(const Params& p) {
    PHASE_IDS(); bfu* HL = (bfu*)(p.ws + WS_HL); const float* DEC = (const float*)(p.ws + WS_DEC);
    typedef unsigned u32x2 __attribute__((ext_vector_type(2)));
    for (long e = gtid; e < 32L * 128 * 32; e += NGT) {
        const int bh = (int)(e >> 12), vq = (int)(e & 4095);
        bfu* base = HL + (size_t)bh * 64 * 16384 + (size_t)vq * 4; const float* db = DEC + (size_t)bh * 64 * 128 + (vq & 31) * 4;
        f32x4 s = (f32x4){0.f, 0.f, 0.f, 0.f};
        for (int c0 = 0; c0 < 64; c0 += 16) {
            u32x2 Lc[16]; f32x4 dc[16];
#pragma unroll
            for (int u = 0; u < 16; ++u) { Lc[u] = *(const u32x2*)(base + (size_t)(c0 + u) * 16384); dc[u] = *(const f32x4*)(db + (c0 + u) * 128); }
#pragma unroll
            for (int u = 0; u < 16; ++u) { *(u32x2*)(base + (size_t)(c0 + u) * 16384) = (u32x2){pk2(s[0], s[1]), pk2(s[2], s[3])};
                s = dc[u] * s + (f32x4){bflo(Lc[u][0]), bfhi(Lc[u][0]), bflo(Lc[u][1]), bfhi(Lc[u][1])}; }
        }
    }
}
__device__ __forceinline__ void mixab_phase3(const Params& p, LAS unsigned char* lds) {
#if EN_MIXAB
    PHASE_IDS(); unsigned char* ws = p.ws;
    for (int t = blockIdx.x; t < 2048; t += G) hgrn_out_tile(t, (const bfu*)(ws + WS_Z1), ARG(p, 6), ARG(p, 7), (const bfu*)(ws + WS_HL), (bfu*)(ws + WS_ACT), lds, tid, wave, lane);
#endif
}
__device__ __forceinline__ void fgate_phase(const Params& p) {
    PHASE_IDS(); const bfu* A = (const bfu*)(p.ws + WS_ACT); const bfu* Bw = (const bfu*)(p.ws + WS_WCIN) + (size_t)8192 * DMOD; float* Fb = (float*)(p.ws + WS_F);
    const int fr = lane & 15, fq = lane >> 4;
    for (int it = gw; it < 2 * (NTOK / 16); it += NGW) {
        const int rb = it >> 1, kh = it & 1;
        const bfu* ap = A + (size_t)(16 * rb + fr) * DMOD + 8 * fq + 1024 * kh; const bfu* bp = Bw + (size_t)fr * DMOD + 8 * fq + 1024 * kh;
        f32x4 acc0 = (f32x4){0.f, 0.f, 0.f, 0.f}, acc1 = acc0;
#pragma unroll 8
        for (int ks = 0; ks < 32; ks += 2) {
            const bf16x8 a0 = *(const bf16x8*)(ap + 32 * ks), b0 = *(const bf16x8*)(bp + 32 * ks), a1 = *(const bf16x8*)(ap + 32 * ks + 32), b1 = *(const bf16x8*)(bp + 32 * ks + 32);
            acc0 = MFMA16(a0, b0, acc0); acc1 = MFMA16(a1, b1, acc1); }
#pragma unroll
        for (int i = 0; i < 4; ++i) Fb[(size_t)kh * NTOK * 16 + (size_t)(16 * rb + 4 * fq + i) * 16 + fr] = acc0[i] + acc1[i];
    }
}
__device__ __forceinline__ void qknorm_phase(const Params& p) {
    PHASE_IDS(); const float* Fb = (const float*)(p.ws + WS_F); float* Cb = (float*)(p.ws + WS_C);
    if (gw < 64) {
        const int bh = gw, b = bh >> 4, h = bh & 15; const float bf_ = ARG(p, 10)[h];
        const float* fp = Fb + ((size_t)b * SEQL + 64 * lane) * 16 + h;
        float tot = 0.f;
        for (int i = 0; i < 64; ++i) { const float z = fp[i * 16] + fp[(size_t)NTOK * 16 + i * 16] + bf_; tot += fminf(z, 0.f) - log1pf(__expf(-fabsf(z))); }
        float inc = tot;
#pragma unroll
        for (int o = 1; o < 64; o <<= 1) { const float u = __shfl_up(inc, o); if (lane >= o) inc += u; }
        float run = inc - tot;
        float* cp = Cb + (size_t)bh * SEQL + 64 * lane;
        for (int i = 0; i < 64; ++i) { const float z = fp[i * 16] + fp[(size_t)NTOK * 16 + i * 16] + bf_; run += fminf(z, 0.f) - log1pf(__expf(-fabsf(z))); cp[i] = run; }
    }
}
__device__ __forceinline__ void attn_phase(const Params& p, char* ldsg) {
#if EN_ATTN
    using bfh = __hip_bfloat16; typedef fox::BlockRef<bfh, bfh> BR;
    const bfh* Qb = (const bfh*)(p.ws + WS_QKVG); bfh* Yb = (bfh*)(p.ws + WS_ACT); const float* Cb = (const float*)(p.ws + WS_C);
    const int total = 512, stride = gridDim.x;
    float margin;
    { const float* qg = ARG(p, 11); const float* kg = ARG(p, 12); float a = 0.f, b = 0.f;
#pragma unroll 8
      for (int i = 0; i < 128; ++i) { a = fmaxf(a, fabsf(qg[i])); b = fmaxf(b, fabsf(kg[i])); }
      margin = 110.0f + 2.0f * 1.01f * 128.0f * a * b * fox::SCALE;
      margin = __builtin_bit_cast(float, __builtin_amdgcn_readfirstlane(__builtin_bit_cast(int, margin))); }
#define FOX_ID(L_, pass_) const int bh_ = ((L_) & 7) + 8 * ((L_) >> 6), x_ = ((L_) >> 3) & 7, qb_ = (pass_) ? 15 - x_ : x_, b_ = bh_ >> 4, h_ = bh_ & 15
#define FOX_REF(r, L_, pass_, sk_) do { FOX_ID(L_, pass_); \
        const size_t SEC_ = (size_t)NTOK * 2048, hb_ = (size_t)bh_ * SEQL * 128, rq_ = hb_ + (size_t)qb_ * 256 * 128; \
        (r).Q = Qb + rq_; (r).K = Qb + SEC_ + hb_ + (size_t)(sk_) * 128; (r).V = Qb + 2 * SEC_ + hb_ + (size_t)(sk_) * 128; (r).Gt = Qb + 3 * SEC_ + rq_; \
        (r).O = Yb + ((size_t)b_ * SEQL + (size_t)qb_ * 256) * 2048 + h_ * 128; (r).P0 = qb_ * 256 - (sk_); (r).cb = Cb + (size_t)bh_ * SEQL + (sk_); } while (0)
    int sk00 = 0, sk01 = 0, sk10 = 0, sk11 = 0;
#define FOX_SKIP(dst, L_, pass_) do { FOX_ID(L_, pass_); (void)b_; (void)h_; dst = fox::fox_jlo(Cb + (size_t)bh_ * SEQL, qb_ * 256, margin) * 64; } while (0)
    { const int L0 = blockIdx.x, L1 = blockIdx.x + stride;
      if (L0 < total) { FOX_SKIP(sk00, L0, 0); FOX_SKIP(sk01, L0, 1); }
      if (L1 < total) { FOX_SKIP(sk10, L1, 0); FOX_SKIP(sk11, L1, 1); } }
#define FOX_SK(L_, pass_) ((L_) == (int)blockIdx.x ? ((pass_) ? sk01 : sk00) : (L_) == (int)blockIdx.x + stride ? ((pass_) ? sk11 : sk10) : 0)
    int L = blockIdx.x;
    if (L < total) {
        int pass = 0; BR cur; FOX_REF(cur, L, 0, FOX_SK(L, 0));
        fox::Seam<bfh> S;
        fox::causal_swa_prime<bfh, bfh>(cur, SEQL, ldsg, S);
        for (;;) {
            const bool more_pass = pass == 0, more_item = L + stride < total, last = !more_pass && !more_item;
            int passn = pass + 1, Ln = L;
            if (!more_pass) { passn = 0; Ln = more_item ? L + stride : L; }
            BR nxt = cur; if (!last) FOX_REF(nxt, Ln, passn, FOX_SK(Ln, passn));
            fox::causal_swa_block<bfh, bfh>(cur, nxt, SEQL, SEQL, ldsg, S);
            if (last) break;
            cur = nxt; pass = passn; L = Ln;
        }
#undef FOX_SK
#undef FOX_SKIP
#undef FOX_ID
#undef FOX_REF
    }
#endif
}
__device__ __forceinline__ void conv_fix_phase(const float* HALO, const float* cw, const float* cbv, bfu* GA) {
    PHASE_IDS();
    for (long e = gtid; e < 256L * 2 * 1408; e += NGT) {
        const int cq = (int)(e % 1408), gr = (int)(e / 1408), r = gr & 1, g = gr >> 1;
        const int c = cq * 4, cp = (c >> 7) * 256 + (c & 127);
        const bool first = (g & 63) == 0;
        const float* H = HALO + (size_t)g * 4 * FF2 + cp; const float* Hp = first ? H : H - 4 * FF2;
        const f32x4 zero = (f32x4){0.f, 0.f, 0.f, 0.f};
        const f32x4 za = *(const f32x4*)(H + r * FF2), zb = *(const f32x4*)(H + r * FF2 + 128);
        f32x4 za1, zb1, za2, zb2;
        if (r == 0) { za1 = *(const f32x4*)(Hp + 3 * FF2); zb1 = *(const f32x4*)(Hp + 3 * FF2 + 128); za2 = *(const f32x4*)(Hp + 2 * FF2); zb2 = *(const f32x4*)(Hp + 2 * FF2 + 128); if (first) { za1 = zero; zb1 = zero; za2 = zero; zb2 = zero; } }
        else { za1 = *(const f32x4*)(H); zb1 = *(const f32x4*)(H + 128); za2 = *(const f32x4*)(Hp + 3 * FF2); zb2 = *(const f32x4*)(Hp + 3 * FF2 + 128); if (first) { za2 = zero; zb2 = zero; } }
        const f32x4 a = *(const f32x4*)(cbv + c) + *(const f32x4*)(cw + c) * za2 + *(const f32x4*)(cw + FF2 + c) * za1 + *(const f32x4*)(cw + 2 * FF2 + c) * za;
        const f32x4 b = *(const f32x4*)(cbv + FFH + c) + *(const f32x4*)(cw + FFH + c) * zb2 + *(const f32x4*)(cw + FF2 + FFH + c) * zb1 + *(const f32x4*)(cw + 2 * FF2 + FFH + c) * zb;
        float gv[4];
#pragma unroll
        for (int i = 0; i < 4; ++i) gv[i] = a[i] * sigmoidf_(a[i]) * b[i];
        *(unsigned long long*)(GA + ((size_t)g * 64 + r) * FFH + c) = (unsigned long long)pk2(gv[0], gv[1]) | ((unsigned long long)pk2(gv[2], gv[3]) << 32);
    }
}
#define GSYNC() xcd_barrier(xbar)
template <int LAYER> __device__ __forceinline__ void ffn_block(const Params& p, LAS unsigned char* lds, const XcdBarrier& xbar) {
    unsigned char* ws = p.ws; bfu* ACT = (bfu*)(ws + WS_ACT); bfu* GA = (bfu*)(ws + WS_GA); float* HALO = (float*)(ws + WS_HALO);
    const bfu* Wup = (const bfu*)(ws + (LAYER ? WS_WUP1 : WS_WUP0)); const bfu* Wdn = (const bfu*)(ws + (LAYER ? WS_WDN1 : WS_WDN0));
    const float* cw = ARG(p, 16) + (size_t)LAYER * 3 * FF2; const float* cbv = ARG(p, 17) + (size_t)LAYER * FF2;
    norm_phase(p.out, ARG(p, 14) + (size_t)LAYER * DMOD, ACT);
    GSYNC();
    { pg8::EpiConvGate E{GA, HALO, cw, cbv}; run_gemm(lds, ACT, Wup, NTOK, FF2, DMOD, E); }
    GSYNC();
    conv_fix_phase(HALO, cw, cbv, GA);
    GSYNC();
    { pg8::EpiResF32 E{p.out, p.out, DMOD}; run_gemm(lds, GA, Wdn, NTOK, DMOD, FFH, E); }
}

__global__ void __launch_bounds__(512, 2) fwd_mega(Params p) {
    extern __shared__ __attribute__((aligned(16))) unsigned char lds_raw[];
    LAS unsigned char* lds = (LAS unsigned char*)lds_raw;
    unsigned char* ws = p.ws; bfu* ACT = (bfu*)(ws + WS_ACT);
    unsigned* barw = (unsigned*)(ws + WS_BAR);
    if (blockIdx.x == 0) for (int i = threadIdx.x; i < 4096; i += 512) barw[i] = 0u;
    if (threadIdx.x < 32) ((LAS unsigned*)(lds + LDS_MISC))[threadIdx.x] = 0u;
    cg::this_grid().sync();
    const XcdBarrier xbar = xcd_barrier_post(barw, (volatile LAS unsigned*)(lds + LDS_MISC));
    p0_phase(p, lds);
    GSYNC();
    { pg8::EpiBf16<0> E{(bfu*)(ws + WS_Z1), ABIN, nullptr, 0, 0, 1.f}; run_gemm(lds, ACT, (const bfu*)(ws + WS_WABIN), NTOK, ABIN, DMOD, E); }
    GSYNC();
    mixab_phase1(p, lds);
    GSYNC();
    hgrn_scan_phase(p);
    GSYNC();
    mixab_phase3(p, lds);
    GSYNC();
    { pg8::EpiResF32 E{ARG(p, 0), p.out, DMOD}; run_gemm(lds, ACT, (const bfu*)(ws + WS_WABOUT), NTOK, DMOD, DMOD, E); }
    GSYNC();
    ffn_block<0>(p, lds, xbar);
    GSYNC();
    norm_phase(p.out, ARG(p, 1) + DMOD, ACT);
    GSYNC();
    { pg8::EpiCin E{(bfu*)(ws + WS_QKVG), ARG(p, 11), ARG(p, 12), (LAS float*)(lds + 131072)}; run_gemm(lds, ACT, (const bfu*)(ws + WS_WCIN), NTOK, 8192, DMOD, E); }
    fgate_phase(p);
    GSYNC();
    qknorm_phase(p);
    GSYNC();
    attn_phase(p, (char*)lds_raw);
    GSYNC();
    { pg8::EpiResF32 E{p.out, p.out, DMOD}; run_gemm(lds, ACT, (const bfu*)(ws + WS_WCOUT), NTOK, DMOD, DMOD, E); }
    GSYNC();
    ffn_block<1>(p, lds, xbar);
}

extern "C" void kernel_launch(void* const* d_in, const int* in_sizes, int n_in, void* d_out, int out_size, void* d_ws, size_t ws_size, hipStream_t stream) {
    static int grid = 0;
    if (grid == 0) {
        if (n_in != 19 || in_sizes[0] != NTOK * DMOD || out_size != NTOK * DMOD || ws_size < WS_TOTAL) {
            fprintf(stderr, "kernel_launch: shape/workspace mismatch (n_in %d, in0 %d, out %d, ws %zu, need %zu)\n", n_in, n_in > 0 ? in_sizes[0] : -1, out_size, ws_size, (size_t)WS_TOTAL); grid = -1; return; }
        int dev = 0, cus = 0, per_cu = 0;
        (void)hipGetDevice(&dev); (void)hipDeviceGetAttribute(&cus, hipDeviceAttributeMultiprocessorCount, dev);
        if (hipFuncSetAttribute((const void*)fwd_mega, hipFuncAttributeMaxDynamicSharedMemorySize, LDS_BYTES) != hipSuccess) { fprintf(stderr, "kernel_launch: hipFuncSetAttribute failed\n"); grid = -1; return; }
        if (hipOccupancyMaxActiveBlocksPerMultiprocessor(&per_cu, (const void*)fwd_mega, 512, LDS_BYTES) != hipSuccess || per_cu < 1) { fprintf(stderr, "kernel_launch: occupancy query says %d\n", per_cu); per_cu = 1; }
        (void)hipGetLastError();
        grid = cus > 0 ? cus : 256;
    }
    if (grid < 0) return;
    Params prm{};
    for (int i = 0; i < 19; ++i) prm.in[i] = (const float*)d_in[i];
    prm.out = (float*)d_out; prm.ws = (unsigned char*)d_ws;
    void* args[] = {&prm};
    hipError_t e = hipLaunchCooperativeKernel((const void*)fwd_mega, dim3(grid), dim3(512), args, LDS_BYTES, stream);
    if (e != hipSuccess) fprintf(stderr, "kernel_launch: cooperative launch failed: %s (grid %d)\n", hipGetErrorString(e), grid);
}
```
